# Optimizing an MI355X kernel written in HIP

```python
import math
import jax, jax.numpy as jnp
from jax import lax
import numpy as np

D_MODEL = 1024
BATCH = 2
SEQ = 16384
DEPTH = 1
DEC_BATCH = 32
DEC_SEQ = 2048
PAST_LEN = 128

ATT_HEADS = 8
ATT_HEAD_DIM = 64
ATT_WIDTH = ATT_HEADS * ATT_HEAD_DIM
DILATED_PATTERNS = ((128, 1), (512, 4), (2048, 16))
ATT_BLOCK = 64
NEG_INF = -1e30
DN_HEADS = 4
DN_HEAD_DIM = 128
DN_WIDTH = DN_HEADS * DN_HEAD_DIM
DN_CONV = 5
DN_CHUNK = 64
MIX_WIDTH = ATT_WIDTH + DN_WIDTH
IN_COLS = 3 * ATT_WIDTH + 4 * DN_WIDTH + 4 * DN_HEADS
FFN_DIM = 2816
FFN_CONV = 3
ROPE_THETA = 10000.0
NORM_EPS = 1e-6

kernel_name = 'hymba_dilated_swa_bi_gated_deltanet_convglu'


def _rms_norm(x, gain):
    xf = x.astype(jnp.float32)
    y = xf * lax.rsqrt(jnp.mean(xf * xf, axis=-1, keepdims=True) + NORM_EPS)
    return (y * gain.astype(jnp.float32)).astype(x.dtype)


def _l2_norm(x):
    return x * lax.rsqrt(jnp.sum(x * x, axis=-1, keepdims=True) + NORM_EPS)


def _dwconv_centered(x, w):
    k_width = w.shape[0]
    pad = k_width // 2
    length = x.shape[1]
    xp = jnp.pad(x, ((0, 0), (pad, pad), (0, 0)))
    out = xp[:, 0:length] * w[0]
    for j in range(1, k_width):
        out = out + xp[:, j:j + length] * w[j]
    return out


def _rotary(x):
    length, dh = x.shape[1], x.shape[-1]
    half = dh // 2
    inv_freq = 1.0 / (ROPE_THETA ** (jnp.arange(half, dtype=jnp.float32) * 2.0 / dh))
    ang = jnp.arange(length, dtype=jnp.float32)[:, None] * inv_freq[None, :]
    cos = jnp.cos(ang)[None, :, None, :]
    sin = jnp.sin(ang)[None, :, None, :]
    x1, x2 = x[..., :half], x[..., half:]
    return jnp.concatenate([x1 * cos - x2 * sin, x2 * cos + x1 * sin], axis=-1)


def _band_attention(q, k, v, radius):
    n, length, h, dh = q.shape
    blk = ATT_BLOCK
    nn = -(-radius // blk)
    nb = -(-length // blk)
    lp = nb * blk
    qp = jnp.pad(q, ((0, 0), (0, lp - length), (0, 0), (0, 0))).reshape(n, nb, blk, h, dh)
    pad_kv = ((0, 0), (nn * blk, lp - length + nn * blk), (0, 0), (0, 0))
    kp = jnp.pad(k, pad_kv).reshape(n, nb + 2 * nn, blk, h, dh)
    vp = jnp.pad(v, pad_kv).reshape(n, nb + 2 * nn, blk, h, dh)
    kw = jnp.concatenate([kp[:, j:j + nb] for j in range(2 * nn + 1)], axis=2)
    vw = jnp.concatenate([vp[:, j:j + nb] for j in range(2 * nn + 1)], axis=2)
    qpos = jnp.arange(nb)[:, None] * blk + jnp.arange(blk)[None, :]
    kpos = jnp.arange(nb)[:, None] * blk - nn * blk + jnp.arange((2 * nn + 1) * blk)[None, :]
    valid = ((jnp.abs(qpos[:, :, None] - kpos[:, None, :]) <= radius)
             & (kpos[:, None, :] >= 0) & (kpos[:, None, :] < length))
    s = jnp.einsum('nbqhd,nbkhd->nbhqk', qp, kw) * (1.0 / math.sqrt(dh))
    s = jnp.where(valid[None, :, None, :, :], s, NEG_INF)
    m = jnp.max(s, axis=-1)
    p = jnp.exp(s - m[..., None])
    den = jnp.sum(p, axis=-1)
    num = jnp.einsum('nbhqk,nbkhd->nbqhd', p, vw).reshape(n, lp, h, dh)[:, :length]
    m = m.transpose(0, 1, 3, 2).reshape(n, lp, h)[:, :length]
    den = den.transpose(0, 1, 3, 2).reshape(n, lp, h)[:, :length]
    return num, m, den


def _dilated_window(q, k, v, window, dilation):
    b, length, h, dh = q.shape
    ld = length // dilation

    def to_sub(t):
        return t.reshape(b, ld, dilation, h, dh).transpose(0, 2, 1, 3, 4).reshape(b * dilation, ld, h, dh)

    num, m, den = _band_attention(to_sub(q), to_sub(k), to_sub(v), window // (2 * dilation))
    num = num.reshape(b, dilation, ld, h, dh).transpose(0, 2, 1, 3, 4).reshape(b, length, h, dh)
    m = m.reshape(b, dilation, ld, h).transpose(0, 2, 1, 3).reshape(b, length, h)
    den = den.reshape(b, dilation, ld, h).transpose(0, 2, 1, 3).reshape(b, length, h)
    return num, m, den


def _dilated_attention(q, k, v):
    parts = [_dilated_window(q, k, v, w, d) for (w, d) in DILATED_PATTERNS]
    m_all = parts[0][1]
    for part in parts[1:]:
        m_all = jnp.maximum(m_all, part[1])
    scale0 = jnp.exp(parts[0][1] - m_all)
    num = parts[0][0] * scale0[..., None]
    den = parts[0][2] * scale0
    for part in parts[1:]:
        sc = jnp.exp(part[1] - m_all)
        num = num + part[0] * sc[..., None]
        den = den + part[2] * sc
    return num / den[..., None]


def _gated_delta_rule(q, k, v, g, beta):
    b, length, h, dk = q.shape
    dv = v.shape[-1]
    c = DN_CHUNK
    nc = length // c

    def chunks(t):
        return t.reshape(b, nc, c, h, -1).transpose(0, 1, 3, 2, 4)

    q, k, v = chunks(q), chunks(k), chunks(v)
    g = g.reshape(b, nc, c, h).transpose(0, 1, 3, 2)
    beta = beta.reshape(b, nc, c, h).transpose(0, 1, 3, 2)
    gc = jnp.cumsum(g, axis=-1)
    tri = jnp.tril(jnp.ones((c, c), dtype=bool))
    strict = jnp.tril(jnp.ones((c, c), dtype=bool), -1)
    decay = jnp.exp(jnp.where(tri, gc[..., :, None] - gc[..., None, :], -jnp.inf))
    kb = k * beta[..., None]
    lmat = jnp.where(strict, jnp.einsum('bnhid,bnhjd->bnhij', kb, k) * decay, 0.0)
    amat = lmat + jnp.eye(c, dtype=lmat.dtype)
    rhs = jnp.concatenate([v * beta[..., None], kb * jnp.exp(gc)[..., None]], axis=-1)
    sol = lax.linalg.triangular_solve(amat, rhs, left_side=True, lower=True, unit_diagonal=True)
    u, w = sol[..., :dv], sol[..., dv:]
    qk = jnp.einsum('bnhid,bnhjd->bnhij', q, k) * decay
    q_dec = q * jnp.exp(gc)[..., None]
    g_last = gc[..., -1]
    k_dec = k * jnp.exp(g_last[..., None] - gc)[..., None]
    xs = tuple(t.swapaxes(0, 1) for t in (u, w, qk, q_dec, k_dec, g_last))

    def step(state, inp):
        u_c, w_c, qk_c, qd_c, kd_c, gl_c = inp
        v_new = u_c - jnp.einsum('bhcd,bhde->bhce', w_c, state)
        o_c = jnp.einsum('bhcd,bhde->bhce', qd_c, state) + jnp.einsum('bhij,bhje->bhie', qk_c, v_new)
        state = state * jnp.exp(gl_c)[..., None, None] + jnp.einsum('bhcd,bhce->bhde', kd_c, v_new)
        return state, o_c

    s0 = jnp.zeros((b, h, dk, dv), jnp.float32)
    _, o = lax.scan(step, s0, xs)
    return o.transpose(1, 0, 3, 2, 4).reshape(b, length, h, dv)


def _layer(x, norm1, w_in, att_q_norm, att_k_norm, dn_conv_w, dn_a_log, dn_dt_bias, dn_out_norm,
           w_out, norm2, w_up, ffn_conv_w, ffn_conv_b, w_down):
    b, length, _ = x.shape
    f32 = jnp.float32
    n = _rms_norm(x, norm1)
    proj = n @ w_in
    o1 = ATT_WIDTH
    o3 = 3 * ATT_WIDTH
    o4 = o3 + 3 * DN_WIDTH
    o5 = o4 + DN_WIDTH
    o6 = o5 + 2 * DN_HEADS
    att_q, att_k, att_v, dn_qkv, dn_g, dn_b, dn_a = jnp.split(proj, [o1, 2 * o1, o3, o4, o5, o6], axis=-1)

    hs = (b, length, ATT_HEADS, ATT_HEAD_DIM)
    aq = _rotary(_rms_norm(att_q.reshape(hs), att_q_norm).astype(f32))
    ak = _rotary(_rms_norm(att_k.reshape(hs), att_k_norm).astype(f32))
    av = att_v.reshape(hs).astype(f32)
    att_out = _dilated_attention(aq, ak, av).reshape(b, length, ATT_WIDTH).astype(x.dtype)

    qkv = jax.nn.silu(_dwconv_centered(dn_qkv, dn_conv_w).astype(f32))
    dq, dk, dv = jnp.split(qkv, [DN_WIDTH, 2 * DN_WIDTH], axis=-1)
    ds = (b, length, DN_HEADS, DN_HEAD_DIM)
    dq = _l2_norm(dq.reshape(ds)) * (DN_HEAD_DIM ** -0.5)
    dk = _l2_norm(dk.reshape(ds))
    dv = dv.reshape(ds)
    beta = jax.nn.sigmoid(dn_b.astype(f32)).reshape(b, length, 2, DN_HEADS)
    log_decay = -jnp.exp(dn_a_log.astype(f32)) * jax.nn.softplus(
        dn_a.astype(f32).reshape(b, length, 2, DN_HEADS) + dn_dt_bias.astype(f32))
    o_fwd = _gated_delta_rule(dq, dk, dv, log_decay[:, :, 0], beta[:, :, 0])
    flip = lambda t: jnp.flip(t, axis=1)
    o_bwd = flip(_gated_delta_rule(flip(dq), flip(dk), flip(dv), flip(log_decay[:, :, 1]), flip(beta[:, :, 1])))
    o_dn = _rms_norm(o_fwd + o_bwd, dn_out_norm) * jax.nn.silu(dn_g.astype(f32)).reshape(ds)
    dn_out = o_dn.reshape(b, length, DN_WIDTH).astype(x.dtype)

    h = x + jnp.concatenate([att_out, dn_out], axis=-1) @ w_out

    u = _dwconv_centered(_rms_norm(h, norm2) @ w_up, ffn_conv_w) + ffn_conv_b
    gate, up = jnp.split(u, 2, axis=-1)
    return h + (jax.nn.silu(gate) * up) @ w_down


def setup_inputs(seed: int = 0) -> dict:
    key = jax.random.key(seed)
    ks = jax.random.split(key, 20)
    f32 = jnp.float32

    def nrm(k, shape, scale):
        return jax.random.normal(k, shape, f32) * scale

    x_prompt = nrm(ks[0], (BATCH, SEQ, D_MODEL), 1.0)
    x_sample = nrm(ks[1], (DEC_BATCH, DEC_SEQ, D_MODEL), 1.0)
    norm1 = 1.0 + nrm(ks[2], (DEPTH, D_MODEL), 0.02)
    w_in = nrm(ks[3], (DEPTH, D_MODEL, IN_COLS), D_MODEL ** -0.5)
    att_q_norm = 1.0 + nrm(ks[4], (DEPTH, ATT_HEAD_DIM), 0.02)
    att_k_norm = 1.0 + nrm(ks[5], (DEPTH, ATT_HEAD_DIM), 0.02)
    dn_conv_w = nrm(ks[6], (DEPTH, DN_CONV, 3 * DN_WIDTH), DN_CONV ** -0.5)
    dn_a_log = jnp.log(jax.random.uniform(ks[7], (DEPTH, 2, DN_HEADS), f32, 1.0, 16.0))
    dt = jnp.exp(jax.random.uniform(ks[8], (DEPTH, 2, DN_HEADS), f32, math.log(1e-3), math.log(1e-1)))
    dn_dt_bias = dt + jnp.log(-jnp.expm1(-dt))
    dn_out_norm = 1.0 + nrm(ks[9], (DEPTH, DN_HEAD_DIM), 0.02)
    w_out = nrm(ks[10], (DEPTH, MIX_WIDTH, D_MODEL), MIX_WIDTH ** -0.5)
    norm2 = 1.0 + nrm(ks[11], (DEPTH, D_MODEL), 0.02)
    w_up = nrm(ks[12], (DEPTH, D_MODEL, 2 * FFN_DIM), D_MODEL ** -0.5)
    ffn_conv_w = nrm(ks[13], (DEPTH, FFN_CONV, 2 * FFN_DIM), FFN_CONV ** -0.5)
    ffn_conv_b = nrm(ks[14], (DEPTH, 2 * FFN_DIM), 0.02)
    w_down = nrm(ks[15], (DEPTH, FFN_DIM, D_MODEL), FFN_DIM ** -0.5)
    return {'x_prompt': x_prompt, 'x_sample': x_sample, 'norm1': norm1, 'w_in': w_in,
            'att_q_norm': att_q_norm, 'att_k_norm': att_k_norm, 'dn_conv_w': dn_conv_w,
            'dn_a_log': dn_a_log, 'dn_dt_bias': dn_dt_bias, 'dn_out_norm': dn_out_norm,
            'w_out': w_out, 'norm2': norm2, 'w_up': w_up, 'ffn_conv_w': ffn_conv_w,
            'ffn_conv_b': ffn_conv_b, 'w_down': w_down}


def reference(x_prompt, x_sample, norm1, w_in, att_q_norm, att_k_norm, dn_conv_w, dn_a_log,
              dn_dt_bias, dn_out_norm, w_out, norm2, w_up, ffn_conv_w, ffn_conv_b, w_down):
    def trunk(x):
        for l in range(DEPTH):
            x = _layer(x, norm1[l], w_in[l], att_q_norm[l], att_k_norm[l], dn_conv_w[l], dn_a_log[l],
                       dn_dt_bias[l], dn_out_norm[l], w_out[l], norm2[l], w_up[l], ffn_conv_w[l],
                       ffn_conv_b[l], w_down[l])
        return x

    y_prompt = trunk(x_prompt)
    y_sample = trunk(x_sample)
    return (y_prompt, y_sample)
```

```cpp
#include <hip/hip_runtime.h>
#include <hip/hip_cooperative_groups.h>
#include <cstdio>
namespace cg = cooperative_groups;

typedef unsigned short u16;
typedef __attribute__((ext_vector_type(8))) short bf16x8;
typedef __attribute__((ext_vector_type(4))) float f32x4;
typedef __attribute__((ext_vector_type(4))) unsigned u32x4;
typedef __attribute__((ext_vector_type(2))) unsigned u32x2;
typedef __bf16 bf2_t __attribute__((ext_vector_type(2)));
typedef float f2_t __attribute__((ext_vector_type(2)));
#define DI __device__ __forceinline__

constexpr int TG = 32768;
constexpr int NPROJ = 3584;
constexpr size_t MiB = 1u << 20;
constexpr size_t WS_WIN = 0, WS_WOUT = 7 * MiB, WS_WUP = 9 * MiB, WS_WDOWN = 20 * MiB;
constexpr size_t WS_GATES = 27 * MiB, WS_LSE = 29 * MiB, WS_ROWSQ = 32 * MiB, WS_EGL = 34 * MiB;
constexpr size_t WS_NBUF = 35 * MiB;
constexpr size_t WS_PROJ = 99 * MiB;
constexpr size_t WS_HB = WS_PROJ, WS_ACT = WS_PROJ + 64 * MiB;
constexpr size_t WS_DNP = 339 * MiB, WS_ATTP = 435 * MiB, WS_DNOP = 531 * MiB, WS_OF = 819 * MiB;
constexpr int DNOP_BYTES = 73728;
constexpr int OP_WN = 0, OP_QD = 16384, OP_QK = 32768, OP_KDT = 40960, OP_UT = 57344;
constexpr int LDS_BYTES = 163840;

struct Params {
  const float *xp, *xs, *norm1, *w_in, *qn, *kn, *dn_conv_w, *a_log, *dt_bias, *out_norm, *w_out, *norm2, *w_up, *ffn_cw, *ffn_cb, *w_down;
  float* out; unsigned char* ws;
};

DI float bf2f(unsigned v) { return __uint_as_float(v << 16); }
DI float bflo(unsigned v) { return __uint_as_float(v << 16); }
DI float bfhi(unsigned v) { return __uint_as_float(v & 0xffff0000u); }
DI unsigned pk2(float lo, float hi) { f2_t v = {lo, hi}; bf2_t r = __builtin_convertvector(v, bf2_t); return __builtin_bit_cast(unsigned, r); }
DI u16 f2bf(float x) { return (u16)(pk2(x, 0.f) & 0xffffu); }
DI int opaque_tid() { int t = threadIdx.x; asm volatile("" : "+v"(t)); return t; }
DI float wave_sum(float v) {
#pragma unroll
  for (int o = 32; o > 0; o >>= 1) v += __shfl_xor(v, o);
  return v;
}
DI f32x4 mfma16(bf16x8 a, bf16x8 b, f32x4 c) { return __builtin_amdgcn_mfma_f32_16x16x32_bf16(a, b, c, 0, 0, 0); }
DI float sigmoidf_(float x) { return 1.f / (1.f + __expf(-x)); }
DI float siluf_(float x) { return x / (1.f + __expf(-x)); }

DI void conv_weight(const float* __restrict__ W, int Nsrc, int K, int Nout, u16* __restrict__ WT, int mode, const float* __restrict__ scale,
                    long gtid, long nthr) {
  const int kgn = K >> 3;
  for (long idx = gtid; idx < (long)Nout * kgn; idx += nthr) {
    const int n = (int)(idx % Nout), kg = (int)(idx / Nout);
    int src = n;
    if (mode == 1) { const int pn = n >> 8, ct = n & 255; src = (ct < 128) ? (pn * 128 + ct) : (2816 + pn * 128 + ct - 128); }
    float v[8];
#pragma unroll
    for (int j = 0; j < 8; ++j) { const int k = kg * 8 + j; const float s = scale ? scale[k] : 1.f; v[j] = W[(long)k * Nsrc + src] * s; }
    u32x4 o = {pk2(v[0], v[1]), pk2(v[2], v[3]), pk2(v[4], v[5]), pk2(v[6], v[7])};
    *(u32x4*)(WT + (long)n * K + kg * 8) = o;
  }
}

DI void phase_norm(const Params& p, const float* __restrict__ xg, unsigned char* ws, unsigned char* smem) {
  const int tidx = opaque_tid();
  f32x4* gw4 = (f32x4*)smem;
  float* gwf = (float*)smem;
  for (int e = tidx; e < 1024 * 16; e += 512) {
    const int k = e >> 4, jg = e & 15;
    const int ln = (k >> 2) & 63, j = k >> 8, ee = k & 3, q = jg >> 2, cmp = jg & 3;
    gwf[((((j * 4 + ee) * 4 + q) * 64 + ln) << 2) + cmp] = p.w_in[(long)k * 3600 + 3584 + jg];
  }
  __syncthreads();
  const int wave = tidx >> 6, lane = tidx & 63;
  u16* nbuf = (u16*)(ws + WS_NBUF); float* gates = (float*)(ws + WS_GATES);
  for (int row = blockIdx.x * 8 + wave; row < TG; row += gridDim.x * 8) {
    const f32x4* xr = (const f32x4*)(xg + (long)row * 1024);
    f32x4 v[4]; float ss = 0.f;
#pragma unroll
    for (int j = 0; j < 4; ++j) { v[j] = xr[lane + 64 * j]; ss += v[j].x * v[j].x + v[j].y * v[j].y + v[j].z * v[j].z + v[j].w * v[j].w; }
    ss = wave_sum(ss);
    const float rs = rsqrtf(ss * (1.f / 1024.f) + 1e-6f);
    float ga[16];
#pragma unroll
    for (int i = 0; i < 16; ++i) ga[i] = 0.f;
#pragma unroll
    for (int j = 0; j < 4; ++j) {
      const f32x4 nw = ((const f32x4*)p.norm1)[lane + 64 * j];
      v[j].x *= rs * nw.x; v[j].y *= rs * nw.y; v[j].z *= rs * nw.z; v[j].w *= rs * nw.w;
      u32x2 o = {pk2(v[j].x, v[j].y), pk2(v[j].z, v[j].w)};
      *(u32x2*)(nbuf + (long)row * 1024 + 4 * (lane + 64 * j)) = o;
#pragma unroll
      for (int e = 0; e < 4; ++e) {
        const float xv = v[j][e];
#pragma unroll
        for (int q = 0; q < 4; ++q) {
          const f32x4 w4 = gw4[((j * 4 + e) * 4 + q) * 64 + lane];
          ga[4 * q + 0] += xv * w4.x; ga[4 * q + 1] += xv * w4.y; ga[4 * q + 2] += xv * w4.z; ga[4 * q + 3] += xv * w4.w;
        }
        __builtin_amdgcn_sched_barrier(0);
      }
    }
    float r = 0.f;
#pragma unroll
    for (int i = 0; i < 16; ++i) { const float s = wave_sum(ga[i]); r = (lane == i) ? s : r; }
    if (lane < 16) {
      float o;
      if (lane < 8) o = sigmoidf_(r);
      else { const int jj = lane - 8; const float z = r + p.dt_bias[jj]; const float sp = (z > 20.f) ? z : log1pf(__expf(z)); o = -__expf(p.a_log[jj]) * sp; }
      gates[(long)row * 16 + lane] = o;
    }
  }
}

template <int MODE>
DI void gemm_phase(const Params& p, int grp, unsigned char* ws, unsigned char* smem, const float* __restrict__ xg, float* __restrict__ outg) {
  const int tidx = opaque_tid();
  const u16* A; const u16* Bt; int K, nM, nN, lda;
  if (MODE == 1) { A = (const u16*)(ws + WS_NBUF); Bt = (const u16*)(ws + WS_WIN); K = 1024; nM = TG / 256; nN = NPROJ / 256; lda = 1024; }
  else if (MODE == 2) { A = (const u16*)(ws + WS_NBUF); Bt = (const u16*)(ws + WS_WOUT); K = 1024; nM = TG / 256; nN = 4; lda = 1024; }
  else if (MODE == 3) { A = (const u16*)(ws + WS_HB); Bt = (const u16*)(ws + WS_WUP); K = 1024; nM = (TG + 253) / 254; nN = 22; lda = 1024; }
  else { A = (const u16*)(ws + WS_ACT); Bt = (const u16*)(ws + WS_WDOWN); K = 2816; nM = TG / 256; nN = 4; lda = 2816; }
  const int L = (grp == 0) ? 16384 : 2048;
  const int tid = tidx, lane = tid & 63, wid = tid >> 6, wr = wid >> 2, wc = wid & 3, c16 = lane & 15, g = lane >> 4;
  const int ntiles = nM * nN, nk = K >> 6;
  const int G = gridDim.x, b = blockIdx.x;
  const int bperm = ((G & 7) == 0) ? ((b & 7) * (G >> 3) + (b >> 3)) : b;
  const int chunk = tid & 7, r0 = tid >> 3;
  const int sw = c16 & 7;
  const int aoff = (wr * 128 + c16) * 128, boff = 32768 + (wc * 64 + c16) * 128;
  for (int T = bperm; T < ntiles; T += G) {
    const int sg = T / (8 * nN), fm = sg * 8, gsz = (nM - fm) < 8 ? (nM - fm) : 8, idx = T - sg * 8 * nN;
    const int pm = fm + (idx % gsz), pn = idx / gsz;
    const int rowbase = (MODE == 3) ? (pm * 254 - 1) : (pm * 256);
    int ao[4];
#pragma unroll
    for (int i = 0; i < 4; ++i) {
      int ar = rowbase + r0 + 64 * i;
      if (MODE == 3) ar = ar < 0 ? 0 : (ar > TG - 1 ? TG - 1 : ar);
      ao[i] = ar * lda + chunk * 8;
    }
    const u16* bp0 = Bt + (long)(pn * 256 + r0) * K + chunk * 8;
    f32x4 acc[8][4];
#pragma unroll
    for (int m = 0; m < 8; ++m)
#pragma unroll
      for (int n = 0; n < 4; ++n) acc[m][n] = (f32x4){0.f, 0.f, 0.f, 0.f};
    u32x4 ra[4], rb[4];
#pragma unroll
    for (int i = 0; i < 4; ++i) { ra[i] = *(const u32x4*)(A + ao[i]); rb[i] = *(const u32x4*)(bp0 + i * 64 * K); }
    __syncthreads();
#pragma unroll
    for (int i = 0; i < 4; ++i) {
      const int row = r0 + 64 * i; const int off = row * 128 + ((chunk ^ (row & 7)) << 4);
      *(u32x4*)(smem + off) = ra[i]; *(u32x4*)(smem + 32768 + off) = rb[i];
    }
    __syncthreads();
    for (int kt = 0; kt < nk; ++kt) {
      if (kt + 1 < nk) {
#pragma unroll
        for (int i = 0; i < 4; ++i) { ra[i] = *(const u32x4*)(A + ao[i] + (kt + 1) * 64); rb[i] = *(const u32x4*)(bp0 + i * 64 * K + (kt + 1) * 64); }
      }
      const unsigned char* buf = smem + (kt & 1) * 65536;
#pragma unroll
      for (int kk = 0; kk < 2; ++kk) {
        bf16x8 bfr[4];
        const int co = ((kk * 4 + g) ^ sw) << 4;
#pragma unroll
        for (int n = 0; n < 4; ++n) bfr[n] = *(const bf16x8*)(buf + boff + n * 2048 + co);
#pragma unroll
        for (int mh = 0; mh < 2; ++mh) {
          bf16x8 af[4];
#pragma unroll
          for (int m = 0; m < 4; ++m) af[m] = *(const bf16x8*)(buf + aoff + (mh * 4 + m) * 2048 + co);
#pragma unroll
          for (int m = 0; m < 4; ++m)
#pragma unroll
            for (int n = 0; n < 4; ++n) acc[mh * 4 + m][n] = mfma16(bfr[n], af[m], acc[mh * 4 + m][n]);
          __builtin_amdgcn_sched_barrier(0);
        }
      }
      if (kt + 1 < nk) {
        unsigned char* nb = smem + ((kt + 1) & 1) * 65536;
#pragma unroll
        for (int i = 0; i < 4; ++i) {
          const int row = r0 + 64 * i; const int off = row * 128 + ((chunk ^ (row & 7)) << 4);
          *(u32x4*)(nb + off) = ra[i]; *(u32x4*)(nb + 32768 + off) = rb[i];
        }
      }
      __syncthreads();
    }
    if (MODE == 1) {
      u16* proj = (u16*)(ws + WS_PROJ);
#pragma unroll
      for (int m = 0; m < 8; ++m) {
        const long row = pm * 256 + wr * 128 + m * 16 + c16;
#pragma unroll
        for (int n = 0; n < 4; ++n) {
          const int col = pn * 256 + wc * 64 + n * 16 + g * 4;
          u32x2 o = {pk2(acc[m][n].x, acc[m][n].y), pk2(acc[m][n].z, acc[m][n].w)};
          *(u32x2*)(proj + row * NPROJ + col) = o;
        }
      }
    } else if (MODE == 2) {
      u16* hb = (u16*)(ws + WS_HB); float* rowsq = (float*)(ws + WS_ROWSQ);
#pragma unroll
      for (int m = 0; m < 8; ++m) {
        const long row = pm * 256 + wr * 128 + m * 16 + c16;
        float s = 0.f;
#pragma unroll
        for (int n = 0; n < 4; ++n) {
          const int col = pn * 256 + wc * 64 + n * 16 + g * 4;
          const f32x4 xv = *(const f32x4*)(xg + row * 1024 + col);
          f32x4 h = {xv.x + acc[m][n].x, xv.y + acc[m][n].y, xv.z + acc[m][n].z, xv.w + acc[m][n].w};
          *(f32x4*)(outg + row * 1024 + col) = h;
          u32x2 o = {pk2(h.x, h.y), pk2(h.z, h.w)};
          *(u32x2*)(hb + row * 1024 + col) = o;
          s += h.x * h.x + h.y * h.y + h.z * h.z + h.w * h.w;
        }
        s += __shfl_xor(s, 16); s += __shfl_xor(s, 32);
        if (g == 0) rowsq[row * 16 + pn * 4 + wc] = s;
      }
    } else if (MODE == 4) {
#pragma unroll
      for (int m = 0; m < 8; ++m) {
        const long row = pm * 256 + wr * 128 + m * 16 + c16;
#pragma unroll
        for (int n = 0; n < 4; ++n) {
          const int col = pn * 256 + wc * 64 + n * 16 + g * 4;
          f32x4 h = *(const f32x4*)(outg + row * 1024 + col);
          h.x += acc[m][n].x; h.y += acc[m][n].y; h.z += acc[m][n].z; h.w += acc[m][n].w;
          *(f32x4*)(outg + row * 1024 + col) = h;
        }
      }
    } else {
      const float* rowsq = (const float*)(ws + WS_ROWSQ);
      u16* act = (u16*)(ws + WS_ACT);
#pragma unroll
      for (int m = 0; m < 8; ++m) {
        const int rl = wr * 128 + m * 16 + c16;
        int ar = rowbase + rl; ar = ar < 0 ? 0 : (ar > TG - 1 ? TG - 1 : ar);
        const f32x4* rq = (const f32x4*)(rowsq + (long)ar * 16);
        const f32x4 q0 = rq[0], q1 = rq[1], q2 = rq[2], q3 = rq[3];
        const float ssq = (q0.x + q0.y + q0.z + q0.w) + (q1.x + q1.y + q1.z + q1.w) + (q2.x + q2.y + q2.z + q2.w) + (q3.x + q3.y + q3.z + q3.w);
        const float rs2 = rsqrtf(ssq * (1.f / 1024.f) + 1e-6f);
#pragma unroll
        for (int n = 0; n < 4; ++n) {
          const int col = wc * 64 + n * 16 + g * 4;
          u32x2 o = {pk2(acc[m][n].x * rs2, acc[m][n].y * rs2), pk2(acc[m][n].z * rs2, acc[m][n].w * rs2)};
          *(u32x2*)(smem + rl * 520 + col * 2) = o;
        }
      }
      __syncthreads();
      {
        const int hp = tid & 63, rg = tid >> 6;
        const int hid = pn * 128 + 2 * hp;
        float cwg[3][2], cwu[3][2], cbg[2], cbu[2];
#pragma unroll
        for (int j = 0; j < 3; ++j) {
          cwg[j][0] = p.ffn_cw[j * 5632 + hid]; cwg[j][1] = p.ffn_cw[j * 5632 + hid + 1];
          cwu[j][0] = p.ffn_cw[j * 5632 + 2816 + hid]; cwu[j][1] = p.ffn_cw[j * 5632 + 2816 + hid + 1];
        }
        cbg[0] = p.ffn_cb[hid]; cbg[1] = p.ffn_cb[hid + 1]; cbu[0] = p.ffn_cb[2816 + hid]; cbu[1] = p.ffn_cb[2816 + hid + 1];
        const int i0 = rg * 32 < 1 ? 1 : rg * 32, i1 = (rg * 32 + 31) > 254 ? 254 : (rg * 32 + 31);
        unsigned gp = *(const unsigned*)(smem + (i0 - 1) * 520 + hp * 4), up = *(const unsigned*)(smem + (i0 - 1) * 520 + 256 + hp * 4);
        unsigned gc = *(const unsigned*)(smem + i0 * 520 + hp * 4), uc = *(const unsigned*)(smem + i0 * 520 + 256 + hp * 4);
        for (int i = i0; i <= i1; ++i) {
          const unsigned gn = *(const unsigned*)(smem + (i + 1) * 520 + hp * 4), un = *(const unsigned*)(smem + (i + 1) * 520 + 256 + hp * 4);
          const int lt = rowbase + i;
          if (lt < TG) {
            const int pos = lt & (L - 1);
            const float mp = (pos != 0) ? 1.f : 0.f, mn = (pos != L - 1) ? 1.f : 0.f;
            const float G0 = cwg[0][0] * bflo(gp) * mp + cwg[1][0] * bflo(gc) + cwg[2][0] * bflo(gn) * mn + cbg[0];
            const float G1 = cwg[0][1] * bfhi(gp) * mp + cwg[1][1] * bfhi(gc) + cwg[2][1] * bfhi(gn) * mn + cbg[1];
            const float U0 = cwu[0][0] * bflo(up) * mp + cwu[1][0] * bflo(uc) + cwu[2][0] * bflo(un) * mn + cbu[0];
            const float U1 = cwu[0][1] * bfhi(up) * mp + cwu[1][1] * bfhi(uc) + cwu[2][1] * bfhi(un) * mn + cbu[1];
            *(unsigned*)(act + (long)lt * 2816 + hid) = pk2(siluf_(G0) * U0, siluf_(G1) * U1);
          }
          gp = gc; up = uc; gc = gn; uc = un;
        }
      }
    }
  }
}

DI void phase_prep(const Params& p, int grp, unsigned char* ws) {
  const int tidx = opaque_tid();
  const int L = (grp == 0) ? 16384 : 2048;
  const int lane = tidx & 63;
  const int gw = blockIdx.x * 8 + (tidx >> 6), NW = gridDim.x * 8;
  u16* proj = (u16*)(ws + WS_PROJ);
  {
    const int i = lane & 15;
    const float f0 = exp2f(-(float)(2 * i) * (13.287712379549449f / 32.f)), f1 = exp2f(-(float)(2 * i + 1) * (13.287712379549449f / 32.f));
    for (int base = gw * 4; base < TG * 16; base += NW * 4) {
      const int u = base + (lane >> 4), t = u >> 4, hs = u & 15;
      u16* ptr = proj + (long)t * NPROJ + hs * 64;
      const unsigned elo = *(const unsigned*)(ptr + 2 * i), ehi = *(const unsigned*)(ptr + 32 + 2 * i);
      float x1a = bflo(elo), x1b = bfhi(elo), x2a = bflo(ehi), x2b = bfhi(ehi);
      float ss = x1a * x1a + x1b * x1b + x2a * x2a + x2b * x2b;
      ss += __shfl_xor(ss, 1); ss += __shfl_xor(ss, 2); ss += __shfl_xor(ss, 4); ss += __shfl_xor(ss, 8);
      const float rs = rsqrtf(ss * (1.f / 64.f) + 1e-6f);
      const float* gn = (hs < 8) ? p.qn : p.kn;
      const float sc = (hs < 8) ? 0.125f : 1.f;
      x1a *= rs * gn[2 * i]; x1b *= rs * gn[2 * i + 1]; x2a *= rs * gn[32 + 2 * i]; x2b *= rs * gn[33 + 2 * i];
      const float pos = (float)(t & (L - 1));
      float s0, c0, s1, c1;
      sincosf(pos * f0, &s0, &c0); sincosf(pos * f1, &s1, &c1);
      const float o1a = (x1a * c0 - x2a * s0) * sc, o2a = (x2a * c0 + x1a * s0) * sc;
      const float o1b = (x1b * c1 - x2b * s1) * sc, o2b = (x2b * c1 + x1b * s1) * sc;
      *(unsigned*)(ptr + 2 * i) = pk2(o1a, o1b); *(unsigned*)(ptr + 32 + 2 * i) = pk2(o2a, o2b);
    }
  }
  {
    u16* dnp = (u16*)(ws + WS_DNP);
    for (int unit = gw; unit < 12 * (TG / 64); unit += NW) {
      const int s = unit % 12, r = unit / 12, t0 = r * 64;
      const int c = s * 128 + 2 * lane;
      float w0[5], w1[5];
#pragma unroll
      for (int j = 0; j < 5; ++j) { w0[j] = p.dn_conv_w[j * 1536 + c]; w1[j] = p.dn_conv_w[j * 1536 + c + 1]; }
      const u16* src = proj + 1536 + c;
      const int pos0 = t0 & (L - 1);
      unsigned win[5];
      win[0] = (pos0 >= 2) ? *(const unsigned*)(src + (long)(t0 - 2) * NPROJ) : 0u;
      win[1] = (pos0 >= 1) ? *(const unsigned*)(src + (long)(t0 - 1) * NPROJ) : 0u;
      win[2] = *(const unsigned*)(src + (long)t0 * NPROJ);
      win[3] = *(const unsigned*)(src + (long)(t0 + 1) * NPROJ);
      const float qs = (s < 4) ? 0.08838834764831845f : 1.f;
      for (int tt = 0; tt < 64; ++tt) {
        const int t = t0 + tt, pos = pos0 + tt;
        win[4] = (pos + 2 < L) ? *(const unsigned*)(src + (long)(t + 2) * NPROJ) : 0u;
        float a0 = 0.f, a1 = 0.f;
#pragma unroll
        for (int j = 0; j < 5; ++j) { a0 += w0[j] * bflo(win[j]); a1 += w1[j] * bfhi(win[j]); }
        a0 = siluf_(a0); a1 = siluf_(a1);
        if (s < 8) {
          const float ss = wave_sum(a0 * a0 + a1 * a1);
          const float rs = rsqrtf(ss + 1e-6f) * qs;
          a0 *= rs; a1 *= rs;
        }
        *(unsigned*)(dnp + (long)t * 1536 + c) = pk2(a0, a1);
#pragma unroll
        for (int j = 0; j < 4; ++j) win[j] = win[j + 1];
      }
    }
  }
}

DI void attn_item(int grp, unsigned char* ws, unsigned char* smem, int item) {
  const int tidx = opaque_tid();
  const int L = (grp == 0) ? 16384 : 2048;
  const int pat = item >> 11, rem = item & 2047, h = rem & 7, bi = rem >> 3;
  const int dsh = pat * 2, d = 1 << dsh;
  const int st = bi >> dsh, r = bi & (d - 1), base = st * (128 << dsh), s0 = base & ~(L - 1);
  const int tid = tidx, lane = tid & 63, w = tid >> 6, c16 = lane & 15, g = lane >> 4;
  const u16* proj = (const u16*)(ws + WS_PROJ);
  unsigned char* Qs = smem; unsigned char* Ks = smem + 16384; u16* Vt = (u16*)(smem + 51200);
  for (int e = tid; e < 1024; e += 512) {
    const int row = e >> 3, ch = e & 7; const long lt = base + r + (row << dsh);
    const u32x4 v = *(const u32x4*)(proj + lt * NPROJ + h * 64 + ch * 8);
    *(u32x4*)(Qs + row * 128 + ((ch ^ (row & 7)) << 4)) = v;
  }
  for (int e = tid; e < 2176; e += 512) {
    const int row = e >> 3, ch = e & 7; const int lt = base + r + (row - 64) * d;
    const bool valid = (row < 256) && (lt >= s0) && (lt < s0 + L);
    u32x4 kv = {0u, 0u, 0u, 0u}, vv = {0u, 0u, 0u, 0u};
    if (valid) { kv = *(const u32x4*)(proj + (long)lt * NPROJ + 512 + h * 64 + ch * 8); vv = *(const u32x4*)(proj + (long)lt * NPROJ + 1024 + h * 64 + ch * 8); }
    *(u32x4*)(Ks + row * 128 + ((ch ^ (row & 7)) << 4)) = kv;
    u16* vd = Vt + (ch * 8) * 280 + row;
    vd[0 * 280] = (u16)(vv.x & 0xffff); vd[1 * 280] = (u16)(vv.x >> 16); vd[2 * 280] = (u16)(vv.y & 0xffff); vd[3 * 280] = (u16)(vv.y >> 16);
    vd[4 * 280] = (u16)(vv.z & 0xffff); vd[5 * 280] = (u16)(vv.z >> 16); vd[6 * 280] = (u16)(vv.w & 0xffff); vd[7 * 280] = (u16)(vv.w >> 16);
  }
  __syncthreads();
  const int sw = c16 & 7;
  bf16x8 qf[2];
#pragma unroll
  for (int kk = 0; kk < 2; ++kk) qf[kk] = *(const bf16x8*)(Qs + (16 * w + c16) * 128 + (((kk * 4 + g) ^ sw) << 4));
  f32x4 sc[10];
#pragma unroll
  for (int t = 0; t < 10; ++t) {
    f32x4 a = {0.f, 0.f, 0.f, 0.f};
#pragma unroll
    for (int kk = 0; kk < 2; ++kk) {
      const bf16x8 kf = *(const bf16x8*)(Ks + ((w + t) * 16 + c16) * 128 + (((kk * 4 + g) ^ sw) << 4));
      a = mfma16(kf, qf[kk], a);
    }
    sc[t] = a;
  }
  const int qi = 16 * w + c16;
  float mx = -1e30f;
#pragma unroll
  for (int t = 0; t < 10; ++t)
#pragma unroll
    for (int j = 0; j < 4; ++j) {
      const int kj = (w + t) * 16 + g * 4 + j - 64;
      const int lt = base + r + kj * d;
      const int df = qi - kj;
      const bool valid = (df <= 64) && (df >= -64) && (lt >= s0) && (lt < s0 + L);
      const float s = valid ? sc[t][j] : -1e30f;
      sc[t][j] = s; mx = fmaxf(mx, s);
    }
  mx = fmaxf(mx, __shfl_xor(mx, 16)); mx = fmaxf(mx, __shfl_xor(mx, 32));
  float den = 0.f;
#pragma unroll
  for (int t = 0; t < 10; ++t)
#pragma unroll
    for (int j = 0; j < 4; ++j) { const float pe = (sc[t][j] > -1e29f) ? __expf(sc[t][j] - mx) : 0.f; sc[t][j] = pe; den += pe; }
  den += __shfl_xor(den, 16); den += __shfl_xor(den, 32);
  f32x4 oa[4];
#pragma unroll
  for (int n = 0; n < 4; ++n) oa[n] = (f32x4){0.f, 0.f, 0.f, 0.f};
#pragma unroll
  for (int tp = 0; tp < 5; ++tp) {
    u32x4 pu = {pk2(sc[2 * tp].x, sc[2 * tp].y), pk2(sc[2 * tp].z, sc[2 * tp].w), pk2(sc[2 * tp + 1].x, sc[2 * tp + 1].y), pk2(sc[2 * tp + 1].z, sc[2 * tp + 1].w)};
    const bf16x8 pa = __builtin_bit_cast(bf16x8, pu);
#pragma unroll
    for (int n = 0; n < 4; ++n) {
      const u16* vp = Vt + (n * 16 + c16) * 280 + (w + 2 * tp) * 16 + g * 4;
      const u32x2 v0 = *(const u32x2*)vp, v1 = *(const u32x2*)(vp + 16);
      u32x4 vu = {v0.x, v0.y, v1.x, v1.y};
      oa[n] = mfma16(pa, __builtin_bit_cast(bf16x8, vu), oa[n]);
    }
  }
  u16* attp = (u16*)(ws + WS_ATTP); float* lse = (float*)(ws + WS_LSE);
#pragma unroll
  for (int j = 0; j < 4; ++j) {
    const int qs = g * 4 + j;
    const float dj = __shfl(den, qs);
    const float inv = 1.f / dj;
    const long lt = base + r + ((16 * w + qs) << dsh);
    u16* dst = attp + ((long)pat * TG + lt) * 512 + h * 64 + c16;
#pragma unroll
    for (int n = 0; n < 4; ++n) dst[n * 16] = f2bf(oa[n][j] * inv);
  }
  if (g == 0) { const long lt = base + r + ((long)qi << dsh); lse[((long)pat * TG + lt) * 8 + h] = mx + __logf(den); }
  __syncthreads();
}

DI void dnlocal_item(unsigned char* ws, unsigned char* smem, int item) {
  const int tidx = opaque_tid();
  const int ch = item >> 2, hd = item & 3;
  const int tid = tidx, lane = tid & 63, w = tid >> 6, c16 = lane & 15, g = lane >> 4;
  const int dir = tid >> 8, t8 = tid & 255;
  const u16* dnp = (const u16*)(ws + WS_DNP); const float* gates = (const float*)(ws + WS_GATES);
  unsigned char* Kl = smem; unsigned char* Ql = smem + 17408; unsigned char* Vl = smem + 34816;
  float* KK = (float*)(smem + 51200); float* QKm = (float*)(smem + 67584);
  float* Am = (float*)(smem + 83968);
  float* gcs = (float*)(smem + 116736);
  u16* Xs = (u16*)(smem + 51200);
  unsigned char* opnd = ws + WS_DNOP + (long)item * 2 * DNOP_BYTES;
  const long tok0 = (long)ch * 64;
  for (int e = tid; e < 3072; e += 512) {
    const int which = e >> 10, q = e & 1023, row = q >> 4, c8 = q & 15;
    const u32x4 v = *(const u32x4*)(dnp + (tok0 + row) * 1536 + which * 512 + hd * 128 + c8 * 8);
    unsigned char* dst = (which == 0) ? (Ql + row * 272) : (which == 1) ? (Kl + row * 272) : (Vl + row * 256);
    *(u32x4*)(dst + c8 * 16) = v;
  }
  if (tid < 128) {
    const int dd = tid >> 6, i = tid & 63, ri = dd ? 63 - i : i;
    const float be = gates[(tok0 + ri) * 16 + dd * 4 + hd];
    float gv = gates[(tok0 + ri) * 16 + 8 + dd * 4 + hd];
#pragma unroll
    for (int o = 1; o < 64; o <<= 1) { const float t = __shfl_up(gv, o); if (i >= o) gv += t; }
    gcs[dd * 64 + i] = gv; gcs[128 + dd * 64 + i] = be; gcs[256 + dd * 64 + i] = be * __expf(gv);
  }
  __syncthreads();
  {
    const int which = w >> 2, mt = w & 3;
    const unsigned char* Asrc = which ? Ql : Kl;
    f32x4 a4[4];
#pragma unroll
    for (int n = 0; n < 4; ++n) a4[n] = (f32x4){0.f, 0.f, 0.f, 0.f};
#pragma unroll
    for (int kk = 0; kk < 4; ++kk) {
      const bf16x8 af = *(const bf16x8*)(Asrc + (mt * 16 + c16) * 272 + (kk * 4 + g) * 16);
#pragma unroll
      for (int n = 0; n < 4; ++n) {
        const bf16x8 bfv = *(const bf16x8*)(Kl + (n * 16 + c16) * 272 + (kk * 4 + g) * 16);
        a4[n] = mfma16(af, bfv, a4[n]);
      }
    }
    float* dst = which ? QKm : KK;
#pragma unroll
    for (int n = 0; n < 4; ++n)
#pragma unroll
      for (int j = 0; j < 4; ++j) dst[(mt * 16 + g * 4 + j) * 64 + n * 16 + c16] = a4[n][j];
  }
  __syncthreads();
  {
    const float* gc = gcs + dir * 64; const float* be = gcs + 128 + dir * 64;
    u16* qkout = (u16*)(opnd + dir * DNOP_BYTES + OP_QK);
    for (int e = t8; e < 2048; e += 256) {
      const int i = e >> 5, j = (e & 31) * 2;
      const int ri = dir ? 63 - i : i, rj = dir ? 63 - j : j, rj1 = dir ? 62 - j : j + 1;
      const float gi = gc[i];
      const float d0 = __expf(gi - gc[j]), d1 = __expf(gi - gc[j + 1]);
      const float bi = be[i];
      Am[(dir * 64 + i) * 64 + j] = (j < i) ? bi * KK[ri * 64 + rj] * d0 : 0.f;
      Am[(dir * 64 + i) * 64 + j + 1] = (j + 1 < i) ? bi * KK[ri * 64 + rj1] * d1 : 0.f;
      const float q0 = (j <= i) ? QKm[ri * 64 + rj] * d0 : 0.f, q1 = (j + 1 <= i) ? QKm[ri * 64 + rj1] * d1 : 0.f;
      *(unsigned*)(qkout + i * 64 + j) = pk2(q0, q1);
    }
  }
  __syncthreads();
  {
    const bool isu = t8 < 128;
    const unsigned char* src = isu ? (Vl + t8 * 2) : (Kl + (t8 - 128) * 2);
    const int sstr = isu ? 256 : 272;
    const float* scl = gcs + (isu ? 128 : 256) + dir * 64;
    const float* Ad = Am + dir * 4096;
    float X[64];
#pragma unroll
    for (int i = 0; i < 64; ++i) {
      const int ri = dir ? 63 - i : i;
      float a = bf2f(*(const u16*)(src + ri * sstr)) * scl[i];
#pragma unroll
      for (int j4 = 0; j4 < (i + 3) / 4; ++j4) {
        const f32x4 av = *(const f32x4*)(Ad + i * 64 + j4 * 4);
        if (4 * j4 + 0 < i) a -= av.x * X[4 * j4 + 0];
        if (4 * j4 + 1 < i) a -= av.y * X[4 * j4 + 1];
        if (4 * j4 + 2 < i) a -= av.z * X[4 * j4 + 2];
        if (4 * j4 + 3 < i) a -= av.w * X[4 * j4 + 3];
      }
      X[i] = a;
    }
    if (isu) {
      u32x4* dst = (u32x4*)(opnd + dir * DNOP_BYTES + OP_UT + t8 * 128);
#pragma unroll
      for (int q = 0; q < 8; ++q) { u32x4 o = {pk2(X[8 * q], X[8 * q + 1]), pk2(X[8 * q + 2], X[8 * q + 3]), pk2(X[8 * q + 4], X[8 * q + 5]), pk2(X[8 * q + 6], X[8 * q + 7])}; dst[q] = o; }
    } else {
      u16* xd = Xs + dir * 8192 + (t8 - 128);
#pragma unroll
      for (int i = 0; i < 64; ++i) xd[i * 128] = f2bf(-X[i]);
    }
  }
  __syncthreads();
  {
    for (int e = tid; e < 2048; e += 512) {
      const int dd = e >> 10, q = e & 1023;
      *(u32x4*)(opnd + dd * DNOP_BYTES + OP_WN + q * 16) = *(const u32x4*)((const unsigned char*)Xs + dd * 16384 + q * 16);
    }
    for (int e = tid; e < 2048; e += 512) {
      const int dd = e >> 10, q = e & 1023, i = q >> 4, c8 = q & 15, ri = dd ? 63 - i : i;
      const float sc = __expf(gcs[dd * 64 + i]);
      const u32x4 v = *(const u32x4*)(Ql + ri * 272 + c8 * 16);
      u32x4 o = {pk2(bflo(v.x) * sc, bfhi(v.x) * sc), pk2(bflo(v.y) * sc, bfhi(v.y) * sc), pk2(bflo(v.z) * sc, bfhi(v.z) * sc), pk2(bflo(v.w) * sc, bfhi(v.w) * sc)};
      *(u32x4*)(opnd + dd * DNOP_BYTES + OP_QD + q * 16) = o;
    }
    {
      const int dk = t8 & 127, half = t8 >> 7;
      const float gl = gcs[dir * 64 + 63];
      u32x4* dst = (u32x4*)(opnd + dir * DNOP_BYTES + OP_KDT + dk * 128 + half * 64);
#pragma unroll
      for (int q = 0; q < 4; ++q) {
        float v[8];
#pragma unroll
        for (int jj = 0; jj < 8; ++jj) {
          const int i = half * 32 + q * 8 + jj, ri = dir ? 63 - i : i;
          v[jj] = bf2f(*(const u16*)(Kl + ri * 272 + dk * 2)) * __expf(gl - gcs[dir * 64 + i]);
        }
        u32x4 o = {pk2(v[0], v[1]), pk2(v[2], v[3]), pk2(v[4], v[5]), pk2(v[6], v[7])};
        dst[q] = o;
      }
      if (t8 == 0) ((float*)(ws + WS_EGL))[item * 2 + dir] = __expf(gl);
    }
  }
  __syncthreads();
}

DI void scan_chain(int grp, unsigned char* ws, unsigned char* smem, int chain) {
  const int tidx = opaque_tid();
  const int L = (grp == 0) ? 16384 : 2048, nc = L >> 6;
  const int dir = chain & 1, hd = (chain >> 1) & 3, sq = chain >> 3;
  const int tid = tidx, lane = tid & 63, w = tid >> 6, c16 = lane & 15, g = lane >> 4;
  const int chunk0 = sq * nc;
  const float* egl = (const float*)(ws + WS_EGL);
  u16* obuf = (u16*)(ws + WS_OF) + (long)dir * TG * 512;
  int ldsoff[9]; int goff[9];
#pragma unroll
  for (int i = 0; i < 9; ++i) {
    const int q = tid + 512 * i;
    goff[i] = q * 16;
    int lo;
    if (q < 2048) { const int a = q >> 10, qq = q & 1023; lo = a * 17408 + (qq >> 4) * 272 + (qq & 15) * 16; }
    else if (q < 2560) { const int qq = q - 2048; lo = 34816 + (qq >> 3) * 144 + (qq & 7) * 16; }
    else if (q < 3584) { const int qq = q - 2560; lo = 44032 + (qq >> 3) * 144 + (qq & 7) * 16; }
    else { const int qq = q - 3584; lo = 62464 + (qq >> 3) * 144 + (qq & 7) * 16; }
    ldsoff[i] = lo;
  }
  f32x4 S[8];
#pragma unroll
  for (int t = 0; t < 8; ++t) S[t] = (f32x4){0.f, 0.f, 0.f, 0.f};
  u32x4 pre[9];
  {
    const int chk = chunk0 + (dir ? nc - 1 : 0);
    const unsigned char* src = ws + WS_DNOP + ((long)(chk * 4 + hd) * 2 + dir) * DNOP_BYTES;
#pragma unroll
    for (int i = 0; i < 9; ++i) pre[i] = *(const u32x4*)(src + goff[i]);
  }
  __syncthreads();
#pragma unroll
  for (int i = 0; i < 9; ++i) *(u32x4*)(smem + ldsoff[i]) = pre[i];
  __syncthreads();
  for (int m = 0; m < nc; ++m) {
    const int chk = chunk0 + (dir ? nc - 1 - m : m);
    const float eg = egl[(chk * 4 + hd) * 2 + dir];
    if (m + 1 < nc) {
      const int chn = chunk0 + (dir ? nc - 2 - m : m + 1);
      const unsigned char* src = ws + WS_DNOP + ((long)(chn * 4 + hd) * 2 + dir) * DNOP_BYTES;
#pragma unroll
      for (int i = 0; i < 9; ++i) pre[i] = *(const u32x4*)(src + goff[i]);
    }
    const unsigned char* B = smem + (m & 1) * 80896;
    bf16x8 sb[4];
#pragma unroll
    for (int kb = 0; kb < 4; ++kb) {
      u32x4 u = {pk2(S[2 * kb].x, S[2 * kb].y), pk2(S[2 * kb].z, S[2 * kb].w), pk2(S[2 * kb + 1].x, S[2 * kb + 1].y), pk2(S[2 * kb + 1].z, S[2 * kb + 1].w)};
      sb[kb] = __builtin_bit_cast(bf16x8, u);
    }
    f32x4 va[4], oa[4];
#pragma unroll
    for (int mt = 0; mt < 4; ++mt) {
      const u32x2 uu = *(const u32x2*)(B + 62464 + (16 * w + c16) * 144 + (mt * 16 + g * 4) * 2);
      va[mt] = (f32x4){bflo(uu.x), bfhi(uu.x), bflo(uu.y), bfhi(uu.y)};
      oa[mt] = (f32x4){0.f, 0.f, 0.f, 0.f};
    }
#pragma unroll
    for (int mt = 0; mt < 4; ++mt)
#pragma unroll
      for (int kb = 0; kb < 4; ++kb) {
        const unsigned char* ap = B + (mt * 16 + c16) * 272 + (kb * 32 + g * 4) * 2;
        const u32x2 a0 = *(const u32x2*)ap, a1 = *(const u32x2*)(ap + 32);
        u32x4 au = {a0.x, a0.y, a1.x, a1.y};
        va[mt] = mfma16(__builtin_bit_cast(bf16x8, au), sb[kb], va[mt]);
        const u32x2 q0 = *(const u32x2*)(ap + 17408), q1 = *(const u32x2*)(ap + 17408 + 32);
        u32x4 qu = {q0.x, q0.y, q1.x, q1.y};
        oa[mt] = mfma16(__builtin_bit_cast(bf16x8, qu), sb[kb], oa[mt]);
      }
    bf16x8 vb[2];
#pragma unroll
    for (int cb = 0; cb < 2; ++cb) {
      u32x4 u = {pk2(va[2 * cb].x, va[2 * cb].y), pk2(va[2 * cb].z, va[2 * cb].w), pk2(va[2 * cb + 1].x, va[2 * cb + 1].y), pk2(va[2 * cb + 1].z, va[2 * cb + 1].w)};
      vb[cb] = __builtin_bit_cast(bf16x8, u);
    }
#pragma unroll
    for (int mt = 0; mt < 4; ++mt)
#pragma unroll
      for (int cb = 0; cb < 2; ++cb) {
        const unsigned char* ap = B + 34816 + (mt * 16 + c16) * 144 + (cb * 32 + g * 4) * 2;
        const u32x2 a0 = *(const u32x2*)ap, a1 = *(const u32x2*)(ap + 32);
        u32x4 au = {a0.x, a0.y, a1.x, a1.y};
        oa[mt] = mfma16(__builtin_bit_cast(bf16x8, au), vb[cb], oa[mt]);
      }
#pragma unroll
    for (int t = 0; t < 8; ++t) {
      f32x4 s = {S[t].x * eg, S[t].y * eg, S[t].z * eg, S[t].w * eg};
#pragma unroll
      for (int cb = 0; cb < 2; ++cb) {
        const unsigned char* ap = B + 44032 + (t * 16 + c16) * 144 + (cb * 32 + g * 4) * 2;
        const u32x2 a0 = *(const u32x2*)ap, a1 = *(const u32x2*)(ap + 32);
        u32x4 au = {a0.x, a0.y, a1.x, a1.y};
        s = mfma16(__builtin_bit_cast(bf16x8, au), vb[cb], s);
      }
      S[t] = s;
    }
#pragma unroll
    for (int mt = 0; mt < 4; ++mt)
#pragma unroll
      for (int j = 0; j < 4; ++j) {
        const int i = mt * 16 + g * 4 + j;
        const long tok = (long)chk * 64 + (dir ? 63 - i : i);
        obuf[tok * 512 + hd * 128 + 16 * w + c16] = f2bf(oa[mt][j]);
      }
    if (m + 1 < nc) {
      unsigned char* nb = smem + ((m + 1) & 1) * 80896;
#pragma unroll
      for (int i = 0; i < 9; ++i) *(u32x4*)(nb + ldsoff[i]) = pre[i];
    }
    __syncthreads();
  }
}

DI void phase_merge(const Params& p, unsigned char* ws) {
  const int tidx = opaque_tid();
  const int lane = tidx & 63;
  const int gw = blockIdx.x * 8 + (tidx >> 6), NW = gridDim.x * 8;
  const u16* attp = (const u16*)(ws + WS_ATTP); const float* lse = (const float*)(ws + WS_LSE);
  const u16* of = (const u16*)(ws + WS_OF); const u16* proj = (const u16*)(ws + WS_PROJ);
  u16* mix = (u16*)(ws + WS_NBUF);
  f32x4 gn0 = *(const f32x4*)(p.out_norm + (lane & 15) * 8), gn1 = *(const f32x4*)(p.out_norm + (lane & 15) * 8 + 4);
  for (int t = gw; t < TG; t += NW) {
    {
      const int h = lane >> 3;
      const float l0 = lse[((long)0 * TG + t) * 8 + h], l1 = lse[((long)1 * TG + t) * 8 + h], l2 = lse[((long)2 * TG + t) * 8 + h];
      const float mx = fmaxf(l0, fmaxf(l1, l2));
      float w0 = __expf(l0 - mx), w1 = __expf(l1 - mx), w2 = __expf(l2 - mx);
      const float inv = 1.f / (w0 + w1 + w2); w0 *= inv; w1 *= inv; w2 *= inv;
      const u32x4 a = *(const u32x4*)(attp + ((long)0 * TG + t) * 512 + lane * 8);
      const u32x4 b = *(const u32x4*)(attp + ((long)1 * TG + t) * 512 + lane * 8);
      const u32x4 c = *(const u32x4*)(attp + ((long)2 * TG + t) * 512 + lane * 8);
      u32x4 o;
      o.x = pk2(w0 * bflo(a.x) + w1 * bflo(b.x) + w2 * bflo(c.x), w0 * bfhi(a.x) + w1 * bfhi(b.x) + w2 * bfhi(c.x));
      o.y = pk2(w0 * bflo(a.y) + w1 * bflo(b.y) + w2 * bflo(c.y), w0 * bfhi(a.y) + w1 * bfhi(b.y) + w2 * bfhi(c.y));
      o.z = pk2(w0 * bflo(a.z) + w1 * bflo(b.z) + w2 * bflo(c.z), w0 * bfhi(a.z) + w1 * bfhi(b.z) + w2 * bfhi(c.z));
      o.w = pk2(w0 * bflo(a.w) + w1 * bflo(b.w) + w2 * bflo(c.w), w0 * bfhi(a.w) + w1 * bfhi(b.w) + w2 * bfhi(c.w));
      *(u32x4*)(mix + (long)t * 1024 + lane * 8) = o;
    }
    {
      const u32x4 a = *(const u32x4*)(of + (long)t * 512 + lane * 8);
      const u32x4 b = *(const u32x4*)(of + ((long)TG + t) * 512 + lane * 8);
      const u32x4 gg = *(const u32x4*)(proj + (long)t * NPROJ + 3072 + lane * 8);
      float o[8] = {bflo(a.x) + bflo(b.x), bfhi(a.x) + bfhi(b.x), bflo(a.y) + bflo(b.y), bfhi(a.y) + bfhi(b.y),
                    bflo(a.z) + bflo(b.z), bfhi(a.z) + bfhi(b.z), bflo(a.w) + bflo(b.w), bfhi(a.w) + bfhi(b.w)};
      float ss = 0.f;
#pragma unroll
      for (int i = 0; i < 8; ++i) ss += o[i] * o[i];
      ss += __shfl_xor(ss, 1); ss += __shfl_xor(ss, 2); ss += __shfl_xor(ss, 4); ss += __shfl_xor(ss, 8);
      const float rs = rsqrtf(ss * (1.f / 128.f) + 1e-6f);
      const float gv[8] = {bflo(gg.x), bfhi(gg.x), bflo(gg.y), bfhi(gg.y), bflo(gg.z), bfhi(gg.z), bflo(gg.w), bfhi(gg.w)};
      const float gn[8] = {gn0.x, gn0.y, gn0.z, gn0.w, gn1.x, gn1.y, gn1.z, gn1.w};
      float y[8];
#pragma unroll
      for (int i = 0; i < 8; ++i) y[i] = o[i] * rs * gn[i] * siluf_(gv[i]);
      u32x4 ov = {pk2(y[0], y[1]), pk2(y[2], y[3]), pk2(y[4], y[5]), pk2(y[6], y[7])};
      *(u32x4*)(mix + (long)t * 1024 + 512 + lane * 8) = ov;
    }
  }
}

extern __shared__ __attribute__((aligned(16))) unsigned char smem[];

__global__ void __launch_bounds__(512) mk_fwd(Params p) {
  cg::grid_group grid = cg::this_grid();
  unsigned char* ws = p.ws;
  {
    const long gtid = (long)blockIdx.x * 512 + opaque_tid(), nthr = (long)gridDim.x * 512;
    conv_weight(p.w_in, 3600, 1024, NPROJ, (u16*)(ws + WS_WIN), 0, nullptr, gtid, nthr);
    conv_weight(p.w_out, 1024, 1024, 1024, (u16*)(ws + WS_WOUT), 0, nullptr, gtid, nthr);
    conv_weight(p.w_up, 5632, 1024, 5632, (u16*)(ws + WS_WUP), 1, p.norm2, gtid, nthr);
    conv_weight(p.w_down, 1024, 2816, 1024, (u16*)(ws + WS_WDOWN), 0, nullptr, gtid, nthr);
  }
#pragma unroll 1
  for (int grp = 0; grp < 3; ++grp) {
    const float* xg = (grp == 0) ? p.xp : (p.xs + (long)(grp - 1) * TG * 1024);
    float* outg = p.out + (long)grp * TG * 1024;
    phase_norm(p, xg, ws, smem);
    grid.sync();
    gemm_phase<1>(p, grp, ws, smem, xg, outg);
    grid.sync();
    phase_prep(p, grp, ws);
    grid.sync();
    {
      for (int it = blockIdx.x; it < 8192; it += gridDim.x) {
        if ((it & 3) == 3) dnlocal_item(ws, smem, it >> 2);
        else attn_item(grp, ws, smem, (it >> 2) * 3 + (it & 3));
      }
    }
    grid.sync();
    {
      const int nchains = (grp == 0) ? 16 : 128;
      for (int c = blockIdx.x; c < nchains; c += gridDim.x) scan_chain(grp, ws, smem, c);
    }
    grid.sync();
    phase_merge(p, ws);
    grid.sync();
    gemm_phase<2>(p, grp, ws, smem, xg, outg);
    grid.sync();
    gemm_phase<3>(p, grp, ws, smem, xg, outg);
    grid.sync();
    gemm_phase<4>(p, grp, ws, smem, xg, outg);
    if (grp < 2) grid.sync();
  }
}

extern "C" void kernel_launch(void* const* d_in, const int* in_sizes, int n_in, void* d_out, int out_size,
                              void* d_ws, size_t ws_size, hipStream_t stream) {
  static int grid_blocks = 0;
  if (!grid_blocks) {
    int dev = 0, cus = 0, per_cu = 0;
    (void)hipGetDevice(&dev);
    (void)hipDeviceGetAttribute(&cus, hipDeviceAttributeMultiprocessorCount, dev);
    (void)hipFuncSetAttribute((const void*)mk_fwd, hipFuncAttributeMaxDynamicSharedMemorySize, LDS_BYTES);
    (void)hipOccupancyMaxActiveBlocksPerMultiprocessor(&per_cu, (const void*)mk_fwd, 512, LDS_BYTES);
    if (per_cu < 1) per_cu = 1;
    grid_blocks = cus * per_cu;
    if (ws_size < 883 * MiB) fprintf(stderr, "workspace too small: %zu\n", ws_size);
  }
  Params p{};
  p.xp = (const float*)d_in[0]; p.xs = (const float*)d_in[1]; p.norm1 = (const float*)d_in[2]; p.w_in = (const float*)d_in[3];
  p.qn = (const float*)d_in[4]; p.kn = (const float*)d_in[5]; p.dn_conv_w = (const float*)d_in[6]; p.a_log = (const float*)d_in[7];
  p.dt_bias = (const float*)d_in[8]; p.out_norm = (const float*)d_in[9]; p.w_out = (const float*)d_in[10]; p.norm2 = (const float*)d_in[11];
  p.w_up = (const float*)d_in[12]; p.ffn_cw = (const float*)d_in[13]; p.ffn_cb = (const float*)d_in[14]; p.w_down = (const float*)d_in[15];
  p.out = (float*)d_out; p.ws = (unsigned char*)d_ws;
  void* args[] = {&p};
  hipError_t e = hipLaunchCooperativeKernel((void*)mk_fwd, dim3(grid_blocks), dim3(512), args, LDS_BYTES, stream);
  if (e != hipSuccess) fprintf(stderr, "cooperative launch failed: %s (grid %d)\n", hipGetErrorString(e), grid_blocks);
}
```

```cpp
#include <hip/hip_runtime.h>
#include <hip/hip_cooperative_groups.h>
#include <cstdio>
namespace cg = cooperative_groups;

typedef unsigned short u16;
typedef __attribute__((ext_vector_type(8))) short bf16x8;
typedef __attribute__((ext_vector_type(4))) float f32x4;
typedef __attribute__((ext_vector_type(4))) unsigned u32x4;
typedef __attribute__((ext_vector_type(2))) unsigned u32x2;
typedef __bf16 bf2_t __attribute__((ext_vector_type(2)));
typedef float f2_t __attribute__((ext_vector_type(2)));
#define DI __device__ __forceinline__

constexpr int TG = 32768;
constexpr int NPROJ = 3584;
constexpr size_t MiB = 1u << 20;
constexpr size_t WS_WIN = 0, WS_WOUT = 7 * MiB, WS_WUP = 9 * MiB, WS_WDOWN = 20 * MiB;
constexpr size_t WS_GATES = 27 * MiB, WS_LSE = 29 * MiB, WS_ROWSQ = 32 * MiB, WS_EGL = 34 * MiB;
constexpr size_t WS_NBUF = 35 * MiB;
constexpr size_t WS_PROJ = 99 * MiB;
constexpr size_t WS_HB = WS_PROJ, WS_ACT = WS_PROJ + 64 * MiB;
constexpr size_t WS_DNP = 339 * MiB, WS_ATTP = 435 * MiB, WS_DNOP = 531 * MiB, WS_OF = 819 * MiB;
constexpr int DNOP_BYTES = 73728;
constexpr int OP_WN = 0, OP_QD = 16384, OP_QK = 32768, OP_KDT = 40960, OP_UT = 57344;
constexpr int LDS_BYTES = 163840;
#ifndef PROBE_MASK
#define PROBE_MASK 0
#endif
#define REP(bit) for (int rep_ = 0; rep_ < (((PROBE_MASK) >> (bit)) & 1) + 1; ++rep_)

struct Params {
  const float *xp, *xs, *norm1, *w_in, *qn, *kn, *dn_conv_w, *a_log, *dt_bias, *out_norm, *w_out, *norm2, *w_up, *ffn_cw, *ffn_cb, *w_down;
  float* out; unsigned char* ws;
};

DI float bf2f(unsigned v) { return __uint_as_float(v << 16); }
DI float bflo(unsigned v) { return __uint_as_float(v << 16); }
DI float bfhi(unsigned v) { return __uint_as_float(v & 0xffff0000u); }
DI unsigned pk2(float lo, float hi) { f2_t v = {lo, hi}; bf2_t r = __builtin_convertvector(v, bf2_t); return __builtin_bit_cast(unsigned, r); }
DI u16 f2bf(float x) { return (u16)(pk2(x, 0.f) & 0xffffu); }
DI int opaque_tid() { int t = threadIdx.x; asm volatile("" : "+v"(t)); return t; }
DI float wave_sum(float v) {
#pragma unroll
  for (int o = 32; o > 0; o >>= 1) v += __shfl_xor(v, o);
  return v;
}
DI f32x4 mfma16(bf16x8 a, bf16x8 b, f32x4 c) { return __builtin_amdgcn_mfma_f32_16x16x32_bf16(a, b, c, 0, 0, 0); }
#define LAS __attribute__((address_space(3)))
DI void glds16(const void* g, unsigned ldsoff) {
  __builtin_amdgcn_global_load_lds((const __attribute__((address_space(1))) void*)g, (LAS void*)(unsigned long)ldsoff, 16, 0, 0);
}
DI int kperm(int k) { return (k & ~31) | (((k >> 2) & 3) << 3) | (((k >> 4) & 1) << 2) | (k & 3); }
DI float sigmoidf_(float x) { return 1.f / (1.f + __expf(-x)); }
DI float siluf_(float x) { return x / (1.f + __expf(-x)); }

DI void conv_weight(const float* __restrict__ W, int Nsrc, int K, int Nout, u16* __restrict__ WT, int mode, const float* __restrict__ scale,
                    long gtid, long nthr) {
  const int kgn = K >> 3;
  for (long idx = gtid; idx < (long)Nout * kgn; idx += nthr) {
    const int n = (int)(idx % Nout), kg = (int)(idx / Nout);
    int src = n;
    if (mode == 1) { const int pn = n >> 8, ct = n & 255; src = (ct < 128) ? (pn * 128 + ct) : (2816 + pn * 128 + ct - 128); }
    float v[8];
#pragma unroll
    for (int j = 0; j < 8; ++j) { const int k = kg * 8 + j; const float s = scale ? scale[k] : 1.f; v[j] = W[(long)k * Nsrc + src] * s; }
    u32x4 o = {pk2(v[0], v[1]), pk2(v[2], v[3]), pk2(v[4], v[5]), pk2(v[6], v[7])};
    *(u32x4*)(WT + (long)n * K + kg * 8) = o;
  }
}

DI void phase_norm(const Params& p, const float* __restrict__ xg, unsigned char* ws, unsigned char* smem) {
  const int tidx = opaque_tid();
  f32x4* gw4 = (f32x4*)smem;
  float* gwf = (float*)smem;
  for (int e = tidx; e < 1024 * 16; e += 512) {
    const int k = e >> 4, jg = e & 15;
    const int ln = (k >> 2) & 63, j = k >> 8, ee = k & 3, q = jg >> 2, cmp = jg & 3;
    gwf[((((j * 4 + ee) * 4 + q) * 64 + ln) << 2) + cmp] = p.w_in[(long)k * 3600 + 3584 + jg];
  }
  __syncthreads();
  const int wave = tidx >> 6, lane = tidx & 63;
  u16* nbuf = (u16*)(ws + WS_NBUF); float* gates = (float*)(ws + WS_GATES);
  for (int row = blockIdx.x * 8 + wave; row < TG; row += gridDim.x * 8) {
    const f32x4* xr = (const f32x4*)(xg + (long)row * 1024);
    f32x4 v[4]; float ss = 0.f;
#pragma unroll
    for (int j = 0; j < 4; ++j) { v[j] = xr[lane + 64 * j]; ss += v[j].x * v[j].x + v[j].y * v[j].y + v[j].z * v[j].z + v[j].w * v[j].w; }
    ss = wave_sum(ss);
    const float rs = rsqrtf(ss * (1.f / 1024.f) + 1e-6f);
    float ga[16];
#pragma unroll
    for (int i = 0; i < 16; ++i) ga[i] = 0.f;
#pragma unroll
    for (int j = 0; j < 4; ++j) {
      const f32x4 nw = ((const f32x4*)p.norm1)[lane + 64 * j];
      v[j].x *= rs * nw.x; v[j].y *= rs * nw.y; v[j].z *= rs * nw.z; v[j].w *= rs * nw.w;
      u32x2 o = {pk2(v[j].x, v[j].y), pk2(v[j].z, v[j].w)};
      *(u32x2*)(nbuf + (long)row * 1024 + 4 * (lane + 64 * j)) = o;
#pragma unroll
      for (int e = 0; e < 4; ++e) {
        const float xv = v[j][e];
#pragma unroll
        for (int q = 0; q < 4; ++q) {
          const f32x4 w4 = gw4[((j * 4 + e) * 4 + q) * 64 + lane];
          ga[4 * q + 0] += xv * w4.x; ga[4 * q + 1] += xv * w4.y; ga[4 * q + 2] += xv * w4.z; ga[4 * q + 3] += xv * w4.w;
        }
        __builtin_amdgcn_sched_barrier(0);
      }
    }
    float r = 0.f;
#pragma unroll
    for (int i = 0; i < 16; ++i) { const float s = wave_sum(ga[i]); r = (lane == i) ? s : r; }
    if (lane < 16) {
      float o;
      if (lane < 8) o = sigmoidf_(r);
      else { const int jj = lane - 8; const float z = r + p.dt_bias[jj]; const float ez = __expf(z); const float sp = (z > 20.f) ? z : ((ez < 0.02f) ? ez * (1.f - ez * (0.5f - ez * (1.f / 3.f))) : __logf(1.f + ez)); o = -__expf(p.a_log[jj]) * sp; }
      gates[(long)row * 16 + lane] = o;
    }
  }
}

template <int MODE>
DI void gemm_phase(const Params& p, int grp, unsigned char* ws, unsigned char* smem, const float* __restrict__ xg, float* __restrict__ outg) {
  const int tidx = opaque_tid();
  const u16* A; const u16* Bt; int K, nM, nN, lda;
  if (MODE == 1) { A = (const u16*)(ws + WS_NBUF); Bt = (const u16*)(ws + WS_WIN); K = 1024; nM = TG / 256; nN = NPROJ / 256; lda = 1024; }
  else if (MODE == 2) { A = (const u16*)(ws + WS_NBUF); Bt = (const u16*)(ws + WS_WOUT); K = 1024; nM = TG / 256; nN = 4; lda = 1024; }
  else if (MODE == 3) { A = (const u16*)(ws + WS_HB); Bt = (const u16*)(ws + WS_WUP); K = 1024; nM = (TG + 253) / 254; nN = 22; lda = 1024; }
  else { A = (const u16*)(ws + WS_ACT); Bt = (const u16*)(ws + WS_WDOWN); K = 2816; nM = TG / 256; nN = 4; lda = 2816; }
  const int L = (grp == 0) ? 16384 : 2048;
  const int tid = tidx, lane = tid & 63, wid = tid >> 6, wr = wid >> 2, wc = wid & 3, c16 = lane & 15, g = lane >> 4;
  const int ntiles = nM * nN, nk = K >> 6;
  const int G = gridDim.x, b = blockIdx.x;
  const int bperm = ((G & 7) == 0) ? ((b & 7) * (G >> 3) + (b >> 3)) : b;
  const int r0 = tid >> 3, schunk = (tid & 7) ^ ((tid >> 3) & 7);
  const int sw = c16 & 7;
  const int aoff = (wr * 128 + c16) * 128, boff = 32768 + (wc * 64 + c16) * 128;
  for (int T = bperm; T < ntiles; T += G) {
    const int sg = T / (8 * nN), fm = sg * 8, gsz = (nM - fm) < 8 ? (nM - fm) : 8, idx = T - sg * 8 * nN;
    const int pm = fm + (idx % gsz), pn = idx / gsz;
    const int rowbase = (MODE == 3) ? (pm * 254 - 1) : (pm * 256);
    int ao[4];
#pragma unroll
    for (int i = 0; i < 4; ++i) {
      int ar = rowbase + r0 + 64 * i;
      if (MODE == 3) ar = ar < 0 ? 0 : (ar > TG - 1 ? TG - 1 : ar);
      ao[i] = ar * lda + schunk * 8;
    }
    const u16* bp0 = Bt + (long)(pn * 256 + r0) * K + schunk * 8;
    f32x4 acc[8][4];
#pragma unroll
    for (int m = 0; m < 8; ++m)
#pragma unroll
      for (int n = 0; n < 4; ++n) acc[m][n] = (f32x4){0.f, 0.f, 0.f, 0.f};
    __syncthreads();
#pragma unroll
    for (int i = 0; i < 4; ++i) { glds16(A + ao[i], tid * 16 + i * 8192); glds16(bp0 + i * 64 * K, 32768 + tid * 16 + i * 8192); }
    __syncthreads();
    for (int kt = 0; kt < nk; ++kt) {
      if (kt + 1 < nk) {
        const unsigned nb = ((kt + 1) & 1) * 65536 + tid * 16;
#pragma unroll
        for (int i = 0; i < 4; ++i) { glds16(A + ao[i] + (kt + 1) * 64, nb + i * 8192); glds16(bp0 + i * 64 * K + (kt + 1) * 64, nb + 32768 + i * 8192); }
      }
      const unsigned char* buf = smem + (kt & 1) * 65536;
#pragma unroll
      for (int kk = 0; kk < 2; ++kk) {
        bf16x8 bfr[4];
        const int co = ((kk * 4 + g) ^ sw) << 4;
#pragma unroll
        for (int n = 0; n < 4; ++n) bfr[n] = *(const bf16x8*)(buf + boff + n * 2048 + co);
#pragma unroll
        for (int mh = 0; mh < 2; ++mh) {
          bf16x8 af[4];
#pragma unroll
          for (int m = 0; m < 4; ++m) af[m] = *(const bf16x8*)(buf + aoff + (mh * 4 + m) * 2048 + co);
#pragma unroll
          for (int m = 0; m < 4; ++m)
#pragma unroll
            for (int n = 0; n < 4; ++n) acc[mh * 4 + m][n] = mfma16(bfr[n], af[m], acc[mh * 4 + m][n]);
        }
      }
      __syncthreads();
    }
    if (MODE == 1) {
      u16* proj = (u16*)(ws + WS_PROJ);
#pragma unroll
      for (int m = 0; m < 8; ++m) {
        const long row = pm * 256 + wr * 128 + m * 16 + c16;
#pragma unroll
        for (int n = 0; n < 4; ++n) {
          const int col = pn * 256 + wc * 64 + n * 16 + g * 4;
          u32x2 o = {pk2(acc[m][n].x, acc[m][n].y), pk2(acc[m][n].z, acc[m][n].w)};
          *(u32x2*)(proj + row * NPROJ + col) = o;
        }
      }
    } else if (MODE == 2) {
      u16* hb = (u16*)(ws + WS_HB); float* rowsq = (float*)(ws + WS_ROWSQ);
#pragma unroll
      for (int m = 0; m < 8; ++m) {
        const long row = pm * 256 + wr * 128 + m * 16 + c16;
        float s = 0.f;
#pragma unroll
        for (int n = 0; n < 4; ++n) {
          const int col = pn * 256 + wc * 64 + n * 16 + g * 4;
          const f32x4 xv = *(const f32x4*)(xg + row * 1024 + col);
          f32x4 h = {xv.x + acc[m][n].x, xv.y + acc[m][n].y, xv.z + acc[m][n].z, xv.w + acc[m][n].w};
          *(f32x4*)(outg + row * 1024 + col) = h;
          u32x2 o = {pk2(h.x, h.y), pk2(h.z, h.w)};
          *(u32x2*)(hb + row * 1024 + col) = o;
          s += h.x * h.x + h.y * h.y + h.z * h.z + h.w * h.w;
        }
        s += __shfl_xor(s, 16); s += __shfl_xor(s, 32);
        if (g == 0) rowsq[row * 16 + pn * 4 + wc] = s;
      }
    } else if (MODE == 4) {
#pragma unroll
      for (int m = 0; m < 8; ++m) {
        const long row = pm * 256 + wr * 128 + m * 16 + c16;
#pragma unroll
        for (int n = 0; n < 4; ++n) {
          const int col = pn * 256 + wc * 64 + n * 16 + g * 4;
          f32x4 h = *(const f32x4*)(outg + row * 1024 + col);
          h.x += acc[m][n].x; h.y += acc[m][n].y; h.z += acc[m][n].z; h.w += acc[m][n].w;
          *(f32x4*)(outg + row * 1024 + col) = h;
        }
      }
    } else {
      const float* rowsq = (const float*)(ws + WS_ROWSQ);
      u16* act = (u16*)(ws + WS_ACT);
#pragma unroll
      for (int m = 0; m < 8; ++m) {
        const int rl = wr * 128 + m * 16 + c16;
        int ar = rowbase + rl; ar = ar < 0 ? 0 : (ar > TG - 1 ? TG - 1 : ar);
        const f32x4* rq = (const f32x4*)(rowsq + (long)ar * 16);
        const f32x4 q0 = rq[0], q1 = rq[1], q2 = rq[2], q3 = rq[3];
        const float ssq = (q0.x + q0.y + q0.z + q0.w) + (q1.x + q1.y + q1.z + q1.w) + (q2.x + q2.y + q2.z + q2.w) + (q3.x + q3.y + q3.z + q3.w);
        const float rs2 = rsqrtf(ssq * (1.f / 1024.f) + 1e-6f);
#pragma unroll
        for (int n = 0; n < 4; ++n) {
          const int col = wc * 64 + n * 16 + g * 4;
          u32x2 o = {pk2(acc[m][n].x * rs2, acc[m][n].y * rs2), pk2(acc[m][n].z * rs2, acc[m][n].w * rs2)};
          *(u32x2*)(smem + rl * 520 + col * 2) = o;
        }
      }
      __syncthreads();
      {
        const int hp = tid & 63, rg = tid >> 6;
        const int hid = pn * 128 + 2 * hp;
        float cwg[3][2], cwu[3][2], cbg[2], cbu[2];
#pragma unroll
        for (int j = 0; j < 3; ++j) {
          cwg[j][0] = p.ffn_cw[j * 5632 + hid]; cwg[j][1] = p.ffn_cw[j * 5632 + hid + 1];
          cwu[j][0] = p.ffn_cw[j * 5632 + 2816 + hid]; cwu[j][1] = p.ffn_cw[j * 5632 + 2816 + hid + 1];
        }
        cbg[0] = p.ffn_cb[hid]; cbg[1] = p.ffn_cb[hid + 1]; cbu[0] = p.ffn_cb[2816 + hid]; cbu[1] = p.ffn_cb[2816 + hid + 1];
        const int i0 = rg * 32 < 1 ? 1 : rg * 32, i1 = (rg * 32 + 31) > 254 ? 254 : (rg * 32 + 31);
        unsigned gp = *(const unsigned*)(smem + (i0 - 1) * 520 + hp * 4), up = *(const unsigned*)(smem + (i0 - 1) * 520 + 256 + hp * 4);
        unsigned gc = *(const unsigned*)(smem + i0 * 520 + hp * 4), uc = *(const unsigned*)(smem + i0 * 520 + 256 + hp * 4);
        for (int i = i0; i <= i1; ++i) {
          const unsigned gn = *(const unsigned*)(smem + (i + 1) * 520 + hp * 4), un = *(const unsigned*)(smem + (i + 1) * 520 + 256 + hp * 4);
          const int lt = rowbase + i;
          if (lt < TG) {
            const int pos = lt & (L - 1);
            const float mp = (pos != 0) ? 1.f : 0.f, mn = (pos != L - 1) ? 1.f : 0.f;
            const float G0 = cwg[0][0] * bflo(gp) * mp + cwg[1][0] * bflo(gc) + cwg[2][0] * bflo(gn) * mn + cbg[0];
            const float G1 = cwg[0][1] * bfhi(gp) * mp + cwg[1][1] * bfhi(gc) + cwg[2][1] * bfhi(gn) * mn + cbg[1];
            const float U0 = cwu[0][0] * bflo(up) * mp + cwu[1][0] * bflo(uc) + cwu[2][0] * bflo(un) * mn + cbu[0];
            const float U1 = cwu[0][1] * bfhi(up) * mp + cwu[1][1] * bfhi(uc) + cwu[2][1] * bfhi(un) * mn + cbu[1];
            *(unsigned*)(act + (long)lt * 2816 + hid) = pk2(siluf_(G0) * U0, siluf_(G1) * U1);
          }
          gp = gc; up = uc; gc = gn; uc = un;
        }
      }
    }
  }
}

DI void phase_prep(const Params& p, int grp, unsigned char* ws) {
  const int tidx = opaque_tid();
  const int L = (grp == 0) ? 16384 : 2048;
  const int lane = tidx & 63;
  const int gw = blockIdx.x * 8 + (tidx >> 6), NW = gridDim.x * 8;
  u16* proj = (u16*)(ws + WS_PROJ);
  {
    const int i = lane & 15;
    const float f0 = exp2f(-(float)(2 * i) * (13.287712379549449f / 32.f)), f1 = exp2f(-(float)(2 * i + 1) * (13.287712379549449f / 32.f));
    for (int base = gw * 4; base < TG * 16; base += NW * 4) {
      const int u = base + (lane >> 4), t = u >> 4, hs = u & 15;
      u16* ptr = proj + (long)t * NPROJ + hs * 64;
      const unsigned elo = *(const unsigned*)(ptr + 2 * i), ehi = *(const unsigned*)(ptr + 32 + 2 * i);
      float x1a = bflo(elo), x1b = bfhi(elo), x2a = bflo(ehi), x2b = bfhi(ehi);
      float ss = x1a * x1a + x1b * x1b + x2a * x2a + x2b * x2b;
      ss += __shfl_xor(ss, 1); ss += __shfl_xor(ss, 2); ss += __shfl_xor(ss, 4); ss += __shfl_xor(ss, 8);
      const float rs = rsqrtf(ss * (1.f / 64.f) + 1e-6f);
      const float* gn = (hs < 8) ? p.qn : p.kn;
      const float sc = (hs < 8) ? 0.125f : 1.f;
      x1a *= rs * gn[2 * i]; x1b *= rs * gn[2 * i + 1]; x2a *= rs * gn[32 + 2 * i]; x2b *= rs * gn[33 + 2 * i];
      const float pos = (float)(t & (L - 1));
      float s0, c0, s1, c1;
      sincosf(pos * f0, &s0, &c0); sincosf(pos * f1, &s1, &c1);
      const float o1a = (x1a * c0 - x2a * s0) * sc, o2a = (x2a * c0 + x1a * s0) * sc;
      const float o1b = (x1b * c1 - x2b * s1) * sc, o2b = (x2b * c1 + x1b * s1) * sc;
      *(unsigned*)(ptr + 2 * i) = pk2(o1a, o1b); *(unsigned*)(ptr + 32 + 2 * i) = pk2(o2a, o2b);
    }
  }
  {
    u16* dnp = (u16*)(ws + WS_DNP);
    for (int unit = gw; unit < 12 * (TG / 64); unit += NW) {
      const int s = unit % 12, r = unit / 12, t0 = r * 64;
      const int c = s * 128 + 2 * lane;
      float w0[5], w1[5];
#pragma unroll
      for (int j = 0; j < 5; ++j) { w0[j] = p.dn_conv_w[j * 1536 + c]; w1[j] = p.dn_conv_w[j * 1536 + c + 1]; }
      const u16* src = proj + 1536 + c;
      const int pos0 = t0 & (L - 1);
      unsigned win[5];
      win[0] = (pos0 >= 2) ? *(const unsigned*)(src + (long)(t0 - 2) * NPROJ) : 0u;
      win[1] = (pos0 >= 1) ? *(const unsigned*)(src + (long)(t0 - 1) * NPROJ) : 0u;
      win[2] = *(const unsigned*)(src + (long)t0 * NPROJ);
      win[3] = *(const unsigned*)(src + (long)(t0 + 1) * NPROJ);
      const float qs = (s < 4) ? 0.08838834764831845f : 1.f;
      for (int tb = 0; tb < 64; tb += 8) {
        unsigned nw[8];
#pragma unroll
        for (int u = 0; u < 8; ++u) nw[u] = (pos0 + tb + u + 2 < L) ? *(const unsigned*)(src + (long)(t0 + tb + u + 2) * NPROJ) : 0u;
#pragma unroll
        for (int u = 0; u < 8; ++u) {
        const int t = t0 + tb + u;
        win[4] = nw[u];
        float a0 = 0.f, a1 = 0.f;
#pragma unroll
        for (int j = 0; j < 5; ++j) { a0 += w0[j] * bflo(win[j]); a1 += w1[j] * bfhi(win[j]); }
        a0 = siluf_(a0); a1 = siluf_(a1);
        if (s < 8) {
          const float ss = wave_sum(a0 * a0 + a1 * a1);
          const float rs = rsqrtf(ss + 1e-6f) * qs;
          a0 *= rs; a1 *= rs;
        }
        *(unsigned*)(dnp + (long)t * 1536 + c) = pk2(a0, a1);
#pragma unroll
        for (int j = 0; j < 4; ++j) win[j] = win[j + 1];
        }
      }
    }
  }
}

DI void attn_item(int grp, unsigned char* ws, unsigned char* smem, int item) {
  const int tidx = opaque_tid();
  const int L = (grp == 0) ? 16384 : 2048;
  const int pat = item >> 11, rem = item & 2047, h = rem & 7, bi = rem >> 3;
  const int dsh = pat * 2, d = 1 << dsh;
  const int st = bi >> dsh, r = bi & (d - 1), base = st * (128 << dsh), s0 = base & ~(L - 1);
  const int tid = tidx, lane = tid & 63, w = tid >> 6, c16 = lane & 15, g = lane >> 4;
  const u16* proj = (const u16*)(ws + WS_PROJ);
  unsigned char* Qs = smem; unsigned char* Ks = smem + 16384; u16* Vt = (u16*)(smem + 51200);
  for (int e = tid; e < 1024; e += 512) {
    const int row = e >> 3, ch = e & 7; const long lt = base + r + (row << dsh);
    const u32x4 v = *(const u32x4*)(proj + lt * NPROJ + h * 64 + ch * 8);
    *(u32x4*)(Qs + row * 128 + ((ch ^ (row & 7)) << 4)) = v;
  }
  for (int e = tid; e < 2048; e += 512) {
    const int row = e >> 3, ch = e & 7; const int lt = base + r + (row - 64) * d;
    const bool valid = (lt >= s0) && (lt < s0 + L);
    u32x4 kv = {0u, 0u, 0u, 0u}, vv = {0u, 0u, 0u, 0u};
    if (valid) { kv = *(const u32x4*)(proj + (long)lt * NPROJ + 512 + h * 64 + ch * 8); vv = *(const u32x4*)(proj + (long)lt * NPROJ + 1024 + h * 64 + ch * 8); }
    *(u32x4*)(Ks + row * 128 + ((ch ^ (row & 7)) << 4)) = kv;
    u16* vd = Vt + (ch * 8) * 280 + kperm(row);
    vd[0 * 280] = (u16)(vv.x & 0xffff); vd[1 * 280] = (u16)(vv.x >> 16); vd[2 * 280] = (u16)(vv.y & 0xffff); vd[3 * 280] = (u16)(vv.y >> 16);
    vd[4 * 280] = (u16)(vv.z & 0xffff); vd[5 * 280] = (u16)(vv.z >> 16); vd[6 * 280] = (u16)(vv.w & 0xffff); vd[7 * 280] = (u16)(vv.w >> 16);
  }
  __syncthreads();
  const int sw = c16 & 7, tb = w & ~1;
  bf16x8 qf[2];
#pragma unroll
  for (int kk = 0; kk < 2; ++kk) qf[kk] = *(const bf16x8*)(Qs + (16 * w + c16) * 128 + (((kk * 4 + g) ^ sw) << 4));
  f32x4 sc[10];
#pragma unroll
  for (int t = 0; t < 10; ++t) {
    f32x4 a = {0.f, 0.f, 0.f, 0.f};
#pragma unroll
    for (int kk = 0; kk < 2; ++kk) {
      const bf16x8 kf = *(const bf16x8*)(Ks + ((tb + t) * 16 + c16) * 128 + (((kk * 4 + g) ^ sw) << 4));
      a = mfma16(kf, qf[kk], a);
    }
    sc[t] = a;
  }
  const int qi = 16 * w + c16;
  float mx = -1e30f;
#pragma unroll
  for (int t = 0; t < 10; ++t)
#pragma unroll
    for (int j = 0; j < 4; ++j) {
      const int kj = (tb + t) * 16 + g * 4 + j - 64;
      const int lt = base + r + kj * d;
      const int df = qi - kj;
      const bool valid = (df <= 64) && (df >= -64) && (lt >= s0) && (lt < s0 + L);
      const float s = valid ? sc[t][j] : -1e30f;
      sc[t][j] = s; mx = fmaxf(mx, s);
    }
  mx = fmaxf(mx, __shfl_xor(mx, 16)); mx = fmaxf(mx, __shfl_xor(mx, 32));
  float den = 0.f;
#pragma unroll
  for (int t = 0; t < 10; ++t)
#pragma unroll
    for (int j = 0; j < 4; ++j) { const float pe = (sc[t][j] > -1e29f) ? __expf(sc[t][j] - mx) : 0.f; sc[t][j] = pe; den += pe; }
  den += __shfl_xor(den, 16); den += __shfl_xor(den, 32);
  f32x4 oa[4];
#pragma unroll
  for (int n = 0; n < 4; ++n) oa[n] = (f32x4){0.f, 0.f, 0.f, 0.f};
#pragma unroll
  for (int tp = 0; tp < 5; ++tp) {
    u32x4 pu = {pk2(sc[2 * tp].x, sc[2 * tp].y), pk2(sc[2 * tp].z, sc[2 * tp].w), pk2(sc[2 * tp + 1].x, sc[2 * tp + 1].y), pk2(sc[2 * tp + 1].z, sc[2 * tp + 1].w)};
    const bf16x8 pa = __builtin_bit_cast(bf16x8, pu);
#pragma unroll
    for (int n = 0; n < 4; ++n) {
      const u16* vp = Vt + (n * 16 + c16) * 280 + ((tb >> 1) + tp) * 32 + g * 8;
      oa[n] = mfma16(pa, *(const bf16x8*)vp, oa[n]);
    }
  }
  u16* attp = (u16*)(ws + WS_ATTP); float* lse = (float*)(ws + WS_LSE);
#pragma unroll
  for (int j = 0; j < 4; ++j) {
    const int qs = g * 4 + j;
    const float dj = __shfl(den, qs);
    const float inv = 1.f / dj;
    const long lt = base + r + ((16 * w + qs) << dsh);
    u16* dst = attp + ((long)pat * TG + lt) * 512 + h * 64 + c16;
#pragma unroll
    for (int n = 0; n < 4; ++n) dst[n * 16] = f2bf(oa[n][j] * inv);
  }
  if (g == 0) { const long lt = base + r + ((long)qi << dsh); lse[((long)pat * TG + lt) * 8 + h] = mx + __logf(den); }
  __syncthreads();
}

DI void dnlocal_item(unsigned char* ws, unsigned char* smem, int item) {
  const int tidx = opaque_tid();
  const int ch = item >> 2, hd = item & 3;
  const int tid = tidx, lane = tid & 63, w = tid >> 6, c16 = lane & 15, g = lane >> 4;
  const int dir = tid >> 8, t8 = tid & 255;
  const u16* dnp = (const u16*)(ws + WS_DNP); const float* gates = (const float*)(ws + WS_GATES);
  unsigned char* Kl = smem; unsigned char* Ql = smem + 17408; unsigned char* Vl = smem + 34816;
  float* KK = (float*)(smem + 51200); float* QKm = (float*)(smem + 67584);
  float* Am = (float*)(smem + 83968);
  float* gcs = (float*)(smem + 116736);
  u16* Xs = (u16*)(smem + 51200);
  unsigned char* opnd = ws + WS_DNOP + (long)item * 2 * DNOP_BYTES;
  const long tok0 = (long)ch * 64;
  for (int e = tid; e < 3072; e += 512) {
    const int which = e >> 10, q = e & 1023, row = q >> 4, c8 = q & 15;
    const u32x4 v = *(const u32x4*)(dnp + (tok0 + row) * 1536 + which * 512 + hd * 128 + c8 * 8);
    unsigned char* dst = (which == 0) ? (Ql + row * 272) : (which == 1) ? (Kl + row * 272) : (Vl + row * 256);
    *(u32x4*)(dst + c8 * 16) = v;
  }
  if (tid < 128) {
    const int dd = tid >> 6, i = tid & 63, ri = dd ? 63 - i : i;
    const float be = gates[(tok0 + ri) * 16 + dd * 4 + hd];
    float gv = gates[(tok0 + ri) * 16 + 8 + dd * 4 + hd];
#pragma unroll
    for (int o = 1; o < 64; o <<= 1) { const float t = __shfl_up(gv, o); if (i >= o) gv += t; }
    gcs[dd * 64 + i] = gv; gcs[128 + dd * 64 + i] = be; gcs[256 + dd * 64 + i] = be * __expf(gv);
  }
  __syncthreads();
  {
    const int which = w >> 2, mt = w & 3;
    const unsigned char* Asrc = which ? Ql : Kl;
    f32x4 a4[4];
#pragma unroll
    for (int n = 0; n < 4; ++n) a4[n] = (f32x4){0.f, 0.f, 0.f, 0.f};
#pragma unroll
    for (int kk = 0; kk < 4; ++kk) {
      const bf16x8 af = *(const bf16x8*)(Asrc + (mt * 16 + c16) * 272 + (kk * 4 + g) * 16);
#pragma unroll
      for (int n = 0; n < 4; ++n) {
        const bf16x8 bfv = *(const bf16x8*)(Kl + (n * 16 + c16) * 272 + (kk * 4 + g) * 16);
        a4[n] = mfma16(af, bfv, a4[n]);
      }
    }
    float* dst = which ? QKm : KK;
#pragma unroll
    for (int n = 0; n < 4; ++n)
#pragma unroll
      for (int j = 0; j < 4; ++j) dst[(mt * 16 + g * 4 + j) * 64 + n * 16 + c16] = a4[n][j];
  }
  __syncthreads();
  {
    const float* gc = gcs + dir * 64; const float* be = gcs + 128 + dir * 64;
    u16* qkout = (u16*)(opnd + dir * DNOP_BYTES + OP_QK);
    for (int e = t8; e < 2048; e += 256) {
      const int i = e >> 5, j = (e & 31) * 2;
      const int ri = dir ? 63 - i : i, rj = dir ? 63 - j : j, rj1 = dir ? 62 - j : j + 1;
      const float gi = gc[i];
      const float d0 = __expf(gi - gc[j]), d1 = __expf(gi - gc[j + 1]);
      const float bi = be[i];
      Am[(dir * 64 + i) * 64 + j] = (j < i) ? bi * KK[ri * 64 + rj] * d0 : 0.f;
      Am[(dir * 64 + i) * 64 + j + 1] = (j + 1 < i) ? bi * KK[ri * 64 + rj1] * d1 : 0.f;
      const float q0 = (j <= i) ? QKm[ri * 64 + rj] * d0 : 0.f, q1 = (j + 1 <= i) ? QKm[ri * 64 + rj1] * d1 : 0.f;
      *(unsigned*)(qkout + i * 64 + kperm(j)) = pk2(q0, q1);
    }
  }
  __syncthreads();
  {
    const bool isu = t8 < 128;
    const unsigned char* src = isu ? (Vl + t8 * 2) : (Kl + (t8 - 128) * 2);
    const int sstr = isu ? 256 : 272;
    const float* scl = gcs + (isu ? 128 : 256) + dir * 64;
    const float* Ad = Am + dir * 4096;
    float X[64];
#pragma unroll
    for (int i = 0; i < 64; ++i) {
      const int ri = dir ? 63 - i : i;
      float a = bf2f(*(const u16*)(src + ri * sstr)) * scl[i];
#pragma unroll
      for (int j4 = 0; j4 < (i + 3) / 4; ++j4) {
        const f32x4 av = *(const f32x4*)(Ad + i * 64 + j4 * 4);
        if (4 * j4 + 0 < i) a -= av.x * X[4 * j4 + 0];
        if (4 * j4 + 1 < i) a -= av.y * X[4 * j4 + 1];
        if (4 * j4 + 2 < i) a -= av.z * X[4 * j4 + 2];
        if (4 * j4 + 3 < i) a -= av.w * X[4 * j4 + 3];
      }
      X[i] = a;
    }
    if (isu) {
      u32x4* dst = (u32x4*)(opnd + dir * DNOP_BYTES + OP_UT + t8 * 128);
#pragma unroll
      for (int q = 0; q < 8; ++q) { u32x4 o = {pk2(X[8 * q], X[8 * q + 1]), pk2(X[8 * q + 2], X[8 * q + 3]), pk2(X[8 * q + 4], X[8 * q + 5]), pk2(X[8 * q + 6], X[8 * q + 7])}; dst[q] = o; }
    } else {
      u16* xd = Xs + dir * 8192 + kperm(t8 - 128);
#pragma unroll
      for (int i = 0; i < 64; ++i) xd[i * 128] = f2bf(-X[i]);
    }
  }
  __syncthreads();
  {
    for (int e = tid; e < 2048; e += 512) {
      const int dd = e >> 10, q = e & 1023;
      *(u32x4*)(opnd + dd * DNOP_BYTES + OP_WN + q * 16) = *(const u32x4*)((const unsigned char*)Xs + dd * 16384 + q * 16);
    }
    for (int e = tid; e < 2048; e += 512) {
      const int dd = e >> 10, q = e & 1023, i = q >> 4, c8 = q & 15, ri = dd ? 63 - i : i;
      const float sc = __expf(gcs[dd * 64 + i]);
      const int kb = c8 >> 2, gg = c8 & 3;
      const u32x2 v0 = *(const u32x2*)(Ql + ri * 272 + (kb * 32 + gg * 4) * 2), v1 = *(const u32x2*)(Ql + ri * 272 + (kb * 32 + 16 + gg * 4) * 2);
      u32x4 o = {pk2(bflo(v0.x) * sc, bfhi(v0.x) * sc), pk2(bflo(v0.y) * sc, bfhi(v0.y) * sc), pk2(bflo(v1.x) * sc, bfhi(v1.x) * sc), pk2(bflo(v1.y) * sc, bfhi(v1.y) * sc)};
      *(u32x4*)(opnd + dd * DNOP_BYTES + OP_QD + q * 16) = o;
    }
    {
      const int dk = t8 & 127, half = t8 >> 7;
      const float gl = gcs[dir * 64 + 63];
      u32x4* dst = (u32x4*)(opnd + dir * DNOP_BYTES + OP_KDT + dk * 128 + half * 64);
#pragma unroll
      for (int q = 0; q < 4; ++q) {
        float v[8];
#pragma unroll
        for (int jj = 0; jj < 8; ++jj) {
          const int i = half * 32 + (jj >> 2) * 16 + q * 4 + (jj & 3), ri = dir ? 63 - i : i;
          v[jj] = bf2f(*(const u16*)(Kl + ri * 272 + dk * 2)) * __expf(gl - gcs[dir * 64 + i]);
        }
        u32x4 o = {pk2(v[0], v[1]), pk2(v[2], v[3]), pk2(v[4], v[5]), pk2(v[6], v[7])};
        dst[q] = o;
      }
      if (t8 == 0) ((float*)(ws + WS_EGL))[item * 2 + dir] = __expf(gl);
    }
  }
  __syncthreads();
}

DI int scan_ldsoff(int q) {
  int lo;
  if (q < 2048) { const int a = q >> 10, qq = q & 1023; lo = a * 17408 + (qq >> 4) * 272 + (qq & 15) * 16; }
  else if (q < 2560) { const int qq = q - 2048; lo = 34816 + (qq >> 3) * 144 + (qq & 7) * 16; }
  else if (q < 3584) { const int qq = q - 2560; lo = 44032 + (qq >> 3) * 144 + (qq & 7) * 16; }
  else { const int qq = q - 3584; lo = 62464 + (qq >> 3) * 144 + (qq & 7) * 16; }
  return lo;
}
DI void scan_step(int m, int nc, int dir, int hd, int chunk0, unsigned char* ws, unsigned char* smem, const float* egl, u16* obuf,
                  f32x4 (&S)[8], u32x4 (&pw)[9], u32x4 (&pl)[9], float& egw, float& egl_next, int tid, int w, int c16, int g) {
  {
    const int chk = chunk0 + (dir ? nc - 1 - m : m);
    const float eg = egw;
    int tz = tid; asm volatile("" : "+v"(tz));
    if (m + 2 < nc) {
      const int chn = chunk0 + (dir ? nc - 3 - m : m + 2);
      const unsigned char* src = ws + WS_DNOP + ((long)(chn * 4 + hd) * 2 + dir) * DNOP_BYTES + tz * 16;
#pragma unroll
      for (int i = 0; i < 9; ++i) pl[i] = *(const u32x4*)(src + i * 8192);
      int z0 = 0; asm volatile("" : "+v"(z0));
      egw = egl[(chn * 4 + hd) * 2 + dir + z0];
    }
    const unsigned char* B = smem + (m & 1) * 80896;
    bf16x8 sb[4];
#pragma unroll
    for (int kb = 0; kb < 4; ++kb) {
      u32x4 u = {pk2(S[2 * kb].x, S[2 * kb].y), pk2(S[2 * kb].z, S[2 * kb].w), pk2(S[2 * kb + 1].x, S[2 * kb + 1].y), pk2(S[2 * kb + 1].z, S[2 * kb + 1].w)};
      sb[kb] = __builtin_bit_cast(bf16x8, u);
    }
    f32x4 va[4], oa[4];
#pragma unroll
    for (int mt = 0; mt < 4; ++mt) {
      const u32x2 uu = *(const u32x2*)(B + 62464 + (16 * w + c16) * 144 + (mt * 16 + g * 4) * 2);
      va[mt] = (f32x4){bflo(uu.x), bfhi(uu.x), bflo(uu.y), bfhi(uu.y)};
      oa[mt] = (f32x4){0.f, 0.f, 0.f, 0.f};
    }
#pragma unroll
    for (int mt = 0; mt < 4; ++mt)
#pragma unroll
      for (int kb = 0; kb < 4; ++kb) {
        const unsigned char* ap = B + (mt * 16 + c16) * 272 + (kb * 32 + g * 8) * 2;
        va[mt] = mfma16(*(const bf16x8*)ap, sb[kb], va[mt]);
        oa[mt] = mfma16(*(const bf16x8*)(ap + 17408), sb[kb], oa[mt]);
      }
    bf16x8 vb[2];
#pragma unroll
    for (int cb = 0; cb < 2; ++cb) {
      u32x4 u = {pk2(va[2 * cb].x, va[2 * cb].y), pk2(va[2 * cb].z, va[2 * cb].w), pk2(va[2 * cb + 1].x, va[2 * cb + 1].y), pk2(va[2 * cb + 1].z, va[2 * cb + 1].w)};
      vb[cb] = __builtin_bit_cast(bf16x8, u);
    }
#pragma unroll
    for (int mt = 0; mt < 4; ++mt)
#pragma unroll
      for (int cb = 0; cb < 2; ++cb) {
        const unsigned char* ap = B + 34816 + (mt * 16 + c16) * 144 + (cb * 32 + g * 8) * 2;
        oa[mt] = mfma16(*(const bf16x8*)ap, vb[cb], oa[mt]);
      }
#pragma unroll
    for (int t = 0; t < 8; ++t) {
      f32x4 s = {S[t].x * eg, S[t].y * eg, S[t].z * eg, S[t].w * eg};
#pragma unroll
      for (int cb = 0; cb < 2; ++cb) {
        const unsigned char* ap = B + 44032 + (t * 16 + c16) * 144 + (cb * 32 + g * 8) * 2;
        s = mfma16(*(const bf16x8*)ap, vb[cb], s);
      }
      S[t] = s;
    }
#pragma unroll
    for (int mt = 0; mt < 4; ++mt)
#pragma unroll
      for (int j = 0; j < 4; ++j) {
        const int i = mt * 16 + g * 4 + j;
        const long tok = (long)chk * 64 + (dir ? 63 - i : i);
        obuf[tok * 512 + hd * 128 + 16 * w + c16] = f2bf(oa[mt][j]);
      }
    if (m + 1 < nc) {
      unsigned char* nb = smem + ((m + 1) & 1) * 80896;
#pragma unroll
      for (int i = 0; i < 9; ++i) *(u32x4*)(nb + scan_ldsoff(tz + 512 * i)) = pw[i];
    }
    __syncthreads();
  }
}

DI void scan_chain(int grp, unsigned char* ws, unsigned char* smem, int chain) {
  const int tidx = opaque_tid();
  const int L = (grp == 0) ? 16384 : 2048, nc = L >> 6;
  const int dir = chain & 1, hd = (chain >> 1) & 3, sq = chain >> 3;
  const int tid = tidx, lane = tid & 63, w = tid >> 6, c16 = lane & 15, g = lane >> 4;
  const int chunk0 = sq * nc;
  const float* egl = (const float*)(ws + WS_EGL);
  u16* obuf = (u16*)(ws + WS_OF) + (long)dir * TG * 512;
  f32x4 S[8];
#pragma unroll
  for (int t = 0; t < 8; ++t) S[t] = (f32x4){0.f, 0.f, 0.f, 0.f};
  u32x4 preA[9], preB[9];
  float egA, egB;
  {
    const int chk = chunk0 + (dir ? nc - 1 : 0);
    const unsigned char* src = ws + WS_DNOP + ((long)(chk * 4 + hd) * 2 + dir) * DNOP_BYTES + tid * 16;
#pragma unroll
    for (int i = 0; i < 9; ++i) preA[i] = *(const u32x4*)(src + i * 8192);
    egA = egl[(chk * 4 + hd) * 2 + dir];
  }
  __syncthreads();
#pragma unroll
  for (int i = 0; i < 9; ++i) *(u32x4*)(smem + scan_ldsoff(tid + 512 * i)) = preA[i];
  {
    const int chk = chunk0 + (dir ? nc - 2 : 1);
    const unsigned char* src = ws + WS_DNOP + ((long)(chk * 4 + hd) * 2 + dir) * DNOP_BYTES + tid * 16;
#pragma unroll
    for (int i = 0; i < 9; ++i) preA[i] = *(const u32x4*)(src + i * 8192);
    egB = egl[(chk * 4 + hd) * 2 + dir];
  }
  __syncthreads();
  for (int m = 0; m < nc; m += 2) {
    scan_step(m, nc, dir, hd, chunk0, ws, smem, egl, obuf, S, preA, preB, egA, egA, tid, w, c16, g);
    scan_step(m + 1, nc, dir, hd, chunk0, ws, smem, egl, obuf, S, preB, preA, egB, egB, tid, w, c16, g);
  }
}

DI void phase_merge(const Params& p, unsigned char* ws) {
  const int tidx = opaque_tid();
  const int lane = tidx & 63;
  const int gw = blockIdx.x * 8 + (tidx >> 6), NW = gridDim.x * 8;
  const u16* attp = (const u16*)(ws + WS_ATTP); const float* lse = (const float*)(ws + WS_LSE);
  const u16* of = (const u16*)(ws + WS_OF); const u16* proj = (const u16*)(ws + WS_PROJ);
  u16* mix = (u16*)(ws + WS_NBUF);
  f32x4 gn0 = *(const f32x4*)(p.out_norm + (lane & 15) * 8), gn1 = *(const f32x4*)(p.out_norm + (lane & 15) * 8 + 4);
  for (int t = gw; t < TG; t += NW) {
    {
      const int h = lane >> 3;
      const float l0 = lse[((long)0 * TG + t) * 8 + h], l1 = lse[((long)1 * TG + t) * 8 + h], l2 = lse[((long)2 * TG + t) * 8 + h];
      const float mx = fmaxf(l0, fmaxf(l1, l2));
      float w0 = __expf(l0 - mx), w1 = __expf(l1 - mx), w2 = __expf(l2 - mx);
      const float inv = 1.f / (w0 + w1 + w2); w0 *= inv; w1 *= inv; w2 *= inv;
      const u32x4 a = *(const u32x4*)(attp + ((long)0 * TG + t) * 512 + lane * 8);
      const u32x4 b = *(const u32x4*)(attp + ((long)1 * TG + t) * 512 + lane * 8);
      const u32x4 c = *(const u32x4*)(attp + ((long)2 * TG + t) * 512 + lane * 8);
      u32x4 o;
      o.x = pk2(w0 * bflo(a.x) + w1 * bflo(b.x) + w2 * bflo(c.x), w0 * bfhi(a.x) + w1 * bfhi(b.x) + w2 * bfhi(c.x));
      o.y = pk2(w0 * bflo(a.y) + w1 * bflo(b.y) + w2 * bflo(c.y), w0 * bfhi(a.y) + w1 * bfhi(b.y) + w2 * bfhi(c.y));
      o.z = pk2(w0 * bflo(a.z) + w1 * bflo(b.z) + w2 * bflo(c.z), w0 * bfhi(a.z) + w1 * bfhi(b.z) + w2 * bfhi(c.z));
      o.w = pk2(w0 * bflo(a.w) + w1 * bflo(b.w) + w2 * bflo(c.w), w0 * bfhi(a.w) + w1 * bfhi(b.w) + w2 * bfhi(c.w));
      *(u32x4*)(mix + (long)t * 1024 + lane * 8) = o;
    }
    {
      const u32x4 a = *(const u32x4*)(of + (long)t * 512 + lane * 8);
      const u32x4 b = *(const u32x4*)(of + ((long)TG + t) * 512 + lane * 8);
      const u32x4 gg = *(const u32x4*)(proj + (long)t * NPROJ + 3072 + lane * 8);
      float o[8] = {bflo(a.x) + bflo(b.x), bfhi(a.x) + bfhi(b.x), bflo(a.y) + bflo(b.y), bfhi(a.y) + bfhi(b.y),
                    bflo(a.z) + bflo(b.z), bfhi(a.z) + bfhi(b.z), bflo(a.w) + bflo(b.w), bfhi(a.w) + bfhi(b.w)};
      float ss = 0.f;
#pragma unroll
      for (int i = 0; i < 8; ++i) ss += o[i] * o[i];
      ss += __shfl_xor(ss, 1); ss += __shfl_xor(ss, 2); ss += __shfl_xor(ss, 4); ss += __shfl_xor(ss, 8);
      const float rs = rsqrtf(ss * (1.f / 128.f) + 1e-6f);
      const float gv[8] = {bflo(gg.x), bfhi(gg.x), bflo(gg.y), bfhi(gg.y), bflo(gg.z), bfhi(gg.z), bflo(gg.w), bfhi(gg.w)};
      const float gn[8] = {gn0.x, gn0.y, gn0.z, gn0.w, gn1.x, gn1.y, gn1.z, gn1.w};
      float y[8];
#pragma unroll
      for (int i = 0; i < 8; ++i) y[i] = o[i] * rs * gn[i] * siluf_(gv[i]);
      u32x4 ov = {pk2(y[0], y[1]), pk2(y[2], y[3]), pk2(y[4], y[5]), pk2(y[6], y[7])};
      *(u32x4*)(mix + (long)t * 1024 + 512 + lane * 8) = ov;
    }
  }
}

extern __shared__ __attribute__((aligned(16))) unsigned char smem[];

__global__ void __launch_bounds__(512) mk_fwd(Params p) {
  cg::grid_group grid = cg::this_grid();
  unsigned char* ws = p.ws;
  {
    const long gtid = (long)blockIdx.x * 512 + opaque_tid(), nthr = (long)gridDim.x * 512;
    conv_weight(p.w_in, 3600, 1024, NPROJ, (u16*)(ws + WS_WIN), 0, nullptr, gtid, nthr);
    conv_weight(p.w_out, 1024, 1024, 1024, (u16*)(ws + WS_WOUT), 0, nullptr, gtid, nthr);
    conv_weight(p.w_up, 5632, 1024, 5632, (u16*)(ws + WS_WUP), 1, p.norm2, gtid, nthr);
    conv_weight(p.w_down, 1024, 2816, 1024, (u16*)(ws + WS_WDOWN), 0, nullptr, gtid, nthr);
  }
#pragma unroll 1
  for (int grp = 0; grp < 3; ++grp) {
    const float* xg = (grp == 0) ? p.xp : (p.xs + (long)(grp - 1) * TG * 1024);
    float* outg = p.out + (long)grp * TG * 1024;
    REP(0) { phase_norm(p, xg, ws, smem); __syncthreads(); }
    grid.sync();
    REP(1) gemm_phase<1>(p, grp, ws, smem, xg, outg);
    grid.sync();
    phase_prep(p, grp, ws);
    grid.sync();
    {
      REP(2) for (int it = blockIdx.x; it < 6144; it += gridDim.x) attn_item(grp, ws, smem, it);
      REP(4) for (int it = blockIdx.x; it < 2048; it += gridDim.x) dnlocal_item(ws, smem, it);
    }
    grid.sync();
    {
      const int nchains = (grp == 0) ? 16 : 128;
      REP(3) for (int c = blockIdx.x; c < nchains; c += gridDim.x) scan_chain(grp, ws, smem, c);
    }
    grid.sync();
    REP(0) phase_merge(p, ws);
    grid.sync();
    REP(1) gemm_phase<2>(p, grp, ws, smem, xg, outg);
    grid.sync();
    REP(1) gemm_phase<3>(p, grp, ws, smem, xg, outg);
    grid.sync();
    gemm_phase<4>(p, grp, ws, smem, xg, outg);
    if (grp < 2) grid.sync();
  }
}

extern "C" void kernel_launch(void* const* d_in, const int* in_sizes, int n_in, void* d_out, int out_size,
                              void* d_ws, size_t ws_size, hipStream_t stream) {
  static int grid_blocks = 0;
  if (!grid_blocks) {
    int dev = 0, cus = 0, per_cu = 0;
    (void)hipGetDevice(&dev);
    (void)hipDeviceGetAttribute(&cus, hipDeviceAttributeMultiprocessorCount, dev);
    (void)hipFuncSetAttribute((const void*)mk_fwd, hipFuncAttributeMaxDynamicSharedMemorySize, LDS_BYTES);
    (void)hipOccupancyMaxActiveBlocksPerMultiprocessor(&per_cu, (const void*)mk_fwd, 512, LDS_BYTES);
    if (per_cu < 1) per_cu = 1;
    grid_blocks = cus * per_cu;
    if (ws_size < 883 * MiB) fprintf(stderr, "workspace too small: %zu\n", ws_size);
  }
  Params p{};
  p.xp = (const float*)d_in[0]; p.xs = (const float*)d_in[1]; p.norm1 = (const float*)d_in[2]; p.w_in = (const float*)d_in[3];
  p.qn = (const float*)d_in[4]; p.kn = (const float*)d_in[5]; p.dn_conv_w = (const float*)d_in[6]; p.a_log = (const float*)d_in[7];
  p.dt_bias = (const float*)d_in[8]; p.out_norm = (const float*)d_in[9]; p.w_out = (const float*)d_in[10]; p.norm2 = (const float*)d_in[11];
  p.w_up = (const float*)d_in[12]; p.ffn_cw = (const float*)d_in[13]; p.ffn_cb = (const float*)d_in[14]; p.w_down = (const float*)d_in[15];
  p.out = (float*)d_out; p.ws = (unsigned char*)d_ws;
  void* args[] = {&p};
  hipError_t e = hipLaunchCooperativeKernel((void*)mk_fwd, dim3(grid_blocks), dim3(512), args, LDS_BYTES, stream);
  if (e != hipSuccess) fprintf(stderr, "cooperative launch failed: %s (grid %d)\n", hipGetErrorString(e), grid_blocks);
}
```

```cpp
#include <hip/hip_runtime.h>
#include <hip/hip_cooperative_groups.h>
#include <cstdio>
namespace cg = cooperative_groups;

typedef unsigned short u16;
typedef __attribute__((ext_vector_type(8))) short bf16x8;
typedef __attribute__((ext_vector_type(4))) float f32x4;
typedef __attribute__((ext_vector_type(4))) unsigned u32x4;
typedef __attribute__((ext_vector_type(2))) unsigned u32x2;
typedef __bf16 bf2_t __attribute__((ext_vector_type(2)));
typedef float f2_t __attribute__((ext_vector_type(2)));
#define DI __device__ __forceinline__

constexpr int TG = 32768;
constexpr int NPROJ = 3584;
constexpr size_t MiB = 1u << 20;
constexpr size_t WS_WIN = 0, WS_WOUT = 7 * MiB, WS_WUP = 9 * MiB, WS_WDOWN = 20 * MiB;
constexpr size_t WS_GATES = 27 * MiB, WS_LSE = 29 * MiB, WS_ROWSQ = 32 * MiB, WS_EGL = 34 * MiB;
constexpr size_t WS_BAR = 34 * MiB + 512 * 1024;
constexpr size_t WS_NBUF = 35 * MiB;
constexpr size_t WS_PROJ = 99 * MiB;
constexpr size_t WS_HB = WS_PROJ, WS_ACT = WS_PROJ + 64 * MiB;
constexpr size_t WS_DNP = 339 * MiB, WS_ATTP = 435 * MiB, WS_DNOP = 531 * MiB, WS_OF = 819 * MiB;
constexpr int DNOP_BYTES = 73728;
constexpr int OP_WN = 0, OP_QD = 16384, OP_QK = 32768, OP_KDT = 40960, OP_UT = 57344;
constexpr int LDS_BYTES = 163840;
#ifndef PROBE_MASK
#define PROBE_MASK 0
#endif
#define GSYNC() do { xcd_barrier(xb); if ((PROBE_MASK >> 7) & 1) xcd_barrier(xb); } while (0)
#define REP(bit) for (int rep_ = 0; rep_ < (((PROBE_MASK) >> (bit)) & 1) + 1; ++rep_)

struct Params {
  const float *xp, *xs, *norm1, *w_in, *qn, *kn, *dn_conv_w, *a_log, *dt_bias, *out_norm, *w_out, *norm2, *w_up, *ffn_cw, *ffn_cb, *w_down;
  float* out; unsigned char* ws;
};

DI float bf2f(unsigned v) { return __uint_as_float(v << 16); }
DI float bflo(unsigned v) { return __uint_as_float(v << 16); }
DI float bfhi(unsigned v) { return __uint_as_float(v & 0xffff0000u); }
DI unsigned pk2(float lo, float hi) { f2_t v = {lo, hi}; bf2_t r = __builtin_convertvector(v, bf2_t); return __builtin_bit_cast(unsigned, r); }
DI u16 f2bf(float x) { return (u16)(pk2(x, 0.f) & 0xffffu); }
DI int opaque_tid() {
  const int wv = __builtin_amdgcn_readfirstlane((int)threadIdx.x >> 6);
  int ln;
  asm volatile("v_mbcnt_lo_u32_b32 %0, -1, 0\n\tv_mbcnt_hi_u32_b32 %0, -1, %0" : "=v"(ln));
  return (wv << 6) | ln; }
DI float wave_sum(float v) {
#pragma unroll
  for (int o = 32; o > 0; o >>= 1) v += __shfl_xor(v, o);
  return v;
}
DI f32x4 mfma16(bf16x8 a, bf16x8 b, f32x4 c) { return __builtin_amdgcn_mfma_f32_16x16x32_bf16(a, b, c, 0, 0, 0); }
#define LAS __attribute__((address_space(3)))
DI void glds16(const void* g, unsigned ldsoff) {
  __builtin_amdgcn_global_load_lds((const __attribute__((address_space(1))) void*)g, (LAS void*)(unsigned long)ldsoff, 16, 0, 0);
}
DI int kperm(int k) { return (k & ~31) | (((k >> 2) & 3) << 3) | (((k >> 4) & 1) << 2) | (k & 3); }
DI float sigmoidf_(float x) { return 1.f / (1.f + __expf(-x)); }
DI float siluf_(float x) { return x / (1.f + __expf(-x)); }

DI void conv_weight(const float* __restrict__ W, int Nsrc, int K, int Nout, u16* __restrict__ WT, int mode, const float* __restrict__ scale,
                    long gtid, long nthr) {
  const int kgn = K >> 3;
  for (long idx = gtid; idx < (long)Nout * kgn; idx += nthr) {
    const int n = (int)(idx % Nout), kg = (int)(idx / Nout);
    int src = n;
    if (mode == 1) { const int pn = n >> 8, ct = n & 255; src = (ct < 128) ? (pn * 128 + ct) : (2816 + pn * 128 + ct - 128); }
    float v[8];
#pragma unroll
    for (int j = 0; j < 8; ++j) { const int k = kg * 8 + j; const float s = scale ? scale[k] : 1.f; v[j] = W[(long)k * Nsrc + src] * s; }
    u32x4 o = {pk2(v[0], v[1]), pk2(v[2], v[3]), pk2(v[4], v[5]), pk2(v[6], v[7])};
    *(u32x4*)(WT + (long)n * K + kg * 8) = o;
  }
}

DI void phase_norm(const Params& p, const float* __restrict__ xg, unsigned char* ws, unsigned char* smem) {
  const int tidx = opaque_tid();
  f32x4* gw4 = (f32x4*)smem;
  float* gwf = (float*)smem;
  for (int e = tidx; e < 1024 * 16; e += 512) {
    const int k = e >> 4, jg = e & 15;
    const int ln = (k >> 2) & 63, j = k >> 8, ee = k & 3, q = jg >> 2, cmp = jg & 3;
    gwf[((((j * 4 + ee) * 4 + q) * 64 + ln) << 2) + cmp] = p.w_in[(long)k * 3600 + 3584 + jg];
  }
  __syncthreads();
  const int wave = tidx >> 6, lane = tidx & 63;
  u16* nbuf = (u16*)(ws + WS_NBUF); float* gates = (float*)(ws + WS_GATES);
  for (int row = blockIdx.x * 8 + wave; row < TG; row += gridDim.x * 8) {
    const f32x4* xr = (const f32x4*)(xg + (long)row * 1024);
    f32x4 v[4]; float ss = 0.f;
#pragma unroll
    for (int j = 0; j < 4; ++j) { v[j] = xr[lane + 64 * j]; ss += v[j].x * v[j].x + v[j].y * v[j].y + v[j].z * v[j].z + v[j].w * v[j].w; }
    ss = wave_sum(ss);
    const float rs = rsqrtf(ss * (1.f / 1024.f) + 1e-6f);
    float ga[16];
#pragma unroll
    for (int i = 0; i < 16; ++i) ga[i] = 0.f;
#pragma unroll
    for (int j = 0; j < 4; ++j) {
      const f32x4 nw = ((const f32x4*)p.norm1)[lane + 64 * j];
      v[j].x *= rs * nw.x; v[j].y *= rs * nw.y; v[j].z *= rs * nw.z; v[j].w *= rs * nw.w;
      u32x2 o = {pk2(v[j].x, v[j].y), pk2(v[j].z, v[j].w)};
      *(u32x2*)(nbuf + (long)row * 1024 + 4 * (lane + 64 * j)) = o;
#pragma unroll
      for (int e = 0; e < 4; ++e) {
        const float xv = v[j][e];
#pragma unroll
        for (int q = 0; q < 4; ++q) {
          const f32x4 w4 = gw4[((j * 4 + e) * 4 + q) * 64 + lane];
          ga[4 * q + 0] += xv * w4.x; ga[4 * q + 1] += xv * w4.y; ga[4 * q + 2] += xv * w4.z; ga[4 * q + 3] += xv * w4.w;
        }
        __builtin_amdgcn_sched_barrier(0);
      }
    }
    float r = 0.f;
#pragma unroll
    for (int i = 0; i < 16; ++i) { const float s = wave_sum(ga[i]); r = (lane == i) ? s : r; }
    if (lane < 16) {
      float o;
      if (lane < 8) o = sigmoidf_(r);
      else { const int jj = lane - 8; const float z = r + p.dt_bias[jj]; const float ez = __expf(z); const float sp = (z > 20.f) ? z : ((ez < 0.02f) ? ez * (1.f - ez * (0.5f - ez * (1.f / 3.f))) : __logf(1.f + ez)); o = -__expf(p.a_log[jj]) * sp; }
      gates[(long)row * 16 + lane] = o;
    }
  }
}

template <int MODE>
DI void gemm_phase(const Params& p, int grp, unsigned char* ws, unsigned char* smem, const float* __restrict__ xg, float* __restrict__ outg) {
  const int tidx = opaque_tid();
  const u16* A; const u16* Bt; int K, nM, nN, lda;
  if (MODE == 1) { A = (const u16*)(ws + WS_NBUF); Bt = (const u16*)(ws + WS_WIN); K = 1024; nM = TG / 256; nN = NPROJ / 256; lda = 1024; }
  else if (MODE == 2) { A = (const u16*)(ws + WS_NBUF); Bt = (const u16*)(ws + WS_WOUT); K = 1024; nM = TG / 256; nN = 4; lda = 1024; }
  else if (MODE == 3) { A = (const u16*)(ws + WS_HB); Bt = (const u16*)(ws + WS_WUP); K = 1024; nM = (TG + 253) / 254; nN = 22; lda = 1024; }
  else { A = (const u16*)(ws + WS_ACT); Bt = (const u16*)(ws + WS_WDOWN); K = 2816; nM = TG / 256; nN = 4; lda = 2816; }
  const int L = (grp == 0) ? 16384 : 2048;
  const int tid = tidx, lane = tid & 63, wid = tid >> 6, wr = wid >> 2, wc = wid & 3, c16 = lane & 15, g = lane >> 4;
  const int ntiles = nM * nN, nk = K >> 6;
  const int G = gridDim.x, b = blockIdx.x;
  const int bperm = ((G & 7) == 0) ? ((b & 7) * (G >> 3) + (b >> 3)) : b;
  const int r0 = tid >> 3, schunk = (tid & 7) ^ ((tid >> 3) & 7);
  const int sw = c16 & 7;
  const int aoff = (wr * 128 + c16) * 128, boff = 32768 + (wc * 64 + c16) * 128;
  for (int T = bperm; T < ntiles; T += G) {
    const int sg = T / (8 * nN), fm = sg * 8, gsz = (nM - fm) < 8 ? (nM - fm) : 8, idx = T - sg * 8 * nN;
    const int pm = fm + (idx % gsz), pn = idx / gsz;
    const int rowbase = (MODE == 3) ? (pm * 254 - 1) : (pm * 256);
    int ao[4];
#pragma unroll
    for (int i = 0; i < 4; ++i) {
      int ar = rowbase + r0 + 64 * i;
      if (MODE == 3) ar = ar < 0 ? 0 : (ar > TG - 1 ? TG - 1 : ar);
      ao[i] = ar * lda + schunk * 8;
    }
    const u16* bp0 = Bt + (long)(pn * 256 + r0) * K + schunk * 8;
    f32x4 acc[8][4];
#pragma unroll
    for (int m = 0; m < 8; ++m)
#pragma unroll
      for (int n = 0; n < 4; ++n) acc[m][n] = (f32x4){0.f, 0.f, 0.f, 0.f};
    __syncthreads();
#pragma unroll
    for (int i = 0; i < 4; ++i) { glds16(A + ao[i], tid * 16 + i * 8192); glds16(bp0 + i * 64 * K, 32768 + tid * 16 + i * 8192); }
    __syncthreads();
    for (int kt = 0; kt < nk; ++kt) {
      if (kt + 1 < nk) {
        const unsigned nb = ((kt + 1) & 1) * 65536 + tid * 16;
#pragma unroll
        for (int i = 0; i < 4; ++i) { glds16(A + ao[i] + (kt + 1) * 64, nb + i * 8192); glds16(bp0 + i * 64 * K + (kt + 1) * 64, nb + 32768 + i * 8192); }
      }
      const unsigned char* buf = smem + (kt & 1) * 65536;
#pragma unroll
      for (int kk = 0; kk < 2; ++kk) {
        bf16x8 bfr[4];
        const int co = ((kk * 4 + g) ^ sw) << 4;
#pragma unroll
        for (int n = 0; n < 4; ++n) bfr[n] = *(const bf16x8*)(buf + boff + n * 2048 + co);
#pragma unroll
        for (int mh = 0; mh < 2; ++mh) {
          bf16x8 af[4];
#pragma unroll
          for (int m = 0; m < 4; ++m) af[m] = *(const bf16x8*)(buf + aoff + (mh * 4 + m) * 2048 + co);
#pragma unroll
          for (int m = 0; m < 4; ++m)
#pragma unroll
            for (int n = 0; n < 4; ++n) acc[mh * 4 + m][n] = mfma16(bfr[n], af[m], acc[mh * 4 + m][n]);
        }
      }
      __syncthreads();
    }
    if (MODE == 1) {
      u16* proj = (u16*)(ws + WS_PROJ);
#pragma unroll
      for (int m = 0; m < 8; ++m) {
        const long row = pm * 256 + wr * 128 + m * 16 + c16;
#pragma unroll
        for (int n = 0; n < 4; ++n) {
          const int col = pn * 256 + wc * 64 + n * 16 + g * 4;
          u32x2 o = {pk2(acc[m][n].x, acc[m][n].y), pk2(acc[m][n].z, acc[m][n].w)};
          *(u32x2*)(proj + row * NPROJ + col) = o;
        }
      }
    } else if (MODE == 2) {
      u16* hb = (u16*)(ws + WS_HB); float* rowsq = (float*)(ws + WS_ROWSQ);
#pragma unroll
      for (int m = 0; m < 8; ++m) {
        const long row = pm * 256 + wr * 128 + m * 16 + c16;
        float s = 0.f;
#pragma unroll
        for (int n = 0; n < 4; ++n) {
          const int col = pn * 256 + wc * 64 + n * 16 + g * 4;
          const f32x4 xv = *(const f32x4*)(xg + row * 1024 + col);
          f32x4 h = {xv.x + acc[m][n].x, xv.y + acc[m][n].y, xv.z + acc[m][n].z, xv.w + acc[m][n].w};
          *(f32x4*)(outg + row * 1024 + col) = h;
          u32x2 o = {pk2(h.x, h.y), pk2(h.z, h.w)};
          *(u32x2*)(hb + row * 1024 + col) = o;
          s += h.x * h.x + h.y * h.y + h.z * h.z + h.w * h.w;
        }
        s += __shfl_xor(s, 16); s += __shfl_xor(s, 32);
        if (g == 0) rowsq[row * 16 + pn * 4 + wc] = s;
      }
    } else if (MODE == 4) {
#pragma unroll
      for (int m = 0; m < 8; ++m) {
        const long row = pm * 256 + wr * 128 + m * 16 + c16;
#pragma unroll
        for (int n = 0; n < 4; ++n) {
          const int col = pn * 256 + wc * 64 + n * 16 + g * 4;
          f32x4 h = *(const f32x4*)(outg + row * 1024 + col);
          h.x += acc[m][n].x; h.y += acc[m][n].y; h.z += acc[m][n].z; h.w += acc[m][n].w;
          *(f32x4*)(outg + row * 1024 + col) = h;
        }
      }
    } else {
      const float* rowsq = (const float*)(ws + WS_ROWSQ);
      u16* act = (u16*)(ws + WS_ACT);
#pragma unroll
      for (int m = 0; m < 8; ++m) {
        const int rl = wr * 128 + m * 16 + c16;
        int ar = rowbase + rl; ar = ar < 0 ? 0 : (ar > TG - 1 ? TG - 1 : ar);
        const f32x4* rq = (const f32x4*)(rowsq + (long)ar * 16);
        const f32x4 q0 = rq[0], q1 = rq[1], q2 = rq[2], q3 = rq[3];
        const float ssq = (q0.x + q0.y + q0.z + q0.w) + (q1.x + q1.y + q1.z + q1.w) + (q2.x + q2.y + q2.z + q2.w) + (q3.x + q3.y + q3.z + q3.w);
        const float rs2 = rsqrtf(ssq * (1.f / 1024.f) + 1e-6f);
#pragma unroll
        for (int n = 0; n < 4; ++n) {
          const int col = wc * 64 + n * 16 + g * 4;
          u32x2 o = {pk2(acc[m][n].x * rs2, acc[m][n].y * rs2), pk2(acc[m][n].z * rs2, acc[m][n].w * rs2)};
          *(u32x2*)(smem + rl * 520 + col * 2) = o;
        }
      }
      __syncthreads();
      {
        const int hp = tid & 63, rg = tid >> 6;
        const int hid = pn * 128 + 2 * hp;
        float cwg[3][2], cwu[3][2], cbg[2], cbu[2];
#pragma unroll
        for (int j = 0; j < 3; ++j) {
          cwg[j][0] = p.ffn_cw[j * 5632 + hid]; cwg[j][1] = p.ffn_cw[j * 5632 + hid + 1];
          cwu[j][0] = p.ffn_cw[j * 5632 + 2816 + hid]; cwu[j][1] = p.ffn_cw[j * 5632 + 2816 + hid + 1];
        }
        cbg[0] = p.ffn_cb[hid]; cbg[1] = p.ffn_cb[hid + 1]; cbu[0] = p.ffn_cb[2816 + hid]; cbu[1] = p.ffn_cb[2816 + hid + 1];
        const int i0 = rg * 32 < 1 ? 1 : rg * 32, i1 = (rg * 32 + 31) > 254 ? 254 : (rg * 32 + 31);
        unsigned gp = *(const unsigned*)(smem + (i0 - 1) * 520 + hp * 4), up = *(const unsigned*)(smem + (i0 - 1) * 520 + 256 + hp * 4);
        unsigned gc = *(const unsigned*)(smem + i0 * 520 + hp * 4), uc = *(const unsigned*)(smem + i0 * 520 + 256 + hp * 4);
        for (int i = i0; i <= i1; ++i) {
          const unsigned gn = *(const unsigned*)(smem + (i + 1) * 520 + hp * 4), un = *(const unsigned*)(smem + (i + 1) * 520 + 256 + hp * 4);
          const int lt = rowbase + i;
          if (lt < TG) {
            const int pos = lt & (L - 1);
            const float mp = (pos != 0) ? 1.f : 0.f, mn = (pos != L - 1) ? 1.f : 0.f;
            const float G0 = cwg[0][0] * bflo(gp) * mp + cwg[1][0] * bflo(gc) + cwg[2][0] * bflo(gn) * mn + cbg[0];
            const float G1 = cwg[0][1] * bfhi(gp) * mp + cwg[1][1] * bfhi(gc) + cwg[2][1] * bfhi(gn) * mn + cbg[1];
            const float U0 = cwu[0][0] * bflo(up) * mp + cwu[1][0] * bflo(uc) + cwu[2][0] * bflo(un) * mn + cbu[0];
            const float U1 = cwu[0][1] * bfhi(up) * mp + cwu[1][1] * bfhi(uc) + cwu[2][1] * bfhi(un) * mn + cbu[1];
            *(unsigned*)(act + (long)lt * 2816 + hid) = pk2(siluf_(G0) * U0, siluf_(G1) * U1);
          }
          gp = gc; up = uc; gc = gn; uc = un;
        }
      }
    }
  }
}

DI void phase_prep(const Params& p, int grp, unsigned char* ws) {
  const int tidx = opaque_tid();
  const int L = (grp == 0) ? 16384 : 2048;
  const int lane = tidx & 63;
  const int gw = blockIdx.x * 8 + (tidx >> 6), NW = gridDim.x * 8;
  u16* proj = (u16*)(ws + WS_PROJ);
  {
    const int i = lane & 15;
    const float f0 = exp2f(-(float)(2 * i) * (13.287712379549449f / 32.f)), f1 = exp2f(-(float)(2 * i + 1) * (13.287712379549449f / 32.f));
    for (int base = gw * 16; base < TG * 16; base += NW * 16) {
      unsigned elo[4], ehi[4];
#pragma unroll
      for (int k = 0; k < 4; ++k) {
        const int u = base + (lane >> 4) + 4 * k, t = u >> 4, hs = u & 15;
        const u16* ptr = proj + (long)t * NPROJ + hs * 64;
        elo[k] = *(const unsigned*)(ptr + 2 * i); ehi[k] = *(const unsigned*)(ptr + 32 + 2 * i);
      }
      float s0, c0, s1, c1;
      {
        const float pos = (float)((base >> 4) & (L - 1));
        sincosf(pos * f0, &s0, &c0); sincosf(pos * f1, &s1, &c1);
      }
#pragma unroll
      for (int k = 0; k < 4; ++k) {
        const int u = base + (lane >> 4) + 4 * k, t = u >> 4, hs = u & 15;
        u16* ptr = proj + (long)t * NPROJ + hs * 64;
        float x1a = bflo(elo[k]), x1b = bfhi(elo[k]), x2a = bflo(ehi[k]), x2b = bfhi(ehi[k]);
        float ss = x1a * x1a + x1b * x1b + x2a * x2a + x2b * x2b;
        ss += __shfl_xor(ss, 1); ss += __shfl_xor(ss, 2); ss += __shfl_xor(ss, 4); ss += __shfl_xor(ss, 8);
        const float rs = rsqrtf(ss * (1.f / 64.f) + 1e-6f);
        const float* gn = (hs < 8) ? p.qn : p.kn;
        const float sc = (hs < 8) ? 0.125f : 1.f;
        x1a *= rs * gn[2 * i]; x1b *= rs * gn[2 * i + 1]; x2a *= rs * gn[32 + 2 * i]; x2b *= rs * gn[33 + 2 * i];
        const float o1a = (x1a * c0 - x2a * s0) * sc, o2a = (x2a * c0 + x1a * s0) * sc;
        const float o1b = (x1b * c1 - x2b * s1) * sc, o2b = (x2b * c1 + x1b * s1) * sc;
        *(unsigned*)(ptr + 2 * i) = pk2(o1a, o1b); *(unsigned*)(ptr + 32 + 2 * i) = pk2(o2a, o2b);
      }
    }
  }
  {
    u16* dnp = (u16*)(ws + WS_DNP);
    for (int unit = gw; unit < 12 * (TG / 64); unit += NW) {
      const int s = unit % 12, r = unit / 12, t0 = r * 64;
      const int c = s * 128 + 2 * lane;
      float w0[5], w1[5];
#pragma unroll
      for (int j = 0; j < 5; ++j) { w0[j] = p.dn_conv_w[j * 1536 + c]; w1[j] = p.dn_conv_w[j * 1536 + c + 1]; }
      const u16* src = proj + 1536 + c;
      const int pos0 = t0 & (L - 1);
      unsigned win[5];
      win[0] = (pos0 >= 2) ? *(const unsigned*)(src + (long)(t0 - 2) * NPROJ) : 0u;
      win[1] = (pos0 >= 1) ? *(const unsigned*)(src + (long)(t0 - 1) * NPROJ) : 0u;
      win[2] = *(const unsigned*)(src + (long)t0 * NPROJ);
      win[3] = *(const unsigned*)(src + (long)(t0 + 1) * NPROJ);
      const float qs = (s < 4) ? 0.08838834764831845f : 1.f;
      for (int tb = 0; tb < 64; tb += 8) {
        unsigned nw[8];
#pragma unroll
        for (int u = 0; u < 8; ++u) nw[u] = (pos0 + tb + u + 2 < L) ? *(const unsigned*)(src + (long)(t0 + tb + u + 2) * NPROJ) : 0u;
#pragma unroll
        for (int u = 0; u < 8; ++u) {
        const int t = t0 + tb + u;
        win[4] = nw[u];
        float a0 = 0.f, a1 = 0.f;
#pragma unroll
        for (int j = 0; j < 5; ++j) { a0 += w0[j] * bflo(win[j]); a1 += w1[j] * bfhi(win[j]); }
        a0 = siluf_(a0); a1 = siluf_(a1);
        if (s < 8) {
          const float ss = wave_sum(a0 * a0 + a1 * a1);
          const float rs = rsqrtf(ss + 1e-6f) * qs;
          a0 *= rs; a1 *= rs;
        }
        *(unsigned*)(dnp + (long)t * 1536 + c) = pk2(a0, a1);
#pragma unroll
        for (int j = 0; j < 4; ++j) win[j] = win[j + 1];
        }
      }
    }
  }
}

DI void attn_item(int grp, unsigned char* ws, unsigned char* smem, int item) {
  const int tidx = opaque_tid();
  const int L = (grp == 0) ? 16384 : 2048;
  const int pat = item >> 11, rem = item & 2047, h = rem & 7, bi = rem >> 3;
  const int dsh = pat * 2, d = 1 << dsh;
  const int st = bi >> dsh, r = bi & (d - 1), base = st * (128 << dsh), s0 = base & ~(L - 1);
  const int tid = tidx, lane = tid & 63, w = tid >> 6, c16 = lane & 15, g = lane >> 4;
  const u16* proj = (const u16*)(ws + WS_PROJ);
  unsigned char* Qs = smem; unsigned char* Ks = smem + 16384; u16* Vt = (u16*)(smem + 51200);
  for (int e = tid; e < 1024; e += 512) {
    const int row = e >> 3, ch = e & 7; const long lt = base + r + (row << dsh);
    const u32x4 v = *(const u32x4*)(proj + lt * NPROJ + h * 64 + ch * 8);
    *(u32x4*)(Qs + row * 128 + ((ch ^ (row & 7)) << 4)) = v;
  }
  for (int e = tid; e < 2048; e += 512) {
    const int row = e >> 3, ch = e & 7; const int lt = base + r + (row - 64) * d;
    const bool valid = (lt >= s0) && (lt < s0 + L);
    u32x4 kv = {0u, 0u, 0u, 0u}, vv = {0u, 0u, 0u, 0u};
    if (valid) { kv = *(const u32x4*)(proj + (long)lt * NPROJ + 512 + h * 64 + ch * 8); vv = *(const u32x4*)(proj + (long)lt * NPROJ + 1024 + h * 64 + ch * 8); }
    *(u32x4*)(Ks + row * 128 + ((ch ^ (row & 7)) << 4)) = kv;
    u16* vd = Vt + (ch * 8) * 280 + kperm(row);
    vd[0 * 280] = (u16)(vv.x & 0xffff); vd[1 * 280] = (u16)(vv.x >> 16); vd[2 * 280] = (u16)(vv.y & 0xffff); vd[3 * 280] = (u16)(vv.y >> 16);
    vd[4 * 280] = (u16)(vv.z & 0xffff); vd[5 * 280] = (u16)(vv.z >> 16); vd[6 * 280] = (u16)(vv.w & 0xffff); vd[7 * 280] = (u16)(vv.w >> 16);
  }
  __syncthreads();
  const int sw = c16 & 7, tb = w & ~1;
  bf16x8 qf[2];
#pragma unroll
  for (int kk = 0; kk < 2; ++kk) qf[kk] = *(const bf16x8*)(Qs + (16 * w + c16) * 128 + (((kk * 4 + g) ^ sw) << 4));
  f32x4 sc[10];
#pragma unroll
  for (int t = 0; t < 10; ++t) {
    f32x4 a = {0.f, 0.f, 0.f, 0.f};
#pragma unroll
    for (int kk = 0; kk < 2; ++kk) {
      const bf16x8 kf = *(const bf16x8*)(Ks + ((tb + t) * 16 + c16) * 128 + (((kk * 4 + g) ^ sw) << 4));
      a = mfma16(kf, qf[kk], a);
    }
    sc[t] = a;
  }
  const int qi = 16 * w + c16;
  float mx = -1e30f;
#pragma unroll
  for (int t = 0; t < 10; ++t)
#pragma unroll
    for (int j = 0; j < 4; ++j) {
      const int kj = (tb + t) * 16 + g * 4 + j - 64;
      const int lt = base + r + kj * d;
      const int df = qi - kj;
      const bool valid = (df <= 64) && (df >= -64) && (lt >= s0) && (lt < s0 + L);
      const float s = valid ? sc[t][j] : -1e30f;
      sc[t][j] = s; mx = fmaxf(mx, s);
    }
  mx = fmaxf(mx, __shfl_xor(mx, 16)); mx = fmaxf(mx, __shfl_xor(mx, 32));
  float den = 0.f;
#pragma unroll
  for (int t = 0; t < 10; ++t)
#pragma unroll
    for (int j = 0; j < 4; ++j) { const float pe = (sc[t][j] > -1e29f) ? __expf(sc[t][j] - mx) : 0.f; sc[t][j] = pe; den += pe; }
  den += __shfl_xor(den, 16); den += __shfl_xor(den, 32);
  f32x4 oa[4];
#pragma unroll
  for (int n = 0; n < 4; ++n) oa[n] = (f32x4){0.f, 0.f, 0.f, 0.f};
#pragma unroll
  for (int tp = 0; tp < 5; ++tp) {
    u32x4 pu = {pk2(sc[2 * tp].x, sc[2 * tp].y), pk2(sc[2 * tp].z, sc[2 * tp].w), pk2(sc[2 * tp + 1].x, sc[2 * tp + 1].y), pk2(sc[2 * tp + 1].z, sc[2 * tp + 1].w)};
    const bf16x8 pa = __builtin_bit_cast(bf16x8, pu);
#pragma unroll
    for (int n = 0; n < 4; ++n) {
      const u16* vp = Vt + (n * 16 + c16) * 280 + ((tb >> 1) + tp) * 32 + g * 8;
      oa[n] = mfma16(*(const bf16x8*)vp, pa, oa[n]);
    }
  }
  u16* attp = (u16*)(ws + WS_ATTP); float* lse = (float*)(ws + WS_LSE);
  {
    const float inv = 1.f / den;
    const long lt = base + r + ((long)qi << dsh);
    u16* dst = attp + ((long)pat * TG + lt) * 512 + h * 64 + g * 4;
#pragma unroll
    for (int n = 0; n < 4; ++n) {
      u32x2 ov = {pk2(oa[n].x * inv, oa[n].y * inv), pk2(oa[n].z * inv, oa[n].w * inv)};
      *(u32x2*)(dst + n * 16) = ov;
    }
  }
  if (g == 0) { const long lt = base + r + ((long)qi << dsh); lse[((long)pat * TG + lt) * 8 + h] = mx + __logf(den); }
  __syncthreads();
}

DI void dnlocal_item(unsigned char* ws, unsigned char* smem, int item) {
  const int tidx = opaque_tid();
  const int ch = item >> 2, hd = item & 3;
  const int tid = tidx, lane = tid & 63, w = tid >> 6, c16 = lane & 15, g = lane >> 4;
  const int dir = tid >> 8, t8 = tid & 255;
  const u16* dnp = (const u16*)(ws + WS_DNP); const float* gates = (const float*)(ws + WS_GATES);
  unsigned char* Kl = smem; unsigned char* Ql = smem + 17408; unsigned char* Vl = smem + 34816;
  float* KK = (float*)(smem + 51200); float* QKm = (float*)(smem + 67584);
  float* Am = (float*)(smem + 83968);
  float* gcs = (float*)(smem + 116736);
  u16* Xs = (u16*)(smem + 51200);
  unsigned char* opnd = ws + WS_DNOP + (long)item * 2 * DNOP_BYTES;
  const long tok0 = (long)ch * 64;
  for (int e = tid; e < 3072; e += 512) {
    const int which = e >> 10, q = e & 1023, row = q >> 4, c8 = q & 15;
    const u32x4 v = *(const u32x4*)(dnp + (tok0 + row) * 1536 + which * 512 + hd * 128 + c8 * 8);
    unsigned char* dst = (which == 0) ? (Ql + row * 272) : (which == 1) ? (Kl + row * 272) : (Vl + row * 256);
    *(u32x4*)(dst + c8 * 16) = v;
  }
  if (tid < 128) {
    const int dd = tid >> 6, i = tid & 63, ri = dd ? 63 - i : i;
    const float be = gates[(tok0 + ri) * 16 + dd * 4 + hd];
    float gv = gates[(tok0 + ri) * 16 + 8 + dd * 4 + hd];
#pragma unroll
    for (int o = 1; o < 64; o <<= 1) { const float t = __shfl_up(gv, o); if (i >= o) gv += t; }
    gcs[dd * 64 + i] = gv; gcs[128 + dd * 64 + i] = be; gcs[256 + dd * 64 + i] = be * __expf(gv);
  }
  __syncthreads();
  {
    const int which = w >> 2, mt = w & 3;
    const unsigned char* Asrc = which ? Ql : Kl;
    f32x4 a4[4];
#pragma unroll
    for (int n = 0; n < 4; ++n) a4[n] = (f32x4){0.f, 0.f, 0.f, 0.f};
#pragma unroll
    for (int kk = 0; kk < 4; ++kk) {
      const bf16x8 af = *(const bf16x8*)(Asrc + (mt * 16 + c16) * 272 + (kk * 4 + g) * 16);
#pragma unroll
      for (int n = 0; n < 4; ++n) {
        const bf16x8 bfv = *(const bf16x8*)(Kl + (n * 16 + c16) * 272 + (kk * 4 + g) * 16);
        a4[n] = mfma16(af, bfv, a4[n]);
      }
    }
    float* dst = which ? QKm : KK;
#pragma unroll
    for (int n = 0; n < 4; ++n)
#pragma unroll
      for (int j = 0; j < 4; ++j) dst[(mt * 16 + g * 4 + j) * 64 + n * 16 + c16] = a4[n][j];
  }
  __syncthreads();
  {
    const float* gc = gcs + dir * 64; const float* be = gcs + 128 + dir * 64;
    u16* qkout = (u16*)(opnd + dir * DNOP_BYTES + OP_QK);
    for (int e = t8; e < 2048; e += 256) {
      const int i = e >> 5, j = (e & 31) * 2;
      const int ri = dir ? 63 - i : i, rj = dir ? 63 - j : j, rj1 = dir ? 62 - j : j + 1;
      const float gi = gc[i];
      const float d0 = __expf(gi - gc[j]), d1 = __expf(gi - gc[j + 1]);
      const float bi = be[i];
      Am[(dir * 64 + i) * 64 + j] = (j < i) ? bi * KK[ri * 64 + rj] * d0 : 0.f;
      Am[(dir * 64 + i) * 64 + j + 1] = (j + 1 < i) ? bi * KK[ri * 64 + rj1] * d1 : 0.f;
      const float q0 = (j <= i) ? QKm[ri * 64 + rj] * d0 : 0.f, q1 = (j + 1 <= i) ? QKm[ri * 64 + rj1] * d1 : 0.f;
      *(unsigned*)(qkout + i * 64 + kperm(j)) = pk2(q0, q1);
    }
  }
  __syncthreads();
  {
    const bool isu = t8 < 128;
    const unsigned char* src = isu ? (Vl + t8 * 2) : (Kl + (t8 - 128) * 2);
    const int sstr = isu ? 256 : 272;
    const float* scl = gcs + (isu ? 128 : 256) + dir * 64;
    const float* Ad = Am + dir * 4096;
    float X[64];
#pragma unroll
    for (int i = 0; i < 64; ++i) {
      const int ri = dir ? 63 - i : i;
      float a = bf2f(*(const u16*)(src + ri * sstr)) * scl[i];
#pragma unroll
      for (int j4 = 0; j4 < (i + 3) / 4; ++j4) {
        const f32x4 av = *(const f32x4*)(Ad + i * 64 + j4 * 4);
        if (4 * j4 + 0 < i) a -= av.x * X[4 * j4 + 0];
        if (4 * j4 + 1 < i) a -= av.y * X[4 * j4 + 1];
        if (4 * j4 + 2 < i) a -= av.z * X[4 * j4 + 2];
        if (4 * j4 + 3 < i) a -= av.w * X[4 * j4 + 3];
      }
      X[i] = a;
    }
    if (isu) {
      u32x4* dst = (u32x4*)(opnd + dir * DNOP_BYTES + OP_UT + t8 * 128);
#pragma unroll
      for (int q = 0; q < 8; ++q) { u32x4 o = {pk2(X[8 * q], X[8 * q + 1]), pk2(X[8 * q + 2], X[8 * q + 3]), pk2(X[8 * q + 4], X[8 * q + 5]), pk2(X[8 * q + 6], X[8 * q + 7])}; dst[q] = o; }
    } else {
      u16* xd = Xs + dir * 8192 + kperm(t8 - 128);
#pragma unroll
      for (int i = 0; i < 64; ++i) xd[i * 128] = f2bf(-X[i]);
    }
  }
  __syncthreads();
  {
    for (int e = tid; e < 2048; e += 512) {
      const int dd = e >> 10, q = e & 1023;
      *(u32x4*)(opnd + dd * DNOP_BYTES + OP_WN + q * 16) = *(const u32x4*)((const unsigned char*)Xs + dd * 16384 + q * 16);
    }
    for (int e = tid; e < 2048; e += 512) {
      const int dd = e >> 10, q = e & 1023, i = q >> 4, c8 = q & 15, ri = dd ? 63 - i : i;
      const float sc = __expf(gcs[dd * 64 + i]);
      const int kb = c8 >> 2, gg = c8 & 3;
      const u32x2 v0 = *(const u32x2*)(Ql + ri * 272 + (kb * 32 + gg * 4) * 2), v1 = *(const u32x2*)(Ql + ri * 272 + (kb * 32 + 16 + gg * 4) * 2);
      u32x4 o = {pk2(bflo(v0.x) * sc, bfhi(v0.x) * sc), pk2(bflo(v0.y) * sc, bfhi(v0.y) * sc), pk2(bflo(v1.x) * sc, bfhi(v1.x) * sc), pk2(bflo(v1.y) * sc, bfhi(v1.y) * sc)};
      *(u32x4*)(opnd + dd * DNOP_BYTES + OP_QD + q * 16) = o;
    }
    {
      const int dk = t8 & 127, half = t8 >> 7;
      const float gl = gcs[dir * 64 + 63];
      u32x4* dst = (u32x4*)(opnd + dir * DNOP_BYTES + OP_KDT + dk * 128 + half * 64);
#pragma unroll
      for (int q = 0; q < 4; ++q) {
        float v[8];
#pragma unroll
        for (int jj = 0; jj < 8; ++jj) {
          const int i = half * 32 + (jj >> 2) * 16 + q * 4 + (jj & 3), ri = dir ? 63 - i : i;
          v[jj] = bf2f(*(const u16*)(Kl + ri * 272 + dk * 2)) * __expf(gl - gcs[dir * 64 + i]);
        }
        u32x4 o = {pk2(v[0], v[1]), pk2(v[2], v[3]), pk2(v[4], v[5]), pk2(v[6], v[7])};
        dst[q] = o;
      }
      if (t8 == 0) ((float*)(ws + WS_EGL))[item * 2 + dir] = __expf(gl);
    }
  }
  __syncthreads();
}

constexpr int SCAN_BUF = 73728 + 256;
DI void glds4(const void* g, unsigned ldsoff) {
  __builtin_amdgcn_global_load_lds((const __attribute__((address_space(1))) void*)g, (LAS void*)(unsigned long)ldsoff, 4, 0, 0);
}
DI void scan_issue(const unsigned char* src, const float* egp, unsigned ldsbase, int tid) {
#pragma unroll
  for (int i = 0; i < 9; ++i) {
    const int q = tid + 512 * i;
    int sq;
    if (i < 4) sq = (q & ~15) | ((q & 15) ^ ((q >> 4) & 15));
    else sq = (q & ~7) | ((q & 7) ^ ((q >> 4) & 7));
    glds16(src + sq * 16, ldsbase + q * 16);
  }
  if (tid < 64) glds4(egp, ldsbase + 73728 + tid * 4);
}
#define SB_ __builtin_amdgcn_sched_barrier(0)
DI void scan_compute(const unsigned char* B, int chk, int dir, int hd, u16* obuf, f32x4 (&S)[8], int w, int c16, int g) {
  const float eg = *(const float*)(B + 73728);
  const int x15 = c16, x7 = (c16 >> 1) & 7;
  bf16x8 sb[4];
#pragma unroll
  for (int kb = 0; kb < 4; ++kb) {
    u32x4 u = {pk2(S[2 * kb].x, S[2 * kb].y), pk2(S[2 * kb].z, S[2 * kb].w), pk2(S[2 * kb + 1].x, S[2 * kb + 1].y), pk2(S[2 * kb + 1].z, S[2 * kb + 1].w)};
    sb[kb] = __builtin_bit_cast(bf16x8, u);
  }
  f32x4 va[4], oa[4];
#pragma unroll
  for (int mt = 0; mt < 4; ++mt) {
    const u32x2 uu = *(const u32x2*)(B + 57344 + (16 * w + c16) * 128 + (((mt * 2 + (g >> 1)) ^ x7) << 4) + (g & 1) * 8);
    va[mt] = (f32x4){bflo(uu.x), bfhi(uu.x), bflo(uu.y), bfhi(uu.y)};
    oa[mt] = (f32x4){0.f, 0.f, 0.f, 0.f};
  }
  const unsigned char* wrow = B + c16 * 256;
  bf16x8 f0[8], f1[8];
#define LDWQ_(dst, kb) _Pragma("unroll") for (int mt = 0; mt < 4; ++mt) { const unsigned char* ap = wrow + mt * 4096 + ((((kb) * 4 + g) ^ x15) << 4); dst[mt] = *(const bf16x8*)ap; dst[4 + mt] = *(const bf16x8*)(ap + 16384); }
#define MMWQ_(src, kb) _Pragma("unroll") for (int mt = 0; mt < 4; ++mt) { va[mt] = mfma16(src[mt], sb[kb], va[mt]); oa[mt] = mfma16(sb[kb], src[4 + mt], oa[mt]); }
  LDWQ_(f0, 0); LDWQ_(f1, 1); SB_;
  MMWQ_(f0, 0); SB_;
  LDWQ_(f0, 2); SB_;
  MMWQ_(f1, 1); SB_;
  LDWQ_(f1, 3); SB_;
  MMWQ_(f0, 2); SB_;
  {
    const unsigned char* qrow = B + 32768 + c16 * 128;
#pragma unroll
    for (int mt = 0; mt < 4; ++mt)
#pragma unroll
      for (int cb = 0; cb < 2; ++cb) f0[mt * 2 + cb] = *(const bf16x8*)(qrow + mt * 2048 + (((cb * 4 + g) ^ x7) << 4));
  }
  SB_;
  MMWQ_(f1, 3); SB_;
#undef LDWQ_
#undef MMWQ_
  bf16x8 vb[2];
#pragma unroll
  for (int cb = 0; cb < 2; ++cb) {
    u32x4 u = {pk2(va[2 * cb].x, va[2 * cb].y), pk2(va[2 * cb].z, va[2 * cb].w), pk2(va[2 * cb + 1].x, va[2 * cb + 1].y), pk2(va[2 * cb + 1].z, va[2 * cb + 1].w)};
    vb[cb] = __builtin_bit_cast(bf16x8, u);
  }
  const unsigned char* krow = B + 40960 + c16 * 128;
#define LDKD_(dst, t0) _Pragma("unroll") for (int t = 0; t < 4; ++t) _Pragma("unroll") for (int cb = 0; cb < 2; ++cb) dst[t * 2 + cb] = *(const bf16x8*)(krow + ((t0) + t) * 2048 + (((cb * 4 + g) ^ x7) << 4));
  LDKD_(f1, 0); SB_;
#pragma unroll
  for (int mt = 0; mt < 4; ++mt)
#pragma unroll
    for (int cb = 0; cb < 2; ++cb) oa[mt] = mfma16(vb[cb], f0[mt * 2 + cb], oa[mt]);
  SB_;
  LDKD_(f0, 4); SB_;
#pragma unroll
  for (int t = 0; t < 4; ++t) {
    f32x4 s = {S[t].x * eg, S[t].y * eg, S[t].z * eg, S[t].w * eg};
#pragma unroll
    for (int cb = 0; cb < 2; ++cb) s = mfma16(f1[t * 2 + cb], vb[cb], s);
    S[t] = s;
  }
  SB_;
#pragma unroll
  for (int t = 0; t < 4; ++t) {
    f32x4 s = {S[4 + t].x * eg, S[4 + t].y * eg, S[4 + t].z * eg, S[4 + t].w * eg};
#pragma unroll
    for (int cb = 0; cb < 2; ++cb) s = mfma16(f0[t * 2 + cb], vb[cb], s);
    S[4 + t] = s;
  }
#undef LDKD_
#pragma unroll
  for (int mt = 0; mt < 4; ++mt) {
    const int i = mt * 16 + c16;
    const long tok = (long)chk * 64 + (dir ? 63 - i : i);
    u32x2 ov = {pk2(oa[mt].x, oa[mt].y), pk2(oa[mt].z, oa[mt].w)};
    *(u32x2*)(obuf + tok * 512 + hd * 128 + 16 * w + g * 4) = ov;
  }
}
#undef SB_

DI void scan_chain(int grp, unsigned char* ws, unsigned char* smem, int chain) {
  const int tidx = opaque_tid();
  const int L = (grp == 0) ? 16384 : 2048, nc = L >> 6;
  const int dir = chain & 1, hd = (chain >> 1) & 3, sq = chain >> 3;
  const int tid = tidx, lane = tid & 63, w = tid >> 6, c16 = lane & 15, g = lane >> 4;
  const int chunk0 = sq * nc;
  const float* egl = (const float*)(ws + WS_EGL);
  u16* obuf = (u16*)(ws + WS_OF) + (long)dir * TG * 512;
  f32x4 S[8];
#pragma unroll
  for (int t = 0; t < 8; ++t) S[t] = (f32x4){0.f, 0.f, 0.f, 0.f};
  __syncthreads();
  {
    const int chk = chunk0 + (dir ? nc - 1 : 0);
    const long it = (long)(chk * 4 + hd) * 2 + dir;
    scan_issue(ws + WS_DNOP + it * DNOP_BYTES, egl + it, 0u, tid);
  }
  __syncthreads();
  for (int m = 0; m < nc; ++m) {
    const int chk = chunk0 + (dir ? nc - 1 - m : m);
    if (m + 1 < nc) {
      const int chn = chunk0 + (dir ? nc - 2 - m : m + 1);
      const long it = (long)(chn * 4 + hd) * 2 + dir;
      scan_issue(ws + WS_DNOP + it * DNOP_BYTES, egl + it, (unsigned)(((m + 1) & 1) * SCAN_BUF), tid);
    }
    scan_compute(smem + (m & 1) * SCAN_BUF, chk, dir, hd, obuf, S, w, c16, g);
    __syncthreads();
  }
}

DI void phase_merge(const Params& p, unsigned char* ws) {
  const int tidx = opaque_tid();
  const int lane = tidx & 63;
  const int gw = blockIdx.x * 8 + (tidx >> 6), NW = gridDim.x * 8;
  const u16* attp = (const u16*)(ws + WS_ATTP); const float* lse = (const float*)(ws + WS_LSE);
  const u16* of = (const u16*)(ws + WS_OF); const u16* proj = (const u16*)(ws + WS_PROJ);
  u16* mix = (u16*)(ws + WS_NBUF);
  f32x4 gn0 = *(const f32x4*)(p.out_norm + (lane & 15) * 8), gn1 = *(const f32x4*)(p.out_norm + (lane & 15) * 8 + 4);
  for (int t = gw; t < TG; t += NW) {
    {
      const int h = lane >> 3;
      const float l0 = lse[((long)0 * TG + t) * 8 + h], l1 = lse[((long)1 * TG + t) * 8 + h], l2 = lse[((long)2 * TG + t) * 8 + h];
      const float mx = fmaxf(l0, fmaxf(l1, l2));
      float w0 = __expf(l0 - mx), w1 = __expf(l1 - mx), w2 = __expf(l2 - mx);
      const float inv = 1.f / (w0 + w1 + w2); w0 *= inv; w1 *= inv; w2 *= inv;
      const u32x4 a = *(const u32x4*)(attp + ((long)0 * TG + t) * 512 + lane * 8);
      const u32x4 b = *(const u32x4*)(attp + ((long)1 * TG + t) * 512 + lane * 8);
      const u32x4 c = *(const u32x4*)(attp + ((long)2 * TG + t) * 512 + lane * 8);
      u32x4 o;
      o.x = pk2(w0 * bflo(a.x) + w1 * bflo(b.x) + w2 * bflo(c.x), w0 * bfhi(a.x) + w1 * bfhi(b.x) + w2 * bfhi(c.x));
      o.y = pk2(w0 * bflo(a.y) + w1 * bflo(b.y) + w2 * bflo(c.y), w0 * bfhi(a.y) + w1 * bfhi(b.y) + w2 * bfhi(c.y));
      o.z = pk2(w0 * bflo(a.z) + w1 * bflo(b.z) + w2 * bflo(c.z), w0 * bfhi(a.z) + w1 * bfhi(b.z) + w2 * bfhi(c.z));
      o.w = pk2(w0 * bflo(a.w) + w1 * bflo(b.w) + w2 * bflo(c.w), w0 * bfhi(a.w) + w1 * bfhi(b.w) + w2 * bfhi(c.w));
      *(u32x4*)(mix + (long)t * 1024 + lane * 8) = o;
    }
    {
      const u32x4 a = *(const u32x4*)(of + (long)t * 512 + lane * 8);
      const u32x4 b = *(const u32x4*)(of + ((long)TG + t) * 512 + lane * 8);
      const u32x4 gg = *(const u32x4*)(proj + (long)t * NPROJ + 3072 + lane * 8);
      float o[8] = {bflo(a.x) + bflo(b.x), bfhi(a.x) + bfhi(b.x), bflo(a.y) + bflo(b.y), bfhi(a.y) + bfhi(b.y),
                    bflo(a.z) + bflo(b.z), bfhi(a.z) + bfhi(b.z), bflo(a.w) + bflo(b.w), bfhi(a.w) + bfhi(b.w)};
      float ss = 0.f;
#pragma unroll
      for (int i = 0; i < 8; ++i) ss += o[i] * o[i];
      ss += __shfl_xor(ss, 1); ss += __shfl_xor(ss, 2); ss += __shfl_xor(ss, 4); ss += __shfl_xor(ss, 8);
      const float rs = rsqrtf(ss * (1.f / 128.f) + 1e-6f);
      const float gv[8] = {bflo(gg.x), bfhi(gg.x), bflo(gg.y), bfhi(gg.y), bflo(gg.z), bfhi(gg.z), bflo(gg.w), bfhi(gg.w)};
      const float gn[8] = {gn0.x, gn0.y, gn0.z, gn0.w, gn1.x, gn1.y, gn1.z, gn1.w};
      float y[8];
#pragma unroll
      for (int i = 0; i < 8; ++i) y[i] = o[i] * rs * gn[i] * siluf_(gv[i]);
      u32x4 ov = {pk2(y[0], y[1]), pk2(y[2], y[3]), pk2(y[4], y[5]), pk2(y[6], y[7])};
      *(u32x4*)(mix + (long)t * 1024 + 512 + lane * 8) = ov;
    }
  }
}


#define XB_TMO      128
#define XB_XCNT(j)  (256  + 64 * (j))
#define XB_XSUB(j)  (1280 + 64 * (j))
#define XB_XGEN(j)  (2304 + 64 * (j))
#define XB_TOP      3328
#define XB_TOPGEN   3392
#define XCD_BAR_WORDS 3456
#define XB_SPIN_CAP (1u << 18)
DI unsigned xb_ld(unsigned* p)              { return __hip_atomic_load(p, __ATOMIC_RELAXED, __HIP_MEMORY_SCOPE_AGENT); }
DI unsigned xb_add(unsigned* p, unsigned v) { return __hip_atomic_fetch_add(p, v, __ATOMIC_RELAXED, __HIP_MEMORY_SCOPE_AGENT); }
DI unsigned xb_xcc_id() { return (unsigned)__builtin_amdgcn_s_getreg((3 << 11) | 20) & 0xFu; }
#define XB_SPIN(cond, bar) do { unsigned _sp = 0; while (cond) { __builtin_amdgcn_s_sleep(1); \
    if ((++_sp & 255u) == 0u) { if (xb_ld(&(bar)[XB_TMO])) break; if (_sp > XB_SPIN_CAP) { atomicAdd(&(bar)[XB_TMO], 1u); break; } } } } while (0)
struct XcdBarrier { unsigned* bar; unsigned x; volatile LAS unsigned* st; };
DI XcdBarrier xcd_barrier_post(unsigned* bar, volatile LAS unsigned* st) {
  XcdBarrier b; b.bar = bar; b.x = xb_xcc_id(); b.st = st;
  if (opaque_tid() == 0) (void)xb_add(&bar[XB_XCNT(b.x)], 1u);
  return b;
}
DI void xcd_barrier_complete(unsigned* bar, unsigned x, unsigned& nloc, unsigned& nx) {
  const unsigned G = gridDim.x * gridDim.y * gridDim.z;
  unsigned sum, cnt, mine, sp = 0u;
  for (;;) {
    sum = 0u; cnt = 0u; mine = 0u;
#pragma unroll
    for (unsigned j = 0; j < 16; ++j) { const unsigned c = xb_ld(&bar[XB_XCNT(j)]); sum += c; cnt += (c > 0u) ? 1u : 0u; mine = (j == x) ? c : mine; }
    if (sum == G) break;
    __builtin_amdgcn_s_sleep(1);
    if ((++sp & 255u) == 0u) { if (xb_ld(&bar[XB_TMO])) break; if (sp > XB_SPIN_CAP) { atomicAdd(&bar[XB_TMO], 1u); break; } }
  }
  nloc = mine > 0u ? mine : 1u; nx = cnt > 0u ? cnt : 1u;
}
DI void xcd_barrier(const XcdBarrier& b) {
  asm volatile("s_waitcnt vmcnt(0)" ::: "memory");
  __syncthreads();
  if (opaque_tid() == 0) {
    unsigned* bar = b.bar;
    __builtin_amdgcn_s_waitcnt(0);
    unsigned nloc = b.st[0], nx = b.st[1];
    if (nloc == 0u) { xcd_barrier_complete(bar, b.x, nloc, nx); b.st[0] = nloc; b.st[1] = nx; }
    const unsigned old = xb_add(&bar[XB_XSUB(b.x)], 1u);
    const unsigned gen = old / nloc;
    if (old + 1u == (gen + 1u) * nloc) {
      __builtin_amdgcn_fence(__ATOMIC_RELEASE, "agent");
      asm volatile("s_waitcnt vmcnt(0)" ::: "memory");
      const unsigned og = xb_add(&bar[XB_TOP], 1u);
      const unsigned tg = og / nx;
      if (og + 1u == (tg + 1u) * nx) xb_add(&bar[XB_TOPGEN], 1u);
      else XB_SPIN(xb_ld(&bar[XB_TOPGEN]) == tg, bar);
      __builtin_amdgcn_fence(__ATOMIC_ACQUIRE, "agent");
      xb_add(&bar[XB_XGEN(b.x)], 1u);
      asm volatile("s_waitcnt vmcnt(0)" ::: "memory");
    } else {
      XB_SPIN(xb_ld(&bar[XB_XGEN(b.x)]) == gen, bar);
      __builtin_amdgcn_fence(__ATOMIC_ACQUIRE, "agent");
      asm volatile("s_waitcnt vmcnt(0)" ::: "memory");
    }
  }
  __syncthreads();
}

extern __shared__ __attribute__((aligned(16))) unsigned char smem[];

__global__ void __launch_bounds__(512) mk_fwd(Params p) {
  cg::grid_group grid = cg::this_grid();
  unsigned char* ws = p.ws;
  volatile LAS unsigned* xst = (volatile LAS unsigned*)(unsigned long)(LDS_BYTES - 16);
  if (opaque_tid() == 0) { xst[0] = 0u; xst[1] = 0u; }
  __syncthreads();
  const XcdBarrier xb = xcd_barrier_post((unsigned*)(ws + WS_BAR), xst);
  {
    const long gtid = (long)blockIdx.x * 512 + opaque_tid(), nthr = (long)gridDim.x * 512;
    conv_weight(p.w_in, 3600, 1024, NPROJ, (u16*)(ws + WS_WIN), 0, nullptr, gtid, nthr);
    conv_weight(p.w_out, 1024, 1024, 1024, (u16*)(ws + WS_WOUT), 0, nullptr, gtid, nthr);
    conv_weight(p.w_up, 5632, 1024, 5632, (u16*)(ws + WS_WUP), 1, p.norm2, gtid, nthr);
    conv_weight(p.w_down, 1024, 2816, 1024, (u16*)(ws + WS_WDOWN), 0, nullptr, gtid, nthr);
  }
#pragma unroll 1
  for (int grp = 0; grp < 3; ++grp) {
    const float* xg = (grp == 0) ? p.xp : (p.xs + (long)(grp - 1) * TG * 1024);
    float* outg = p.out + (long)grp * TG * 1024;
    REP(0) { phase_norm(p, xg, ws, smem); __syncthreads(); }
    if (grp == 0) grid.sync(); else GSYNC();
    REP(1) gemm_phase<1>(p, grp, ws, smem, xg, outg);
    GSYNC();
    phase_prep(p, grp, ws);
    GSYNC();
    {
      REP(2) for (int it = blockIdx.x; it < 6144; it += gridDim.x) attn_item(grp, ws, smem, it);
      REP(4) for (int it = blockIdx.x; it < 2048; it += gridDim.x) dnlocal_item(ws, smem, it);
    }
    GSYNC();
    {
      const int nchains = (grp == 0) ? 16 : 128;
      REP(3) for (int c = blockIdx.x; c < nchains; c += gridDim.x) scan_chain(grp, ws, smem, c);
    }
    GSYNC();
    REP(5) phase_merge(p, ws);
    GSYNC();
    REP(1) gemm_phase<2>(p, grp, ws, smem, xg, outg);
    GSYNC();
    REP(1) gemm_phase<3>(p, grp, ws, smem, xg, outg);
    GSYNC();
    gemm_phase<4>(p, grp, ws, smem, xg, outg);
    if (grp < 2) GSYNC();
  }
}

extern "C" void kernel_launch(void* const* d_in, const int* in_sizes, int n_in, void* d_out, int out_size,
                              void* d_ws, size_t ws_size, hipStream_t stream) {
  static int grid_blocks = 0;
  if (!grid_blocks) {
    int dev = 0, cus = 0, per_cu = 0;
    (void)hipGetDevice(&dev);
    (void)hipDeviceGetAttribute(&cus, hipDeviceAttributeMultiprocessorCount, dev);
    (void)hipFuncSetAttribute((const void*)mk_fwd, hipFuncAttributeMaxDynamicSharedMemorySize, LDS_BYTES);
    (void)hipOccupancyMaxActiveBlocksPerMultiprocessor(&per_cu, (const void*)mk_fwd, 512, LDS_BYTES);
    if (per_cu < 1) per_cu = 1;
    grid_blocks = cus * per_cu;
    if (ws_size < 883 * MiB) fprintf(stderr, "workspace too small: %zu\n", ws_size);
  }
  Params p{};
  p.xp = (const float*)d_in[0]; p.xs = (const float*)d_in[1]; p.norm1 = (const float*)d_in[2]; p.w_in = (const float*)d_in[3];
  p.qn = (const float*)d_in[4]; p.kn = (const float*)d_in[5]; p.dn_conv_w = (const float*)d_in[6]; p.a_log = (const float*)d_in[7];
  p.dt_bias = (const float*)d_in[8]; p.out_norm = (const float*)d_in[9]; p.w_out = (const float*)d_in[10]; p.norm2 = (const float*)d_in[11];
  p.w_up = (const float*)d_in[12]; p.ffn_cw = (const float*)d_in[13]; p.ffn_cb = (const float*)d_in[14]; p.w_down = (const float*)d_in[15];
  p.out = (float*)d_out; p.ws = (unsigned char*)d_ws;
  (void)hipMemsetAsync((unsigned char*)d_ws + WS_BAR, 0, 16384, stream);
  void* args[] = {&p};
  hipError_t e = hipLaunchCooperativeKernel((void*)mk_fwd, dim3(grid_blocks), dim3(512), args, LDS_BYTES, stream);
  if (e != hipSuccess) fprintf(stderr, "cooperative launch failed: %s (grid %d)\n", hipGetErrorString(e), grid_blocks);
}
```

```cpp
#include <hip/hip_runtime.h>
#include <hip/hip_cooperative_groups.h>
#include <cstdio>
namespace cg = cooperative_groups;

typedef unsigned short u16;
typedef __attribute__((ext_vector_type(8))) short bf16x8;
typedef __attribute__((ext_vector_type(4))) float f32x4;
typedef __attribute__((ext_vector_type(4))) unsigned u32x4;
typedef __attribute__((ext_vector_type(2))) unsigned u32x2;
typedef short s16x4 __attribute__((ext_vector_type(4)));
typedef __bf16 bf2_t __attribute__((ext_vector_type(2)));
typedef float f2_t __attribute__((ext_vector_type(2)));
#define DI __device__ __forceinline__

constexpr int TG = 32768;
constexpr int NPROJ = 3584;
constexpr size_t MiB = 1u << 20;
constexpr size_t WS_WIN = 0, WS_WOUT = 7 * MiB, WS_WUP = 9 * MiB, WS_WDOWN = 20 * MiB;
constexpr size_t WS_GATES = 27 * MiB, WS_LSE = 29 * MiB, WS_ROWSQ = 32 * MiB, WS_EGL = 34 * MiB;
constexpr size_t WS_BAR = 34 * MiB + 512 * 1024;
constexpr size_t WS_NBUF = 35 * MiB;
constexpr size_t WS_PROJ = 99 * MiB;
constexpr size_t WS_HB = WS_PROJ, WS_ACT = WS_PROJ + 64 * MiB;
constexpr size_t WS_DNP = 339 * MiB, WS_ATTP = 435 * MiB, WS_DNOP = 531 * MiB, WS_OF = 819 * MiB;
constexpr int DNOP_BYTES = 73728;
constexpr int OP_WN = 0, OP_QD = 16384, OP_QK = 32768, OP_KDT = 40960, OP_UT = 57344;
constexpr int LDS_BYTES = 163840;
#ifndef PROBE_MASK
#define PROBE_MASK 0
#endif
#define GSYNC() do { xcd_barrier(xb); if ((PROBE_MASK >> 7) & 1) xcd_barrier(xb); } while (0)
#define REP(bit) for (int rep_ = 0; rep_ < (((PROBE_MASK) >> (bit)) & 1) + 1; ++rep_)

struct Params {
  const float *xp, *xs, *norm1, *w_in, *qn, *kn, *dn_conv_w, *a_log, *dt_bias, *out_norm, *w_out, *norm2, *w_up, *ffn_cw, *ffn_cb, *w_down;
  float* out; unsigned char* ws;
};

DI float bf2f(unsigned v) { return __uint_as_float(v << 16); }
DI float bflo(unsigned v) { return __uint_as_float(v << 16); }
DI float bfhi(unsigned v) { return __uint_as_float(v & 0xffff0000u); }
DI unsigned pk2(float lo, float hi) { f2_t v = {lo, hi}; bf2_t r = __builtin_convertvector(v, bf2_t); return __builtin_bit_cast(unsigned, r); }
DI u16 f2bf(float x) { return (u16)(pk2(x, 0.f) & 0xffffu); }
DI int opaque_tid() {
  const int wv = __builtin_amdgcn_readfirstlane((int)threadIdx.x >> 6);
  int ln;
  asm volatile("v_mbcnt_lo_u32_b32 %0, -1, 0\n\tv_mbcnt_hi_u32_b32 %0, -1, %0" : "=v"(ln));
  return (wv << 6) | ln; }
DI float dpp_f(float v, const int ctrl_sel) {
  const int x = __float_as_int(v);
  int r;
  if (ctrl_sel == 0) r = __builtin_amdgcn_update_dpp(x, x, 0xB1, 0xF, 0xF, true);
  else if (ctrl_sel == 1) r = __builtin_amdgcn_update_dpp(x, x, 0x4E, 0xF, 0xF, true);
  else if (ctrl_sel == 2) r = __builtin_amdgcn_update_dpp(x, x, 0x141, 0xF, 0xF, true);
  else r = __builtin_amdgcn_update_dpp(x, x, 0x140, 0xF, 0xF, true);
  return __int_as_float(r);
}
DI float sum16(float v) {
  v += dpp_f(v, 0); v += dpp_f(v, 1); v += dpp_f(v, 2); v += dpp_f(v, 3);
  return v;
}
DI float wave_sum(float v) {
  v = sum16(v);
  v += __shfl_xor(v, 16); v += __shfl_xor(v, 32);
  return v;
}
DI f32x4 mfma16(bf16x8 a, bf16x8 b, f32x4 c) { return __builtin_amdgcn_mfma_f32_16x16x32_bf16(a, b, c, 0, 0, 0); }
#define LAS __attribute__((address_space(3)))
DI void glds16(const void* g, unsigned ldsoff) {
  __builtin_amdgcn_global_load_lds((const __attribute__((address_space(1))) void*)g, (LAS void*)(unsigned long)ldsoff, 16, 0, 0);
}
DI int kperm(int k) { return (k & ~31) | (((k >> 2) & 3) << 3) | (((k >> 4) & 1) << 2) | (k & 3); }
DI float sigmoidf_(float x) { return __builtin_amdgcn_rcpf(1.f + __expf(-x)); }
DI float siluf_(float x) { return x * __builtin_amdgcn_rcpf(1.f + __expf(-x)); }

DI void conv_weight(const float* __restrict__ W, int Nsrc, int K, int Nout, u16* __restrict__ WT, int mode, const float* __restrict__ scale,
                    long gtid, long nthr) {
  const int kgn = K >> 3;
  for (long idx = gtid; idx < (long)Nout * kgn; idx += nthr) {
    const int n = (int)(idx % Nout), kg = (int)(idx / Nout);
    int src = n;
    if (mode == 1) { const int pn = n >> 8, ct = n & 255; src = (ct < 128) ? (pn * 128 + ct) : (2816 + pn * 128 + ct - 128); }
    float v[8];
#pragma unroll
    for (int j = 0; j < 8; ++j) { const int k = kg * 8 + j; const float s = scale ? scale[k] : 1.f; v[j] = W[(long)k * Nsrc + src] * s; }
    u32x4 o = {pk2(v[0], v[1]), pk2(v[2], v[3]), pk2(v[4], v[5]), pk2(v[6], v[7])};
    *(u32x4*)(WT + (long)n * K + kg * 8) = o;
  }
}

DI void phase_norm(const Params& p, const float* __restrict__ xg, unsigned char* ws, unsigned char* smem) {
  const int tidx = opaque_tid();
  f32x4* gw4 = (f32x4*)smem;
  float* gwf = (float*)smem;
  for (int e = tidx; e < 1024 * 16; e += 512) {
    const int k = e >> 4, jg = e & 15;
    const int ln = (k >> 2) & 63, j = k >> 8, ee = k & 3, q = jg >> 2, cmp = jg & 3;
    gwf[((((j * 4 + ee) * 4 + q) * 64 + ln) << 2) + cmp] = p.w_in[(long)k * 3600 + 3584 + jg];
  }
  __syncthreads();
  const int wave = tidx >> 6, lane = tidx & 63;
  u16* nbuf = (u16*)(ws + WS_NBUF); float* gates = (float*)(ws + WS_GATES);
  f32x4 vn[4];
  {
    const f32x4* xr = (const f32x4*)(xg + (long)(blockIdx.x * 8 + wave) * 1024);
#pragma unroll
    for (int j = 0; j < 4; ++j) vn[j] = xr[lane + 64 * j];
  }
  for (int row = blockIdx.x * 8 + wave; row < TG; row += gridDim.x * 8) {
    f32x4 v[4]; float ss = 0.f;
#pragma unroll
    for (int j = 0; j < 4; ++j) { v[j] = vn[j]; ss += v[j].x * v[j].x + v[j].y * v[j].y + v[j].z * v[j].z + v[j].w * v[j].w; }
    {
      const int rn = row + gridDim.x * 8;
      const f32x4* xr = (const f32x4*)(xg + (long)(rn < TG ? rn : row) * 1024);
#pragma unroll
      for (int j = 0; j < 4; ++j) vn[j] = xr[lane + 64 * j];
    }
    ss = wave_sum(ss);
    const float rs = rsqrtf(ss * (1.f / 1024.f) + 1e-6f);
    float ga[16];
#pragma unroll
    for (int i = 0; i < 16; ++i) ga[i] = 0.f;
#pragma unroll
    for (int j = 0; j < 4; ++j) {
      const f32x4 nw = ((const f32x4*)p.norm1)[lane + 64 * j];
      v[j].x *= rs * nw.x; v[j].y *= rs * nw.y; v[j].z *= rs * nw.z; v[j].w *= rs * nw.w;
      u32x2 o = {pk2(v[j].x, v[j].y), pk2(v[j].z, v[j].w)};
      *(u32x2*)(nbuf + (long)row * 1024 + 4 * (lane + 64 * j)) = o;
#pragma unroll
      for (int e = 0; e < 4; ++e) {
        const float xv = v[j][e];
#pragma unroll
        for (int q = 0; q < 4; ++q) {
          const f32x4 w4 = gw4[((j * 4 + e) * 4 + q) * 64 + lane];
          ga[4 * q + 0] += xv * w4.x; ga[4 * q + 1] += xv * w4.y; ga[4 * q + 2] += xv * w4.z; ga[4 * q + 3] += xv * w4.w;
        }
        __builtin_amdgcn_sched_barrier(0);
      }
    }
    float r = 0.f;
#pragma unroll
    for (int i = 0; i < 16; ++i) { const float s = wave_sum(ga[i]); r = (lane == i) ? s : r; }
    if (lane < 16) {
      float o;
      if (lane < 8) o = sigmoidf_(r);
      else { const int jj = lane - 8; const float z = r + p.dt_bias[jj]; const float ez = __expf(z); const float sp = (z > 20.f) ? z : ((ez < 0.02f) ? ez * (1.f - ez * (0.5f - ez * (1.f / 3.f))) : __logf(1.f + ez)); o = -__expf(p.a_log[jj]) * sp; }
      gates[(long)row * 16 + lane] = o;
    }
  }
}

DI void phase_prep(const Params& p, int grp, unsigned char* ws) {
  const int tidx = opaque_tid();
  const int L = (grp == 0) ? 16384 : 2048;
  const int lane = tidx & 63;
  const int gw = blockIdx.x * 8 + (tidx >> 6), NW = gridDim.x * 8;
  u16* proj = (u16*)(ws + WS_PROJ);
  {
    const int i = lane & 15;
    const float f0 = exp2f(-(float)(2 * i) * (13.287712379549449f / 32.f)), f1 = exp2f(-(float)(2 * i + 1) * (13.287712379549449f / 32.f));
    for (int tb = gw; tb < TG; tb += 4 * NW) {
      unsigned elo[4][4], ehi[4][4];
#pragma unroll
      for (int kt = 0; kt < 4; ++kt)
#pragma unroll
        for (int k = 0; k < 4; ++k) {
          const int tt = tb + kt * NW, t = tt < TG ? tt : TG - 1, hs = (lane >> 4) + 4 * k;
          const u16* ptr = proj + (long)t * NPROJ + hs * 64;
          elo[kt][k] = *(const unsigned*)(ptr + 2 * i); ehi[kt][k] = *(const unsigned*)(ptr + 32 + 2 * i);
        }
#pragma unroll
      for (int kt = 0; kt < 4; ++kt) {
        const int t = tb + kt * NW;
        if (t >= TG) break;
        float s0, c0, s1, c1;
        {
          const float pos = (float)(t & (L - 1));
          __sincosf(pos * f0, &s0, &c0); __sincosf(pos * f1, &s1, &c1);
        }
#pragma unroll
        for (int k = 0; k < 4; ++k) {
          const int hs = (lane >> 4) + 4 * k;
          u16* ptr = proj + (long)t * NPROJ + hs * 64;
          float x1a = bflo(elo[kt][k]), x1b = bfhi(elo[kt][k]), x2a = bflo(ehi[kt][k]), x2b = bfhi(ehi[kt][k]);
          float ss = x1a * x1a + x1b * x1b + x2a * x2a + x2b * x2b;
          ss = sum16(ss);
          const float rs = __builtin_amdgcn_rsqf(ss * (1.f / 64.f) + 1e-6f);
          const float* gn = (hs < 8) ? p.qn : p.kn;
          const float sc = (hs < 8) ? 0.125f : 1.f;
          x1a *= rs * gn[2 * i]; x1b *= rs * gn[2 * i + 1]; x2a *= rs * gn[32 + 2 * i]; x2b *= rs * gn[33 + 2 * i];
          const float o1a = (x1a * c0 - x2a * s0) * sc, o2a = (x2a * c0 + x1a * s0) * sc;
          const float o1b = (x1b * c1 - x2b * s1) * sc, o2b = (x2b * c1 + x1b * s1) * sc;
          *(unsigned*)(ptr + 2 * i) = pk2(o1a, o1b); *(unsigned*)(ptr + 32 + 2 * i) = pk2(o2a, o2b);
        }
      }
    }
  }
  {
    u16* dnp = (u16*)(ws + WS_DNP);
    const int q = lane >> 4, cb = lane & 15;
    for (int unit = gw; unit < 12 * (TG / 64); unit += NW) {
      const int s = unit % 12, r = unit / 12, t0 = r * 64;
      const int c = s * 128 + cb * 8;
      f32x4 wlo[5], whi[5];
#pragma unroll
      for (int j = 0; j < 5; ++j) { wlo[j] = *(const f32x4*)(p.dn_conv_w + j * 1536 + c); whi[j] = *(const f32x4*)(p.dn_conv_w + j * 1536 + c + 4); }
      const u16* src = proj + 1536 + c;
      const int ts = t0 + 16 * q, pos_s = (t0 & (L - 1)) + 16 * q;
      const u32x4 zero4 = {0u, 0u, 0u, 0u};
      u32x4 win[5];
      win[0] = (pos_s >= 2) ? *(const u32x4*)(src + (long)(ts - 2) * NPROJ) : zero4;
      win[1] = (pos_s >= 1) ? *(const u32x4*)(src + (long)(ts - 1) * NPROJ) : zero4;
      win[2] = *(const u32x4*)(src + (long)ts * NPROJ);
      win[3] = *(const u32x4*)(src + (long)(ts + 1) * NPROJ);
      u32x4 nw[16];
#pragma unroll
      for (int u = 0; u < 16; ++u) nw[u] = (pos_s + u + 2 < L) ? *(const u32x4*)(src + (long)(ts + u + 2) * NPROJ) : zero4;
      const float qs = (s < 4) ? 0.08838834764831845f : 1.f;
#pragma unroll
      for (int u = 0; u < 16; ++u) {
        win[4] = nw[u];
        float a[8];
#pragma unroll
        for (int e = 0; e < 8; ++e) a[e] = 0.f;
#pragma unroll
        for (int j = 0; j < 5; ++j) {
          a[0] += wlo[j].x * bflo(win[j].x); a[1] += wlo[j].y * bfhi(win[j].x); a[2] += wlo[j].z * bflo(win[j].y); a[3] += wlo[j].w * bfhi(win[j].y);
          a[4] += whi[j].x * bflo(win[j].z); a[5] += whi[j].y * bfhi(win[j].z); a[6] += whi[j].z * bflo(win[j].w); a[7] += whi[j].w * bfhi(win[j].w);
        }
        float ss = 0.f;
#pragma unroll
        for (int e = 0; e < 8; ++e) { a[e] = siluf_(a[e]); ss += a[e] * a[e]; }
        if (s < 8) {
          ss = sum16(ss);
          const float rs = __builtin_amdgcn_rsqf(ss + 1e-6f) * qs;
#pragma unroll
          for (int e = 0; e < 8; ++e) a[e] *= rs;
        }
        u32x4 o = {pk2(a[0], a[1]), pk2(a[2], a[3]), pk2(a[4], a[5]), pk2(a[6], a[7])};
        *(u32x4*)(dnp + (long)(ts + u) * 1536 + c) = o;
#pragma unroll
        for (int j = 0; j < 4; ++j) win[j] = win[j + 1];
      }
    }
  }
}

DI void attn_item(int grp, unsigned char* ws, unsigned char* smem, int item) {
  const int tidx = opaque_tid();
  const int L = (grp == 0) ? 16384 : 2048;
  const int pat = item >> 11, rem = item & 2047, h = rem & 7, bi = rem >> 3;
  const int dsh = pat * 2, d = 1 << dsh;
  const int st = bi >> dsh, r = bi & (d - 1), base = st * (128 << dsh), s0 = base & ~(L - 1);
  const int tid = tidx, lane = tid & 63, w = tid >> 6, c16 = lane & 15, g = lane >> 4;
  const u16* proj = (const u16*)(ws + WS_PROJ);
  unsigned char* Qs = smem; unsigned char* Ks = smem + 16384;
  const unsigned VS = 49152u;
  for (int e = tid; e < 1024; e += 512) {
    const int row = e >> 3, ch = e & 7; const long lt = base + r + (row << dsh);
    const u32x4 v = *(const u32x4*)(proj + lt * NPROJ + h * 64 + ch * 8);
    *(u32x4*)(Qs + row * 128 + ((ch ^ (row & 7)) << 4)) = v;
  }
  for (int e = tid; e < 2048; e += 512) {
    const int row = e >> 3, ch = e & 7; const int lt = base + r + (row - 64) * d;
    const bool valid = (lt >= s0) && (lt < s0 + L);
    u32x4 kv = {0u, 0u, 0u, 0u}, vv = {0u, 0u, 0u, 0u};
    if (valid) { kv = *(const u32x4*)(proj + (long)lt * NPROJ + 512 + h * 64 + ch * 8); vv = *(const u32x4*)(proj + (long)lt * NPROJ + 1024 + h * 64 + ch * 8); }
    *(u32x4*)(Ks + row * 128 + ((ch ^ (row & 7)) << 4)) = kv;
    *(u32x4*)(smem + VS + row * 160 + ch * 16) = vv;
  }
  __syncthreads();
  const int sw = c16 & 7, tb = w & ~1;
  bf16x8 qf[2];
#pragma unroll
  for (int kk = 0; kk < 2; ++kk) qf[kk] = *(const bf16x8*)(Qs + (16 * w + c16) * 128 + (((kk * 4 + g) ^ sw) << 4));
  f32x4 sc[10];
  {
    bf16x8 kf[10][2];
#pragma unroll
    for (int t = 0; t < 10; ++t)
#pragma unroll
      for (int kk = 0; kk < 2; ++kk) kf[t][kk] = *(const bf16x8*)(Ks + ((tb + t) * 16 + c16) * 128 + (((kk * 4 + g) ^ sw) << 4));
    __builtin_amdgcn_sched_barrier(0);
#pragma unroll
    for (int t = 0; t < 10; ++t) {
      f32x4 a = {0.f, 0.f, 0.f, 0.f};
#pragma unroll
      for (int kk = 0; kk < 2; ++kk) a = mfma16(kf[t][kk], qf[kk], a);
      sc[t] = a;
    }
  }
  const int qi = 16 * w + c16;
  float mx = -1e30f;
#pragma unroll
  for (int t = 0; t < 10; ++t)
#pragma unroll
    for (int j = 0; j < 4; ++j) {
      const int kj = (tb + t) * 16 + g * 4 + j - 64;
      const int lt = base + r + kj * d;
      const int df = qi - kj;
      const bool valid = (df <= 64) && (df >= -64) && (lt >= s0) && (lt < s0 + L);
      const float s = valid ? sc[t][j] : -1e30f;
      sc[t][j] = s; mx = fmaxf(mx, s);
    }
  mx = fmaxf(mx, __shfl_xor(mx, 16)); mx = fmaxf(mx, __shfl_xor(mx, 32));
  float den = 0.f;
#pragma unroll
  for (int t = 0; t < 10; ++t)
#pragma unroll
    for (int j = 0; j < 4; ++j) { const float pe = (sc[t][j] > -1e29f) ? __expf(sc[t][j] - mx) : 0.f; sc[t][j] = pe; den += pe; }
  den += __shfl_xor(den, 16); den += __shfl_xor(den, 32);
  f32x4 oa[4];
#pragma unroll
  for (int n = 0; n < 4; ++n) oa[n] = (f32x4){0.f, 0.f, 0.f, 0.f};
  {
    bf16x8 vf[5][4];
#pragma unroll
    for (int tp = 0; tp < 5; ++tp)
#pragma unroll
      for (int n = 0; n < 4; ++n) {
        const unsigned a0 = VS + ((tb + 2 * tp) * 16 + g * 4 + (c16 >> 2)) * 160 + n * 32 + (c16 & 3) * 8;
        const s16x4 lo = __builtin_amdgcn_ds_read_tr16_b64_v4i16((LAS s16x4*)(unsigned long)a0);
        const s16x4 hi = __builtin_amdgcn_ds_read_tr16_b64_v4i16((LAS s16x4*)(unsigned long)(a0 + 16 * 160));
        vf[tp][n] = __builtin_shufflevector(lo, hi, 0, 1, 2, 3, 4, 5, 6, 7);
      }
    __builtin_amdgcn_sched_barrier(0);
#pragma unroll
    for (int tp = 0; tp < 5; ++tp) {
      u32x4 pu = {pk2(sc[2 * tp].x, sc[2 * tp].y), pk2(sc[2 * tp].z, sc[2 * tp].w), pk2(sc[2 * tp + 1].x, sc[2 * tp + 1].y), pk2(sc[2 * tp + 1].z, sc[2 * tp + 1].w)};
      const bf16x8 pa = __builtin_bit_cast(bf16x8, pu);
#pragma unroll
      for (int n = 0; n < 4; ++n) oa[n] = mfma16(vf[tp][n], pa, oa[n]);
    }
  }
  u16* attp = (u16*)(ws + WS_ATTP); float* lse = (float*)(ws + WS_LSE);
  {
    const float inv = 1.f / den;
    const long lt = base + r + ((long)qi << dsh);
    u16* dst = attp + ((long)pat * TG + lt) * 512 + h * 64 + g * 4;
#pragma unroll
    for (int n = 0; n < 4; ++n) {
      u32x2 ov = {pk2(oa[n].x * inv, oa[n].y * inv), pk2(oa[n].z * inv, oa[n].w * inv)};
      *(u32x2*)(dst + n * 16) = ov;
    }
  }
  if (g == 0) { const long lt = base + r + ((long)qi << dsh); lse[((long)pat * TG + lt) * 8 + h] = mx + __logf(den); }
  __syncthreads();
}

DI void dnlocal_item(unsigned char* ws, unsigned char* smem, int item) {
  const int tidx = opaque_tid();
  const int ch = item >> 2, hd = item & 3;
  const int tid = tidx, lane = tid & 63, w = tid >> 6, c16 = lane & 15, g = lane >> 4;
  const int dir = tid >> 8, t8 = tid & 255;
  const u16* dnp = (const u16*)(ws + WS_DNP); const float* gates = (const float*)(ws + WS_GATES);
  unsigned char* Kl = smem; unsigned char* Ql = smem + 17408; unsigned char* Vl = smem + 34816;
  float* KK = (float*)(smem + 51200); float* QKm = (float*)(smem + 67584);
  float* Am = (float*)(smem + 83968);
  float* gcs = (float*)(smem + 116736);
  u16* Xs = (u16*)(smem + 51200);
  unsigned char* opnd = ws + WS_DNOP + (long)item * 2 * DNOP_BYTES;
  const long tok0 = (long)ch * 64;
  for (int e = tid; e < 3072; e += 512) {
    const int which = e >> 10, q = e & 1023, row = q >> 4, c8 = q & 15;
    const u32x4 v = *(const u32x4*)(dnp + (tok0 + row) * 1536 + which * 512 + hd * 128 + c8 * 8);
    unsigned char* dst = (which == 0) ? (Ql + row * 272) : (which == 1) ? (Kl + row * 272) : (Vl + row * 256);
    *(u32x4*)(dst + c8 * 16) = v;
  }
  if (tid < 128) {
    const int dd = tid >> 6, i = tid & 63, ri = dd ? 63 - i : i;
    const float be = gates[(tok0 + ri) * 16 + dd * 4 + hd];
    float gv = gates[(tok0 + ri) * 16 + 8 + dd * 4 + hd];
#pragma unroll
    for (int o = 1; o < 64; o <<= 1) { const float t = __shfl_up(gv, o); if (i >= o) gv += t; }
    gcs[dd * 64 + i] = gv; gcs[128 + dd * 64 + i] = be; gcs[256 + dd * 64 + i] = be * __expf(gv);
  }
  __syncthreads();
  {
    const int which = w >> 2, mt = w & 3;
    const unsigned char* Asrc = which ? Ql : Kl;
    f32x4 a4[4];
#pragma unroll
    for (int n = 0; n < 4; ++n) a4[n] = (f32x4){0.f, 0.f, 0.f, 0.f};
    {
      bf16x8 af[4], bfv[4][4];
#pragma unroll
      for (int kk = 0; kk < 4; ++kk) {
        af[kk] = *(const bf16x8*)(Asrc + (mt * 16 + c16) * 272 + (kk * 4 + g) * 16);
#pragma unroll
        for (int n = 0; n < 4; ++n) bfv[kk][n] = *(const bf16x8*)(Kl + (n * 16 + c16) * 272 + (kk * 4 + g) * 16);
      }
      __builtin_amdgcn_sched_barrier(0);
#pragma unroll
      for (int kk = 0; kk < 4; ++kk)
#pragma unroll
        for (int n = 0; n < 4; ++n) a4[n] = mfma16(af[kk], bfv[kk][n], a4[n]);
    }
    float* dst = which ? QKm : KK;
#pragma unroll
    for (int n = 0; n < 4; ++n)
#pragma unroll
      for (int j = 0; j < 4; ++j) dst[(mt * 16 + g * 4 + j) * 64 + n * 16 + c16] = a4[n][j];
  }
  __syncthreads();
  {
    const float* gc = gcs + dir * 64; const float* be = gcs + 128 + dir * 64;
    u16* qkout = (u16*)(opnd + dir * DNOP_BYTES + OP_QK);
#pragma unroll
    for (int e8 = 0; e8 < 8; ++e8) {
      const int e = t8 + 256 * e8;
      const int i = e >> 5, j = (e & 31) * 2;
      const int ri = dir ? 63 - i : i, rj = dir ? 63 - j : j, rj1 = dir ? 62 - j : j + 1;
      const float gi = gc[i];
      const float d0 = __expf(gi - gc[j]), d1 = __expf(gi - gc[j + 1]);
      const float bi = be[i];
      Am[(dir * 64 + i) * 64 + j] = (j < i) ? bi * KK[ri * 64 + rj] * d0 : 0.f;
      Am[(dir * 64 + i) * 64 + j + 1] = (j + 1 < i) ? bi * KK[ri * 64 + rj1] * d1 : 0.f;
      const float q0 = (j <= i) ? QKm[ri * 64 + rj] * d0 : 0.f, q1 = (j + 1 <= i) ? QKm[ri * 64 + rj1] * d1 : 0.f;
      *(unsigned*)(qkout + i * 64 + kperm(j)) = pk2(q0, q1);
    }
  }
  __syncthreads();
  {
    const bool isu = t8 < 128;
    const unsigned char* src = isu ? (Vl + t8 * 2) : (Kl + (t8 - 128) * 2);
    const int sstr = isu ? 256 : 272;
    const float* scl = gcs + (isu ? 128 : 256) + dir * 64;
    const float* Ad = Am + dir * 4096;
    float X[64];
    f32x4 av[2][16]; float rv[2];
    rv[0] = bf2f(*(const u16*)(src + (dir ? 63 : 0) * sstr)) * scl[0];
#pragma unroll
    for (int i = 0; i < 64; ++i) {
      if (i + 1 < 64) {
        const int rn = dir ? 62 - i : i + 1;
#pragma unroll
        for (int j4 = 0; j4 < (i + 4) / 4; ++j4) av[(i + 1) & 1][j4] = *(const f32x4*)(Ad + (i + 1) * 64 + j4 * 4);
        rv[(i + 1) & 1] = bf2f(*(const u16*)(src + rn * sstr)) * scl[i + 1];
      }
      __builtin_amdgcn_sched_barrier(0);
      float a = rv[i & 1], b = 0.f;
#pragma unroll
      for (int j4 = 0; j4 < (i + 3) / 4; ++j4) {
        if (4 * j4 + 0 < i) a -= av[i & 1][j4].x * X[4 * j4 + 0];
        if (4 * j4 + 1 < i) b -= av[i & 1][j4].y * X[4 * j4 + 1];
        if (4 * j4 + 2 < i) a -= av[i & 1][j4].z * X[4 * j4 + 2];
        if (4 * j4 + 3 < i) b -= av[i & 1][j4].w * X[4 * j4 + 3];
      }
      X[i] = a + b;
      __builtin_amdgcn_sched_barrier(0);
    }
    if (isu) {
      u32x4* dst = (u32x4*)(opnd + dir * DNOP_BYTES + OP_UT + t8 * 128);
#pragma unroll
      for (int q = 0; q < 8; ++q) { u32x4 o = {pk2(X[8 * q], X[8 * q + 1]), pk2(X[8 * q + 2], X[8 * q + 3]), pk2(X[8 * q + 4], X[8 * q + 5]), pk2(X[8 * q + 6], X[8 * q + 7])}; dst[q] = o; }
    } else {
      u16* xd = Xs + dir * 8192 + kperm(t8 - 128);
#pragma unroll
      for (int i = 0; i < 64; ++i) xd[i * 128] = f2bf(-X[i]);
    }
  }
  __syncthreads();
  {
#pragma unroll
    for (int e4 = 0; e4 < 4; ++e4) {
      const int e = tid + 512 * e4;
      const int dd = e >> 10, q = e & 1023;
      *(u32x4*)(opnd + dd * DNOP_BYTES + OP_WN + q * 16) = *(const u32x4*)((const unsigned char*)Xs + dd * 16384 + q * 16);
    }
#pragma unroll
    for (int e4 = 0; e4 < 4; ++e4) {
      const int e = tid + 512 * e4;
      const int dd = e >> 10, q = e & 1023, i = q >> 4, c8 = q & 15, ri = dd ? 63 - i : i;
      const float sc = __expf(gcs[dd * 64 + i]);
      const int kb = c8 >> 2, gg = c8 & 3;
      const u32x2 v0 = *(const u32x2*)(Ql + ri * 272 + (kb * 32 + gg * 4) * 2), v1 = *(const u32x2*)(Ql + ri * 272 + (kb * 32 + 16 + gg * 4) * 2);
      u32x4 o = {pk2(bflo(v0.x) * sc, bfhi(v0.x) * sc), pk2(bflo(v0.y) * sc, bfhi(v0.y) * sc), pk2(bflo(v1.x) * sc, bfhi(v1.x) * sc), pk2(bflo(v1.y) * sc, bfhi(v1.y) * sc)};
      *(u32x4*)(opnd + dd * DNOP_BYTES + OP_QD + q * 16) = o;
    }
    {
      const int dk = t8 & 127, half = t8 >> 7;
      const float gl = gcs[dir * 64 + 63];
      u32x4* dst = (u32x4*)(opnd + dir * DNOP_BYTES + OP_KDT + dk * 128 + half * 64);
#pragma unroll
      for (int q = 0; q < 4; ++q) {
        float v[8];
#pragma unroll
        for (int jj = 0; jj < 8; ++jj) {
          const int i = half * 32 + (jj >> 2) * 16 + q * 4 + (jj & 3), ri = dir ? 63 - i : i;
          v[jj] = bf2f(*(const u16*)(Kl + ri * 272 + dk * 2)) * __expf(gl - gcs[dir * 64 + i]);
        }
        u32x4 o = {pk2(v[0], v[1]), pk2(v[2], v[3]), pk2(v[4], v[5]), pk2(v[6], v[7])};
        dst[q] = o;
      }
      if (t8 == 0) ((float*)(ws + WS_EGL))[item * 2 + dir] = __expf(gl);
    }
  }
  __syncthreads();
}

constexpr int SCAN_BUF = 73728 + 256;
DI void glds4(const void* g, unsigned ldsoff) {
  __builtin_amdgcn_global_load_lds((const __attribute__((address_space(1))) void*)g, (LAS void*)(unsigned long)ldsoff, 4, 0, 0);
}
DI void scan_issue(const unsigned char* src, const float* egp, unsigned ldsbase, int tid) {
  if (tid < 256) {
#pragma unroll
    for (int i = 0; i < 18; ++i) {
      const int q = tid + 256 * i;
      int sq;
      if (i < 8) sq = (q & ~15) | ((q & 15) ^ ((q >> 4) & 15));
      else sq = (q & ~7) | ((q & 7) ^ ((q >> 4) & 7));
      glds16(src + sq * 16, ldsbase + q * 16);
    }
    if (tid < 64) glds4(egp, ldsbase + 73728 + tid * 4);
  }
}
#define SB_ __builtin_amdgcn_sched_barrier(0)
DI void scan_compute(const unsigned char* B, int chk, int dir, int hd, u16* obuf, f32x4 (&S)[8], int w, int c16, int g) {
  const float eg = *(const float*)(B + 73728);
  const int x15 = c16, x7 = (c16 >> 1) & 7;
  bf16x8 sb[4];
#pragma unroll
  for (int kb = 0; kb < 4; ++kb) {
    u32x4 u = {pk2(S[2 * kb].x, S[2 * kb].y), pk2(S[2 * kb].z, S[2 * kb].w), pk2(S[2 * kb + 1].x, S[2 * kb + 1].y), pk2(S[2 * kb + 1].z, S[2 * kb + 1].w)};
    sb[kb] = __builtin_bit_cast(bf16x8, u);
  }
  f32x4 va[4], oa[4];
#pragma unroll
  for (int mt = 0; mt < 4; ++mt) {
    const u32x2 uu = *(const u32x2*)(B + 57344 + (16 * w + c16) * 128 + (((mt * 2 + (g >> 1)) ^ x7) << 4) + (g & 1) * 8);
    va[mt] = (f32x4){bflo(uu.x), bfhi(uu.x), bflo(uu.y), bfhi(uu.y)};
    oa[mt] = (f32x4){0.f, 0.f, 0.f, 0.f};
  }
  const unsigned char* wrow = B + c16 * 256;
  bf16x8 f0[8], f1[8];
#define LDWQ_(dst, kb) _Pragma("unroll") for (int mt = 0; mt < 4; ++mt) { const unsigned char* ap = wrow + mt * 4096 + ((((kb) * 4 + g) ^ x15) << 4); dst[mt] = *(const bf16x8*)ap; dst[4 + mt] = *(const bf16x8*)(ap + 16384); }
#define MMWQ_(src, kb) _Pragma("unroll") for (int mt = 0; mt < 4; ++mt) { va[mt] = mfma16(src[mt], sb[kb], va[mt]); oa[mt] = mfma16(sb[kb], src[4 + mt], oa[mt]); }
  LDWQ_(f0, 0); LDWQ_(f1, 1); SB_;
  MMWQ_(f0, 0); SB_;
  LDWQ_(f0, 2); SB_;
  MMWQ_(f1, 1); SB_;
  LDWQ_(f1, 3); SB_;
  MMWQ_(f0, 2); SB_;
  {
    const unsigned char* qrow = B + 32768 + c16 * 128;
#pragma unroll
    for (int mt = 0; mt < 4; ++mt)
#pragma unroll
      for (int cb = 0; cb < 2; ++cb) f0[mt * 2 + cb] = *(const bf16x8*)(qrow + mt * 2048 + (((cb * 4 + g) ^ x7) << 4));
  }
  SB_;
  MMWQ_(f1, 3); SB_;
#undef LDWQ_
#undef MMWQ_
  bf16x8 vb[2];
#pragma unroll
  for (int cb = 0; cb < 2; ++cb) {
    u32x4 u = {pk2(va[2 * cb].x, va[2 * cb].y), pk2(va[2 * cb].z, va[2 * cb].w), pk2(va[2 * cb + 1].x, va[2 * cb + 1].y), pk2(va[2 * cb + 1].z, va[2 * cb + 1].w)};
    vb[cb] = __builtin_bit_cast(bf16x8, u);
  }
  const unsigned char* krow = B + 40960 + c16 * 128;
#define LDKD_(dst, t0) _Pragma("unroll") for (int t = 0; t < 4; ++t) _Pragma("unroll") for (int cb = 0; cb < 2; ++cb) dst[t * 2 + cb] = *(const bf16x8*)(krow + ((t0) + t) * 2048 + (((cb * 4 + g) ^ x7) << 4));
  LDKD_(f1, 0); SB_;
#pragma unroll
  for (int mt = 0; mt < 4; ++mt)
#pragma unroll
    for (int cb = 0; cb < 2; ++cb) oa[mt] = mfma16(vb[cb], f0[mt * 2 + cb], oa[mt]);
  SB_;
  LDKD_(f0, 4); SB_;
#pragma unroll
  for (int t = 0; t < 4; ++t) {
    f32x4 s = {S[t].x * eg, S[t].y * eg, S[t].z * eg, S[t].w * eg};
#pragma unroll
    for (int cb = 0; cb < 2; ++cb) s = mfma16(f1[t * 2 + cb], vb[cb], s);
    S[t] = s;
  }
  SB_;
#pragma unroll
  for (int t = 0; t < 4; ++t) {
    f32x4 s = {S[4 + t].x * eg, S[4 + t].y * eg, S[4 + t].z * eg, S[4 + t].w * eg};
#pragma unroll
    for (int cb = 0; cb < 2; ++cb) s = mfma16(f0[t * 2 + cb], vb[cb], s);
    S[4 + t] = s;
  }
#undef LDKD_
#pragma unroll
  for (int mt = 0; mt < 4; ++mt) {
    const int i = mt * 16 + c16;
    const long tok = (long)chk * 64 + (dir ? 63 - i : i);
    u32x2 ov = {pk2(oa[mt].x, oa[mt].y), pk2(oa[mt].z, oa[mt].w)};
    *(u32x2*)(obuf + tok * 512 + hd * 128 + 16 * w + g * 4) = ov;
  }
}
#undef SB_

DI void scan_chain(int grp, unsigned char* ws, unsigned char* smem, int chain) {
  const int tidx = opaque_tid();
  const int L = (grp == 0) ? 16384 : 2048, nc = L >> 6;
  const int dir = chain & 1, hd = (chain >> 1) & 3, sq = chain >> 3;
  const int tid = tidx, lane = tid & 63, w = tid >> 6, c16 = lane & 15, g = lane >> 4;
  const int chunk0 = sq * nc;
  const float* egl = (const float*)(ws + WS_EGL);
  u16* obuf = (u16*)(ws + WS_OF) + (long)dir * TG * 512;
  f32x4 S[8];
#pragma unroll
  for (int t = 0; t < 8; ++t) S[t] = (f32x4){0.f, 0.f, 0.f, 0.f};
  __syncthreads();
  {
    const int chk = chunk0 + (dir ? nc - 1 : 0);
    const long it = (long)(chk * 4 + hd) * 2 + dir;
    scan_issue(ws + WS_DNOP + it * DNOP_BYTES, egl + it, 0u, tid);
  }
  __syncthreads();
  for (int m = 0; m < nc; ++m) {
    const int chk = chunk0 + (dir ? nc - 1 - m : m);
    if (m + 1 < nc) {
      const int chn = chunk0 + (dir ? nc - 2 - m : m + 1);
      const long it = (long)(chn * 4 + hd) * 2 + dir;
      scan_issue(ws + WS_DNOP + it * DNOP_BYTES, egl + it, (unsigned)(((m + 1) & 1) * SCAN_BUF), tid);
    }
    scan_compute(smem + (m & 1) * SCAN_BUF, chk, dir, hd, obuf, S, w, c16, g);
    __syncthreads();
  }
}

DI void phase_merge(const Params& p, unsigned char* ws) {
  const int tidx = opaque_tid();
  const int lane = tidx & 63;
  const int gw = blockIdx.x * 8 + (tidx >> 6), NW = gridDim.x * 8;
  const u16* attp = (const u16*)(ws + WS_ATTP); const float* lse = (const float*)(ws + WS_LSE);
  const u16* of = (const u16*)(ws + WS_OF); const u16* proj = (const u16*)(ws + WS_PROJ);
  u16* mix = (u16*)(ws + WS_NBUF);
  f32x4 gn0 = *(const f32x4*)(p.out_norm + (lane & 15) * 8), gn1 = *(const f32x4*)(p.out_norm + (lane & 15) * 8 + 4);
  for (int t0 = gw; t0 < TG; t0 += 4 * NW) {
    float l0[4], l1[4], l2[4]; u32x4 pa[4], pb[4], pc[4], fa[4], fb[4], gg[4];
    const int h = lane >> 3;
#pragma unroll
    for (int k = 0; k < 4; ++k) {
      const long tt = t0 + (long)k * NW, t = tt < TG ? tt : TG - 1;
      l0[k] = lse[((long)0 * TG + t) * 8 + h]; l1[k] = lse[((long)1 * TG + t) * 8 + h]; l2[k] = lse[((long)2 * TG + t) * 8 + h];
      pa[k] = *(const u32x4*)(attp + ((long)0 * TG + t) * 512 + lane * 8);
      pb[k] = *(const u32x4*)(attp + ((long)1 * TG + t) * 512 + lane * 8);
      pc[k] = *(const u32x4*)(attp + ((long)2 * TG + t) * 512 + lane * 8);
      fa[k] = *(const u32x4*)(of + t * 512 + lane * 8);
      fb[k] = *(const u32x4*)(of + ((long)TG + t) * 512 + lane * 8);
      gg[k] = *(const u32x4*)(proj + t * NPROJ + 3072 + lane * 8);
    }
#pragma unroll
    for (int k = 0; k < 4; ++k) {
      const long t = t0 + (long)k * NW;
      if (t >= TG) break;
      {
        const float mx = fmaxf(l0[k], fmaxf(l1[k], l2[k]));
        float w0 = __expf(l0[k] - mx), w1 = __expf(l1[k] - mx), w2 = __expf(l2[k] - mx);
        const float inv = __builtin_amdgcn_rcpf(w0 + w1 + w2); w0 *= inv; w1 *= inv; w2 *= inv;
        const u32x4 a = pa[k], b = pb[k], c = pc[k];
        u32x4 o;
        o.x = pk2(w0 * bflo(a.x) + w1 * bflo(b.x) + w2 * bflo(c.x), w0 * bfhi(a.x) + w1 * bfhi(b.x) + w2 * bfhi(c.x));
        o.y = pk2(w0 * bflo(a.y) + w1 * bflo(b.y) + w2 * bflo(c.y), w0 * bfhi(a.y) + w1 * bfhi(b.y) + w2 * bfhi(c.y));
        o.z = pk2(w0 * bflo(a.z) + w1 * bflo(b.z) + w2 * bflo(c.z), w0 * bfhi(a.z) + w1 * bfhi(b.z) + w2 * bfhi(c.z));
        o.w = pk2(w0 * bflo(a.w) + w1 * bflo(b.w) + w2 * bflo(c.w), w0 * bfhi(a.w) + w1 * bfhi(b.w) + w2 * bfhi(c.w));
        *(u32x4*)(mix + t * 1024 + lane * 8) = o;
      }
      {
        const u32x4 a = fa[k], b = fb[k], g4 = gg[k];
        float o[8] = {bflo(a.x) + bflo(b.x), bfhi(a.x) + bfhi(b.x), bflo(a.y) + bflo(b.y), bfhi(a.y) + bfhi(b.y),
                      bflo(a.z) + bflo(b.z), bfhi(a.z) + bfhi(b.z), bflo(a.w) + bflo(b.w), bfhi(a.w) + bfhi(b.w)};
        float ss = 0.f;
#pragma unroll
        for (int i = 0; i < 8; ++i) ss += o[i] * o[i];
        ss = sum16(ss);
        const float rs = __builtin_amdgcn_rsqf(ss * (1.f / 128.f) + 1e-6f);
        const float gv[8] = {bflo(g4.x), bfhi(g4.x), bflo(g4.y), bfhi(g4.y), bflo(g4.z), bfhi(g4.z), bflo(g4.w), bfhi(g4.w)};
        const float gn[8] = {gn0.x, gn0.y, gn0.z, gn0.w, gn1.x, gn1.y, gn1.z, gn1.w};
        float y[8];
#pragma unroll
        for (int i = 0; i < 8; ++i) y[i] = o[i] * rs * gn[i] * siluf_(gv[i]);
        u32x4 ov = {pk2(y[0], y[1]), pk2(y[2], y[3]), pk2(y[4], y[5]), pk2(y[6], y[7])};
        *(u32x4*)(mix + t * 1024 + 512 + lane * 8) = ov;
      }
    }
  }
}

namespace pg8 {
#define PG8_LAS LAS
constexpr int BM = 256, BK = 64, HALF = 128, HTB = HALF * BK * 2;
DI int lds_byte(int r, int c) { const int st = (r >> 4) * 2 + (c >> 5), rr = r & 15, cc = c & 31, ob = rr * 64 + cc * 2; return st * 1024 + (ob ^ (((ob >> 9) & 1) << 5)); }
DI void stage_rc(int b, int& R, int& C) { const int st = b / 1024, sb = b % 1024, swz = sb ^ (((sb >> 9) & 1) << 5); R = (st >> 1) * 16 + swz / 64; C = (st & 1) * 32 + (swz % 64) / 2; }
DI int perm32(int rho) { const int n = rho >> 4, i = rho & 15; return 8 * (i >> 2) + 4 * n + (i & 3); }
struct Unit { int pm, pn; };
struct Gemm8 { const u16* A; const u16* Bt; int K; };
struct TileOrder {
  int nM, nN, ntiles, G, bperm;
  DI bool next(int i, Unit& u) const {
    const int T = i * G + bperm; if (T >= ntiles) return false;
    const int sg = T / (8 * nN), fm = sg * 8, gsz = (nM - fm) < 8 ? (nM - fm) : 8, idx = T - sg * 8 * nN;
    u.pm = fm + (idx % gsz); u.pn = idx / gsz; return true;
  }
  DI void a_ready(const Unit&) const {}
  DI void done(const Unit&) const {}
};
struct EpiProj {
  static constexpr bool PERM = true, AFTER_DRAIN = false;
  u16* proj;
  DI void operator()(const f32x4 (&acc)[2][2][4][2], const Unit& u, int wr, int wc, int fr, int fq) const {
    const int row0 = u.pm * BM + wr * 64 + fr, col0 = u.pn * BM + wc * 32 + 8 * fq;
#pragma unroll
    for (int ai = 0; ai < 2; ++ai)
#pragma unroll
      for (int m = 0; m < 4; ++m) {
        u16* rowp = proj + (size_t)(row0 + ai * HALF + m * 16) * NPROJ + col0;
#pragma unroll
        for (int bj = 0; bj < 2; ++bj) {
          const f32x4 a0 = acc[ai][bj][m][0], a1 = acc[ai][bj][m][1];
          u32x4 o = {pk2(a0.x, a0.y), pk2(a0.z, a0.w), pk2(a1.x, a1.y), pk2(a1.z, a1.w)};
          *(u32x4*)(rowp + bj * HALF) = o;
        }
      }
  }
};
struct EpiH {
  static constexpr bool PERM = true, AFTER_DRAIN = false;
  const float* xg; float* outg; u16* hb; float* rowsq;
  DI void operator()(const f32x4 (&acc)[2][2][4][2], const Unit& u, int wr, int wc, int fr, int fq) const {
    const int row0 = u.pm * BM + wr * 64 + fr, col0 = u.pn * BM + wc * 32 + 8 * fq;
#pragma unroll
    for (int ai = 0; ai < 2; ++ai) {
      f32x4 xv[4][2][2];
#pragma unroll
      for (int m = 0; m < 4; ++m)
#pragma unroll
        for (int bj = 0; bj < 2; ++bj)
#pragma unroll
          for (int n = 0; n < 2; ++n) xv[m][bj][n] = *(const f32x4*)(xg + (size_t)(row0 + ai * HALF + m * 16) * 1024 + col0 + bj * HALF + n * 4);
#pragma unroll
      for (int m = 0; m < 4; ++m) {
        const size_t row = (size_t)(row0 + ai * HALF + m * 16);
        float s = 0.f;
#pragma unroll
        for (int bj = 0; bj < 2; ++bj) {
          const f32x4 h0 = xv[m][bj][0] + acc[ai][bj][m][0], h1 = xv[m][bj][1] + acc[ai][bj][m][1];
          u32x4 o = {pk2(h0.x, h0.y), pk2(h0.z, h0.w), pk2(h1.x, h1.y), pk2(h1.z, h1.w)};
          *(u32x4*)(hb + row * 1024 + col0 + bj * HALF) = o;
          s += h0.x * h0.x + h0.y * h0.y + h0.z * h0.z + h0.w * h0.w + h1.x * h1.x + h1.y * h1.y + h1.z * h1.z + h1.w * h1.w;
        }
        s += __shfl_xor(s, 16); s += __shfl_xor(s, 32);
        if (fq == 0) rowsq[row * 16 + u.pn * 4 + wc] = s;
      }
    }
  }
};
struct EpiOut {
  static constexpr bool PERM = true, AFTER_DRAIN = false;
  float* outg; const u16* hb;
  DI void operator()(const f32x4 (&acc)[2][2][4][2], const Unit& u, int wr, int wc, int fr, int fq) const {
    const int row0 = u.pm * BM + wr * 64 + fr, col0 = u.pn * BM + wc * 32 + 8 * fq;
#pragma unroll
    for (int ai = 0; ai < 2; ++ai) {
      u32x4 hv[4][2];
#pragma unroll
      for (int m = 0; m < 4; ++m)
#pragma unroll
        for (int bj = 0; bj < 2; ++bj) hv[m][bj] = *(const u32x4*)(hb + (size_t)(row0 + ai * HALF + m * 16) * 1024 + col0 + bj * HALF);
#pragma unroll
      for (int m = 0; m < 4; ++m) {
        float* rowp = outg + (size_t)(row0 + ai * HALF + m * 16) * 1024 + col0;
#pragma unroll
        for (int bj = 0; bj < 2; ++bj) {
          const u32x4 v = hv[m][bj];
          f32x4 h0 = {bflo(v.x), bfhi(v.x), bflo(v.y), bfhi(v.y)}, h1 = {bflo(v.z), bfhi(v.z), bflo(v.w), bfhi(v.w)};
          h0 = h0 + acc[ai][bj][m][0]; h1 = h1 + acc[ai][bj][m][1];
          *(f32x4*)(rowp + bj * HALF) = h0; *(f32x4*)(rowp + bj * HALF + 4) = h1;
        }
      }
    }
  }
};
struct OneUnit {
  Unit u;
  DI bool next(int i, Unit& o) const { if (i != 0) return false; o = u; return true; }
  DI void a_ready(const Unit&) const {}
  DI void done(const Unit&) const {}
};
struct EpiGlu {
  static constexpr bool PERM = true, AFTER_DRAIN = true;
  const float* cw; const float* cb; const float* rowsq; u16* act; int pm, pn, L;
  DI void operator()(const f32x4 (&)[2][2][4][2], const Unit&, int, int, int, int) const {}
  DI void fused(const f32x4 (&acc)[2][2][4][2], const Unit&, int wr, int wc, int fr, int fq, PG8_LAS unsigned char* lds, int wid, int lane) const {
    const int rowbase = pm * 254 - 1;
#pragma unroll
    for (int ai = 0; ai < 2; ++ai) {
      f32x4 rq[4][4];
#pragma unroll
      for (int m = 0; m < 4; ++m) {
        const int rl = ai * HALF + wr * 64 + m * 16 + fr;
        int ar = rowbase + rl; ar = ar < 0 ? 0 : (ar > TG - 1 ? TG - 1 : ar);
        const f32x4* rp = (const f32x4*)(rowsq + (long)ar * 16);
#pragma unroll
        for (int q = 0; q < 4; ++q) rq[m][q] = rp[q];
      }
#pragma unroll
      for (int m = 0; m < 4; ++m) {
        const int rl = ai * HALF + wr * 64 + m * 16 + fr;
        const f32x4 q0 = rq[m][0], q1 = rq[m][1], q2 = rq[m][2], q3 = rq[m][3];
        const float ssq = (q0.x + q0.y + q0.z + q0.w) + (q1.x + q1.y + q1.z + q1.w) + (q2.x + q2.y + q2.z + q2.w) + (q3.x + q3.y + q3.z + q3.w);
        const float rs2 = __builtin_amdgcn_rsqf(ssq * (1.f / 1024.f) + 1e-6f);
#pragma unroll
        for (int bj = 0; bj < 2; ++bj)
#pragma unroll
          for (int n = 0; n < 2; ++n) {
            const int col = bj * HALF + wc * 32 + 8 * fq + 4 * n;
            const f32x4 a = acc[ai][bj][m][n];
            u32x2 o = {pk2(a.x * rs2, a.y * rs2), pk2(a.z * rs2, a.w * rs2)};
            *(PG8_LAS u32x2*)(lds + rl * 520 + col * 2) = o;
          }
      }
    }
    __syncthreads();
    {
      const int hp = lane, rg = wid;
      const int hid = pn * 128 + 2 * hp;
      float cwg[3][2], cwu[3][2], cbg[2], cbu[2];
#pragma unroll
      for (int j = 0; j < 3; ++j) {
        cwg[j][0] = cw[j * 5632 + hid]; cwg[j][1] = cw[j * 5632 + hid + 1];
        cwu[j][0] = cw[j * 5632 + 2816 + hid]; cwu[j][1] = cw[j * 5632 + 2816 + hid + 1];
      }
      cbg[0] = cb[hid]; cbg[1] = cb[hid + 1]; cbu[0] = cb[2816 + hid]; cbu[1] = cb[2816 + hid + 1];
      unsigned gk[34], uk[34];
#pragma unroll
      for (int k = 0; k < 34; ++k) {
        int r = rg * 32 - 1 + k; r = r < 0 ? 0 : (r > 255 ? 255 : r);
        gk[k] = *(const PG8_LAS unsigned*)(lds + r * 520 + hp * 4); uk[k] = *(const PG8_LAS unsigned*)(lds + r * 520 + 256 + hp * 4);
      }
#pragma unroll
      for (int kk = 0; kk < 32; ++kk) {
        const int i = rg * 32 + kk;
        const int lt = rowbase + i;
        if (i >= 1 && i <= 254 && lt < TG) {
          const unsigned gp = gk[kk], gc = gk[kk + 1], gn = gk[kk + 2], up = uk[kk], uc = uk[kk + 1], un = uk[kk + 2];
          const int pos = lt & (L - 1);
          float gp0 = bflo(gp), gp1 = bfhi(gp), up0 = bflo(up), up1 = bfhi(up), gn0 = bflo(gn), gn1 = bfhi(gn), un0 = bflo(un), un1 = bfhi(un);
          if (pos == 0) { gp0 = 0.f; gp1 = 0.f; up0 = 0.f; up1 = 0.f; }
          if (pos == L - 1) { gn0 = 0.f; gn1 = 0.f; un0 = 0.f; un1 = 0.f; }
          const float G0 = cwg[0][0] * gp0 + cwg[1][0] * bflo(gc) + cwg[2][0] * gn0 + cbg[0];
          const float G1 = cwg[0][1] * gp1 + cwg[1][1] * bfhi(gc) + cwg[2][1] * gn1 + cbg[1];
          const float U0 = cwu[0][0] * up0 + cwu[1][0] * bflo(uc) + cwu[2][0] * un0 + cbu[0];
          const float U1 = cwu[0][1] * up1 + cwu[1][1] * bfhi(uc) + cwu[2][1] * un1 + cbu[1];
          *(unsigned*)(act + (long)lt * 2816 + hid) = pk2(siluf_(G0) * U0, siluf_(G1) * U1);
        }
      }
    }
    __syncthreads();
  }
};
template <class Epi, class Sched>
__device__ __forceinline__ void gemm8_phase(PG8_LAS unsigned char* lds, const Gemm8 g, const Sched& S, const Epi& E) {
    constexpr bool STAMP = false; unsigned long long* stamps = nullptr;
    const int tid = opaque_tid(), wid = __builtin_amdgcn_readfirstlane(tid >> 6), lane = tid & 63, wr = wid >> 2, wc = wid & 3, fr = lane & 15, fq = lane >> 4;
    const int K = g.K, nt = K / BK;
    int ts_lo = 0, ts_hi = 0, nts = 0; const unsigned long long rt_entry = 0ull;
#define PG8_STAMP() do { if (STAMP && wid == 0 && nts < 64) { const unsigned long long _c = 0ull; \
        ts_lo = (lane == nts) ? (int)(unsigned)_c : ts_lo; ts_hi = (lane == nts) ? (int)(unsigned)(_c >> 32) : ts_hi; ++nts; } } while (0)
    PG8_STAMP();
    unsigned voffA[2], voffB[2];
#pragma unroll
    for (int i = 0; i < 2; ++i) { int R, C; stage_rc(tid * 16 + i * 8192, R, C); const int Rb = Epi::PERM ? ((R & ~31) + perm32(R & 31)) : R;
        voffA[i] = (unsigned)(R * K + C) * 2u; voffB[i] = (unsigned)(Rb * K + C) * 2u; }
    const size_t kstep = (size_t)(BK * 2);
    const size_t hstep = (size_t)HALF * K * 2;
    const size_t tstep = 2 * hstep;
    const unsigned ldsw = (unsigned)wid * 1024u;
    const int aoff = lds_byte(wr * 64 + fr, fq * 8), boff = lds_byte(wc * 32 + fr, fq * 8);
#define PG8_SA(b, h) (((b) * 2 + (h)) * HTB)
#define PG8_SB(b, h) ((4 + (b) * 2 + (h)) * HTB)
#define PG8_STAGE(bufoff, gbase, voff) do { _Pragma("unroll") for (int _i = 0; _i < 2; ++_i) \
        __builtin_amdgcn_global_load_lds((const unsigned*)((const char*)(gbase) + (voff)[_i]), (PG8_LAS unsigned*)(lds + (bufoff) + ldsw + _i * 8192), 16, 0, 0); } while (0)
#define PG8_LDA(dst, b, h) do { _Pragma("unroll") for (int m = 0; m < 4; ++m) _Pragma("unroll") for (int k = 0; k < 2; ++k) dst[m][k] = *(const PG8_LAS bf16x8*)(lds + PG8_SA(b, h) + aoff + m * 2048 + k * 1024); } while (0)
#define PG8_LDB(dst, b, h) do { _Pragma("unroll") for (int n = 0; n < 2; ++n) _Pragma("unroll") for (int k = 0; k < 2; ++k) dst[n][k] = *(const PG8_LAS bf16x8*)(lds + PG8_SB(b, h) + boff + n * 2048 + k * 1024); } while (0)
#define PG8_MMA(ai, bj, At, Bt) do { __builtin_amdgcn_s_setprio(1); _Pragma("unroll") for (int m = 0; m < 4; ++m) _Pragma("unroll") for (int n = 0; n < 2; ++n) _Pragma("unroll") for (int k = 0; k < 2; ++k) \
        acc[ai][bj][m][n] = __builtin_amdgcn_mfma_f32_16x16x32_bf16(Bt[n][k], At[m][k], acc[ai][bj][m][n], 0, 0, 0); __builtin_amdgcn_s_setprio(0); } while (0)
#define PG8_WAIT_V(n) asm volatile("s_waitcnt vmcnt(" #n ")" ::: "memory")
#define PG8_WAIT_L(n) asm volatile("s_waitcnt lgkmcnt(" #n ")" ::: "memory")
#define PG8_BAR __builtin_amdgcn_s_barrier()
#define PG8_SCHED __builtin_amdgcn_sched_barrier(0)
    Unit cur, nxt; int ui = 0;
    if (!S.next(0, cur)) return;
    f32x4 acc[2][2][4][2];
#pragma unroll
    for (int a = 0; a < 2; ++a)
#pragma unroll
        for (int b = 0; b < 2; ++b)
#pragma unroll
            for (int m = 0; m < 4; ++m)
#pragma unroll
                for (int n = 0; n < 2; ++n) acc[a][b][m][n] = (f32x4){0.f, 0.f, 0.f, 0.f};
    bf16x8 At[4][2], B0[2][2], B1[2][2];
    const char* cA = (const char*)g.A + (size_t)cur.pm * tstep; const char* cB = (const char*)g.Bt + (size_t)cur.pn * tstep;
    S.a_ready(cur);
    PG8_STAGE(PG8_SB(0, 0), cB, voffB); PG8_STAGE(PG8_SA(0, 0), cA, voffA); PG8_STAGE(PG8_SB(0, 1), cB + hstep, voffB); PG8_STAGE(PG8_SA(0, 1), cA + hstep, voffA);
    if (wr == 1) PG8_BAR;
    PG8_WAIT_V(4); PG8_BAR;
    PG8_STAGE(PG8_SB(1, 0), cB + kstep, voffB); PG8_STAGE(PG8_SA(1, 0), cA + kstep, voffA); PG8_STAGE(PG8_SB(1, 1), cB + hstep + kstep, voffB);
    PG8_WAIT_V(6); PG8_BAR;
    PG8_STAMP();
    for (;;) {
        const bool has_next = S.next(ui + 1, nxt);
        const char* nA = has_next ? (const char*)g.A + (size_t)nxt.pm * tstep : cA; const char* nB = has_next ? (const char*)g.Bt + (size_t)nxt.pn * tstep : cB;
        for (int t = 0; t < nt; t += 2) {
            const bool last = (t == nt - 2);
            const char* a1 = cA + (size_t)(t + 1) * kstep;
            const char* a2 = last ? nA : cA + (size_t)(t + 2) * kstep; const char* b2 = last ? nB : cB + (size_t)(t + 2) * kstep;
            const char* a3 = a2 + kstep; const char* b3 = b2 + kstep;
            if (last && has_next) S.a_ready(nxt);
            PG8_LDB(B0, 0, 0); PG8_SCHED; PG8_LDA(At, 0, 0); PG8_STAGE(PG8_SA(1, 1), a1 + hstep, voffA);
            PG8_WAIT_L(8); PG8_BAR; PG8_WAIT_L(0); PG8_MMA(0, 0, At, B0); PG8_BAR; PG8_SCHED;
            PG8_LDB(B1, 0, 1); PG8_STAGE(PG8_SB(0, 0), b2, voffB);
            PG8_BAR; PG8_WAIT_L(0); PG8_MMA(0, 1, At, B1); PG8_BAR;
            PG8_LDA(At, 0, 1); PG8_STAGE(PG8_SA(0, 0), a2, voffA);
            PG8_BAR; PG8_WAIT_L(0); PG8_MMA(1, 0, At, B0); PG8_BAR; PG8_SCHED;
            PG8_STAGE(PG8_SB(0, 1), b2 + hstep, voffB);
            PG8_WAIT_V(6); PG8_BAR; PG8_MMA(1, 1, At, B1); PG8_BAR;
            PG8_LDB(B0, 1, 0); PG8_SCHED; PG8_LDA(At, 1, 0); PG8_STAGE(PG8_SA(0, 1), a2 + hstep, voffA);
            PG8_WAIT_L(8); PG8_BAR; PG8_WAIT_L(0); PG8_MMA(0, 0, At, B0); PG8_BAR; PG8_SCHED;
            PG8_LDB(B1, 1, 1); PG8_STAGE(PG8_SB(1, 0), b3, voffB);
            PG8_BAR; PG8_WAIT_L(0); PG8_MMA(0, 1, At, B1); PG8_BAR;
            PG8_LDA(At, 1, 1); PG8_STAGE(PG8_SA(1, 0), a3, voffA);
            PG8_BAR; PG8_WAIT_L(0); PG8_MMA(1, 0, At, B0); PG8_BAR; PG8_SCHED;
            PG8_STAGE(PG8_SB(1, 1), b3 + hstep, voffB);
            PG8_WAIT_V(6); PG8_BAR; PG8_MMA(1, 1, At, B1); PG8_BAR;
        }
        PG8_STAMP();
        if constexpr (!Epi::AFTER_DRAIN) { E(acc, cur, wr, wc, fr, fq); S.done(cur); }
        PG8_STAMP();
        if (!has_next) break;
#pragma unroll
        for (int a = 0; a < 2; ++a)
#pragma unroll
            for (int b = 0; b < 2; ++b)
#pragma unroll
                for (int m = 0; m < 4; ++m)
#pragma unroll
                    for (int n = 0; n < 2; ++n) acc[a][b][m][n] = (f32x4){0.f, 0.f, 0.f, 0.f};
        cur = nxt; cA = nA; cB = nB; ++ui;
    }
    PG8_WAIT_V(0);
    if (wr == 0) PG8_BAR;
    PG8_BAR;
    if constexpr (Epi::AFTER_DRAIN) { E.fused(acc, cur, wr, wc, fr, fq, lds, wid, lane); S.done(cur); }
    PG8_STAMP();
    if (false) { stamps[lane] = lane < nts ? (((unsigned long long)(unsigned)ts_hi << 32) | (unsigned)ts_lo) : 0ull;
        if (lane == 62) stamps[62] = rt_entry; if (lane == 63) stamps[63] = 0ull; }
#undef PG8_STAMP
#undef PG8_SA
#undef PG8_SB
#undef PG8_STAGE
#undef PG8_LDA
#undef PG8_LDB
#undef PG8_MMA
#undef PG8_WAIT_V
#undef PG8_WAIT_L
#undef PG8_BAR
#undef PG8_SCHED
}
}

template <int MODE>
DI void gemm8_run(int grp, unsigned char* ws, const float* __restrict__ xg, float* __restrict__ outg, int bperm) {
  pg8::Gemm8 g; pg8::TileOrder S;
  const int G = gridDim.x;
  S.G = G; S.bperm = bperm;
  S.nM = TG / 256;
  if (MODE == 1) { g.A = (const u16*)(ws + WS_NBUF); g.Bt = (const u16*)(ws + WS_WIN); g.K = 1024; S.nN = NPROJ / 256; }
  else if (MODE == 2) { g.A = (const u16*)(ws + WS_NBUF); g.Bt = (const u16*)(ws + WS_WOUT); g.K = 1024; S.nN = 4; }
  else { g.A = (const u16*)(ws + WS_ACT); g.Bt = (const u16*)(ws + WS_WDOWN); g.K = 2816; S.nN = 4; }
  S.ntiles = S.nM * S.nN;
  __syncthreads();
  if (MODE == 1) { pg8::EpiProj E{(u16*)(ws + WS_PROJ)}; pg8::gemm8_phase((LAS unsigned char*)0, g, S, E); }
  else if (MODE == 2) { pg8::EpiH E{xg, outg, (u16*)(ws + WS_HB), (float*)(ws + WS_ROWSQ)}; pg8::gemm8_phase((LAS unsigned char*)0, g, S, E); }
  else { pg8::EpiOut E{outg, (const u16*)(ws + WS_HB)}; pg8::gemm8_phase((LAS unsigned char*)0, g, S, E); }
  __syncthreads();
}


DI void gemm8_glu(const Params& p, int grp, unsigned char* ws, int bperm) {
  const int L = (grp == 0) ? 16384 : 2048;
  const int nM = (TG + 253) / 254, nN = 22, ntiles = nM * nN, G = gridDim.x;
  __syncthreads();
  for (int T = bperm; T < ntiles; T += G) {
    const int sg = T / (8 * nN), fm = sg * 8, gsz = (nM - fm) < 8 ? (nM - fm) : 8, idx = T - sg * 8 * nN;
    const int pm = fm + (idx % gsz), pn = idx / gsz;
    pg8::Gemm8 g; g.A = (const u16*)(ws + WS_HB) + (long)(pm * 254 - 1) * 1024; g.Bt = (const u16*)(ws + WS_WUP); g.K = 1024;
    pg8::OneUnit S; S.u.pm = 0; S.u.pn = pn;
    pg8::EpiGlu E{p.ffn_cw, p.ffn_cb, (const float*)(ws + WS_ROWSQ), (u16*)(ws + WS_ACT), pm, pn, L};
    pg8::gemm8_phase((LAS unsigned char*)0, g, S, E);
  }
}

#define XB_TMO      128
#define XB_XCNT(j)  (256  + 64 * (j))
#define XB_XSUB(j)  (1280 + 64 * (j))
#define XB_XGEN(j)  (2304 + 64 * (j))
#define XB_TOP      3328
#define XB_TOPGEN   3392
#define XCD_BAR_WORDS 3456
#define XB_SPIN_CAP (1u << 18)
DI unsigned xb_ld(unsigned* p)              { return __hip_atomic_load(p, __ATOMIC_RELAXED, __HIP_MEMORY_SCOPE_AGENT); }
DI unsigned xb_add(unsigned* p, unsigned v) { return __hip_atomic_fetch_add(p, v, __ATOMIC_RELAXED, __HIP_MEMORY_SCOPE_AGENT); }
DI unsigned xb_xcc_id() { return (unsigned)__builtin_amdgcn_s_getreg((3 << 11) | 20) & 0xFu; }
#define XB_SPIN(cond, bar) do { unsigned _sp = 0; while (cond) { __builtin_amdgcn_s_sleep(1); \
    if ((++_sp & 255u) == 0u) { if (xb_ld(&(bar)[XB_TMO])) break; if (_sp > XB_SPIN_CAP) { atomicAdd(&(bar)[XB_TMO], 1u); break; } } } } while (0)
struct XcdBarrier { unsigned* bar; unsigned x; volatile LAS unsigned* st; };
DI XcdBarrier xcd_barrier_post(unsigned* bar, volatile LAS unsigned* st) {
  XcdBarrier b; b.bar = bar; b.x = xb_xcc_id(); b.st = st;
  if (opaque_tid() == 0) (void)xb_add(&bar[XB_XCNT(b.x)], 1u);
  return b;
}
DI void xcd_barrier_complete(unsigned* bar, unsigned x, unsigned& nloc, unsigned& nx) {
  const unsigned G = gridDim.x * gridDim.y * gridDim.z;
  unsigned sum, cnt, mine, sp = 0u;
  for (;;) {
    sum = 0u; cnt = 0u; mine = 0u;
#pragma unroll
    for (unsigned j = 0; j < 16; ++j) { const unsigned c = xb_ld(&bar[XB_XCNT(j)]); sum += c; cnt += (c > 0u) ? 1u : 0u; mine = (j == x) ? c : mine; }
    if (sum == G) break;
    __builtin_amdgcn_s_sleep(1);
    if ((++sp & 255u) == 0u) { if (xb_ld(&bar[XB_TMO])) break; if (sp > XB_SPIN_CAP) { atomicAdd(&bar[XB_TMO], 1u); break; } }
  }
  nloc = mine > 0u ? mine : 1u; nx = cnt > 0u ? cnt : 1u;
}
DI void xcd_barrier(const XcdBarrier& b) {
  asm volatile("s_waitcnt vmcnt(0)" ::: "memory");
  __syncthreads();
  if (opaque_tid() == 0) {
    unsigned* bar = b.bar;
    __builtin_amdgcn_s_waitcnt(0);
    unsigned nloc = b.st[0], nx = b.st[1];
    if (nloc == 0u) { xcd_barrier_complete(bar, b.x, nloc, nx); b.st[0] = nloc; b.st[1] = nx; }
    const unsigned old = xb_add(&bar[XB_XSUB(b.x)], 1u);
    const unsigned gen = old / nloc;
    if (old + 1u == (gen + 1u) * nloc) {
      __builtin_amdgcn_fence(__ATOMIC_RELEASE, "agent");
      asm volatile("s_waitcnt vmcnt(0)" ::: "memory");
      const unsigned og = xb_add(&bar[XB_TOP], 1u);
      const unsigned tg = og / nx;
      if (og + 1u == (tg + 1u) * nx) xb_add(&bar[XB_TOPGEN], 1u);
      else XB_SPIN(xb_ld(&bar[XB_TOPGEN]) == tg, bar);
      __builtin_amdgcn_fence(__ATOMIC_ACQUIRE, "agent");
      xb_add(&bar[XB_XGEN(b.x)], 1u);
      asm volatile("s_waitcnt vmcnt(0)" ::: "memory");
    } else {
      XB_SPIN(xb_ld(&bar[XB_XGEN(b.x)]) == gen, bar);
      __builtin_amdgcn_fence(__ATOMIC_ACQUIRE, "agent");
      asm volatile("s_waitcnt vmcnt(0)" ::: "memory");
    }
  }
  __syncthreads();
}

extern __shared__ __attribute__((aligned(16))) unsigned char smem[];

__global__ void __launch_bounds__(512) mk_fwd(Params p) {
  cg::grid_group grid = cg::this_grid();
  unsigned char* ws = p.ws;
  volatile LAS unsigned* xst = (volatile LAS unsigned*)(unsigned long)(LDS_BYTES - 16);
  if (opaque_tid() == 0) { xst[0] = 0u; xst[1] = 0u; }
  __syncthreads();
  const XcdBarrier xb = xcd_barrier_post((unsigned*)(ws + WS_BAR), xst);
  if (opaque_tid() == 0) xst[2] = xb_add(&xb.bar[XCD_BAR_WORDS + 32 * xb.x], 1u);
  int bperm = blockIdx.x;
  {
    const long gtid = (long)blockIdx.x * 512 + opaque_tid(), nthr = (long)gridDim.x * 512;
    conv_weight(p.w_in, 3600, 1024, NPROJ, (u16*)(ws + WS_WIN), 0, nullptr, gtid, nthr);
    conv_weight(p.w_out, 1024, 1024, 1024, (u16*)(ws + WS_WOUT), 0, nullptr, gtid, nthr);
    conv_weight(p.w_up, 5632, 1024, 5632, (u16*)(ws + WS_WUP), 1, p.norm2, gtid, nthr);
    conv_weight(p.w_down, 1024, 2816, 1024, (u16*)(ws + WS_WDOWN), 0, nullptr, gtid, nthr);
  }
#pragma unroll 1
  for (int grp = 0; grp < 3; ++grp) {
    const float* xg = (grp == 0) ? p.xp : (p.xs + (long)(grp - 1) * TG * 1024);
    float* outg = p.out + (long)grp * TG * 1024;
    REP(0) { phase_norm(p, xg, ws, smem); __syncthreads(); }
    if (grp == 0) {
      grid.sync();
      unsigned off = 0u;
#pragma unroll
      for (unsigned j = 0; j < 16; ++j) { const unsigned c = xb_ld(&xb.bar[XB_XCNT(j)]); off += (j < xb.x) ? c : 0u; }
      bperm = __builtin_amdgcn_readfirstlane((int)(off + xst[2]));
    } else GSYNC();
    REP(1) gemm8_run<1>(grp, ws, xg, outg, bperm);
    GSYNC();
    phase_prep(p, grp, ws);
    GSYNC();
    {
      REP(4) for (int it = blockIdx.x; it < 2048; it += gridDim.x) dnlocal_item(ws, smem, it);
    }
    GSYNC();
    {
      const int nchains = (grp == 0) ? 16 : 128;
      REP(3) for (int c = blockIdx.x; c < nchains; c += gridDim.x) scan_chain(grp, ws, smem, c);
      unsigned* qctr = xb.bar + XCD_BAR_WORDS + 32 * 16 + 32 * grp;
      for (;;) {
        if (opaque_tid() == 0) xst[3] = xb_add(qctr, 1u);
        __syncthreads();
        const int it = __builtin_amdgcn_readfirstlane((int)xst[3]);
        if (it >= 6144) break;
        attn_item(grp, ws, smem, it);
      }
    }
    GSYNC();
    REP(5) phase_merge(p, ws);
    GSYNC();
    REP(8) gemm8_run<2>(grp, ws, xg, outg, bperm);
    GSYNC();
    REP(9) gemm8_glu(p, grp, ws, bperm);
    GSYNC();
    REP(11) gemm8_run<4>(grp, ws, xg, outg, bperm);
  }
}

extern "C" void kernel_launch(void* const* d_in, const int* in_sizes, int n_in, void* d_out, int out_size,
                              void* d_ws, size_t ws_size, hipStream_t stream) {
  static int grid_blocks = 0;
  if (!grid_blocks) {
    int dev = 0, cus = 0, per_cu = 0;
    (void)hipGetDevice(&dev);
    (void)hipDeviceGetAttribute(&cus, hipDeviceAttributeMultiprocessorCount, dev);
    (void)hipFuncSetAttribute((const void*)mk_fwd, hipFuncAttributeMaxDynamicSharedMemorySize, LDS_BYTES);
    (void)hipOccupancyMaxActiveBlocksPerMultiprocessor(&per_cu, (const void*)mk_fwd, 512, LDS_BYTES);
    if (per_cu < 1) per_cu = 1;
    grid_blocks = cus * per_cu;
    if (ws_size < 883 * MiB) fprintf(stderr, "workspace too small: %zu\n", ws_size);
  }
  Params p{};
  p.xp = (const float*)d_in[0]; p.xs = (const float*)d_in[1]; p.norm1 = (const float*)d_in[2]; p.w_in = (const float*)d_in[3];
  p.qn = (const float*)d_in[4]; p.kn = (const float*)d_in[5]; p.dn_conv_w = (const float*)d_in[6]; p.a_log = (const float*)d_in[7];
  p.dt_bias = (const float*)d_in[8]; p.out_norm = (const float*)d_in[9]; p.w_out = (const float*)d_in[10]; p.norm2 = (const float*)d_in[11];
  p.w_up = (const float*)d_in[12]; p.ffn_cw = (const float*)d_in[13]; p.ffn_cb = (const float*)d_in[14]; p.w_down = (const float*)d_in[15];
  p.out = (float*)d_out; p.ws = (unsigned char*)d_ws;
  (void)hipMemsetAsync((unsigned char*)d_ws + WS_BAR, 0, 16384, stream);
  void* args[] = {&p};
  hipError_t e = hipLaunchCooperativeKernel((void*)mk_fwd, dim3(grid_blocks), dim3(512), args, LDS_BYTES, stream);
  if (e != hipSuccess) fprintf(stderr, "cooperative launch failed: %s (grid %d)\n", hipGetErrorString(e), grid_blocks);
}
```

```cpp
#include <hip/hip_runtime.h>
#include <hip/hip_cooperative_groups.h>
#include <cstdio>
namespace cg = cooperative_groups;

typedef unsigned short u16;
typedef __attribute__((ext_vector_type(8))) short bf16x8;
typedef __attribute__((ext_vector_type(4))) float f32x4;
typedef __attribute__((ext_vector_type(4))) unsigned u32x4;
typedef __attribute__((ext_vector_type(2))) unsigned u32x2;
typedef short s16x4 __attribute__((ext_vector_type(4)));
typedef __bf16 bf2_t __attribute__((ext_vector_type(2)));
typedef float f2_t __attribute__((ext_vector_type(2)));
#define DI __device__ __forceinline__

constexpr int TG = 32768;
constexpr int NPROJ = 3584;
constexpr size_t MiB = 1u << 20;
constexpr size_t WS_WIN = 0, WS_WOUT = 7 * MiB, WS_WUP = 9 * MiB, WS_WDOWN = 20 * MiB;
constexpr size_t WS_GATES = 27 * MiB, WS_LSE = 29 * MiB, WS_ROWSQ = 32 * MiB, WS_EGL = 34 * MiB;
constexpr size_t WS_BAR = 34 * MiB + 512 * 1024;
constexpr size_t WS_NBUF = 35 * MiB;
constexpr size_t WS_PROJ = 99 * MiB;
constexpr size_t WS_HB = WS_PROJ, WS_ACT = WS_PROJ + 64 * MiB;
constexpr size_t WS_DNP = 339 * MiB, WS_ATTP = 435 * MiB, WS_DNOP = 531 * MiB, WS_OF = 819 * MiB;
constexpr size_t WS_NBUF2 = 883 * MiB;
constexpr int DNOP_BYTES = 73728;
constexpr int OP_WN = 0, OP_QD = 16384, OP_QK = 32768, OP_KDT = 40960, OP_UT = 57344;
constexpr int LDS_BYTES = 163840;
#ifndef PROBE_MASK
#define PROBE_MASK 0
#endif
#define GSYNC() do { xcd_barrier(xb); if ((PROBE_MASK >> 7) & 1) xcd_barrier(xb); } while (0)
#define REP(bit) for (int rep_ = 0; rep_ < (((PROBE_MASK) >> (bit)) & 1) + 1; ++rep_)

struct Params {
  const float *xp, *xs, *norm1, *w_in, *qn, *kn, *dn_conv_w, *a_log, *dt_bias, *out_norm, *w_out, *norm2, *w_up, *ffn_cw, *ffn_cb, *w_down;
  float* out; unsigned char* ws;
  const float* xgrp[3];
};

DI float bf2f(unsigned v) { return __uint_as_float(v << 16); }
DI float bflo(unsigned v) { return __uint_as_float(v << 16); }
DI float bfhi(unsigned v) { return __uint_as_float(v & 0xffff0000u); }
DI unsigned pk2(float lo, float hi) { f2_t v = {lo, hi}; bf2_t r = __builtin_convertvector(v, bf2_t); return __builtin_bit_cast(unsigned, r); }
DI u16 f2bf(float x) { return (u16)(pk2(x, 0.f) & 0xffffu); }
DI int opaque_tid() {
  const int wv = __builtin_amdgcn_readfirstlane((int)threadIdx.x >> 6);
  int ln;
  asm volatile("v_mbcnt_lo_u32_b32 %0, -1, 0\n\tv_mbcnt_hi_u32_b32 %0, -1, %0" : "=v"(ln));
  return (wv << 6) | ln; }
DI float dpp_f(float v, const int ctrl_sel) {
  const int x = __float_as_int(v);
  int r;
  if (ctrl_sel == 0) r = __builtin_amdgcn_update_dpp(x, x, 0xB1, 0xF, 0xF, true);
  else if (ctrl_sel == 1) r = __builtin_amdgcn_update_dpp(x, x, 0x4E, 0xF, 0xF, true);
  else if (ctrl_sel == 2) r = __builtin_amdgcn_update_dpp(x, x, 0x141, 0xF, 0xF, true);
  else r = __builtin_amdgcn_update_dpp(x, x, 0x140, 0xF, 0xF, true);
  return __int_as_float(r);
}
DI float sum16(float v) {
  v += dpp_f(v, 0); v += dpp_f(v, 1); v += dpp_f(v, 2); v += dpp_f(v, 3);
  return v;
}
DI float wave_sum(float v) {
  v = sum16(v);
  v += __shfl_xor(v, 16); v += __shfl_xor(v, 32);
  return v;
}
DI f32x4 mfma16(bf16x8 a, bf16x8 b, f32x4 c) { return __builtin_amdgcn_mfma_f32_16x16x32_bf16(a, b, c, 0, 0, 0); }
#define LAS __attribute__((address_space(3)))
DI void glds16(const void* g, unsigned ldsoff) {
  __builtin_amdgcn_global_load_lds((const __attribute__((address_space(1))) void*)g, (LAS void*)(unsigned long)ldsoff, 16, 0, 0);
}
DI int kperm(int k) { return (k & ~31) | (((k >> 2) & 3) << 3) | (((k >> 4) & 1) << 2) | (k & 3); }
DI float sigmoidf_(float x) { return __builtin_amdgcn_rcpf(1.f + __expf(-x)); }
DI float siluf_(float x) { return x * __builtin_amdgcn_rcpf(1.f + __expf(-x)); }

DI void conv_weight(const float* __restrict__ W, int Nsrc, int K, int Nout, u16* __restrict__ WT, int mode, const float* __restrict__ scale,
                    long gtid, long nthr) {
  const int kgn = K >> 3;
  for (long idx = gtid; idx < (long)Nout * kgn; idx += nthr) {
    const int n = (int)(idx % Nout), kg = (int)(idx / Nout);
    int src = n;
    if (mode == 1) { const int pn = n >> 8, ct = n & 255; src = (ct < 128) ? (pn * 128 + ct) : (2816 + pn * 128 + ct - 128); }
    float v[8];
#pragma unroll
    for (int j = 0; j < 8; ++j) { const int k = kg * 8 + j; const float s = scale ? scale[k] : 1.f; v[j] = W[(long)k * Nsrc + src] * s; }
    u32x4 o = {pk2(v[0], v[1]), pk2(v[2], v[3]), pk2(v[4], v[5]), pk2(v[6], v[7])};
    *(u32x4*)(WT + (long)n * K + kg * 8) = o;
  }
}

template <int B0>
DI void phase_norm(const Params& p, const float* __restrict__ xg, unsigned char* ws, unsigned char* smem) {
  const int b0 = B0, nb = (int)gridDim.x - B0;
  const int tidx = opaque_tid();
  f32x4* gw4 = (f32x4*)smem;
  float* gwf = (float*)smem;
  for (int e = tidx; e < 1024 * 16; e += 512) {
    const int k = e >> 4, jg = e & 15;
    const int ln = (k >> 2) & 63, j = k >> 8, ee = k & 3, q = jg >> 2, cmp = jg & 3;
    gwf[((((j * 4 + ee) * 4 + q) * 64 + ln) << 2) + cmp] = p.w_in[(long)k * 3600 + 3584 + jg];
  }
  __syncthreads();
  const int wave = tidx >> 6, lane = tidx & 63;
  u16* nbuf = (u16*)(ws + WS_NBUF2); float* gates = (float*)(ws + WS_GATES);
  const int bl = (int)blockIdx.x - b0;
  f32x4 vn[4];
  {
    const f32x4* xr = (const f32x4*)(xg + (long)(bl * 8 + wave) * 1024);
#pragma unroll
    for (int j = 0; j < 4; ++j) vn[j] = xr[lane + 64 * j];
  }
  for (int row = bl * 8 + wave; row < TG; row += nb * 8) {
    f32x4 v[4]; float ss = 0.f;
#pragma unroll
    for (int j = 0; j < 4; ++j) { v[j] = vn[j]; ss += v[j].x * v[j].x + v[j].y * v[j].y + v[j].z * v[j].z + v[j].w * v[j].w; }
    {
      const int rn = row + nb * 8;
      const f32x4* xr = (const f32x4*)(xg + (long)(rn < TG ? rn : row) * 1024);
#pragma unroll
      for (int j = 0; j < 4; ++j) vn[j] = xr[lane + 64 * j];
    }
    ss = wave_sum(ss);
    const float rs = rsqrtf(ss * (1.f / 1024.f) + 1e-6f);
    float ga[16];
#pragma unroll
    for (int i = 0; i < 16; ++i) ga[i] = 0.f;
#pragma unroll
    for (int j = 0; j < 4; ++j) {
      const f32x4 nw = ((const f32x4*)p.norm1)[lane + 64 * j];
      v[j].x *= rs * nw.x; v[j].y *= rs * nw.y; v[j].z *= rs * nw.z; v[j].w *= rs * nw.w;
      u32x2 o = {pk2(v[j].x, v[j].y), pk2(v[j].z, v[j].w)};
      *(u32x2*)(nbuf + (long)row * 1024 + 4 * (lane + 64 * j)) = o;
#pragma unroll
      for (int e = 0; e < 4; ++e) {
        const float xv = v[j][e];
#pragma unroll
        for (int q = 0; q < 4; ++q) {
          const f32x4 w4 = gw4[((j * 4 + e) * 4 + q) * 64 + lane];
          ga[4 * q + 0] += xv * w4.x; ga[4 * q + 1] += xv * w4.y; ga[4 * q + 2] += xv * w4.z; ga[4 * q + 3] += xv * w4.w;
        }
        __builtin_amdgcn_sched_barrier(0);
      }
    }
    float r = 0.f;
#pragma unroll
    for (int i = 0; i < 16; ++i) { const float s = wave_sum(ga[i]); r = (lane == i) ? s : r; }
    if (lane < 16) {
      float o;
      if (lane < 8) o = sigmoidf_(r);
      else { const int jj = lane - 8; const float z = r + p.dt_bias[jj]; const float ez = __expf(z); const float sp = (z > 20.f) ? z : ((ez < 0.02f) ? ez * (1.f - ez * (0.5f - ez * (1.f / 3.f))) : __logf(1.f + ez)); o = -__expf(p.a_log[jj]) * sp; }
      gates[(long)row * 16 + lane] = o;
    }
  }
}

DI void phase_prep(const Params& p, int grp, unsigned char* ws) {
  const int tidx = opaque_tid();
  const int L = (grp == 0) ? 16384 : 2048;
  const int lane = tidx & 63;
  const int gw = blockIdx.x * 8 + (tidx >> 6), NW = gridDim.x * 8;
  u16* proj = (u16*)(ws + WS_PROJ);
  {
    const int i = lane & 15;
    const float f0 = exp2f(-(float)(2 * i) * (13.287712379549449f / 32.f)), f1 = exp2f(-(float)(2 * i + 1) * (13.287712379549449f / 32.f));
    for (int tb = gw; tb < TG; tb += 4 * NW) {
      unsigned elo[4][4], ehi[4][4];
#pragma unroll
      for (int kt = 0; kt < 4; ++kt)
#pragma unroll
        for (int k = 0; k < 4; ++k) {
          const int tt = tb + kt * NW, t = tt < TG ? tt : TG - 1, hs = (lane >> 4) + 4 * k;
          const u16* ptr = proj + (long)t * NPROJ + hs * 64;
          elo[kt][k] = *(const unsigned*)(ptr + 2 * i); ehi[kt][k] = *(const unsigned*)(ptr + 32 + 2 * i);
        }
#pragma unroll
      for (int kt = 0; kt < 4; ++kt) {
        const int t = tb + kt * NW;
        if (t >= TG) break;
        float s0, c0, s1, c1;
        {
          const float pos = (float)(t & (L - 1));
          __sincosf(pos * f0, &s0, &c0); __sincosf(pos * f1, &s1, &c1);
        }
#pragma unroll
        for (int k = 0; k < 4; ++k) {
          const int hs = (lane >> 4) + 4 * k;
          u16* ptr = proj + (long)t * NPROJ + hs * 64;
          float x1a = bflo(elo[kt][k]), x1b = bfhi(elo[kt][k]), x2a = bflo(ehi[kt][k]), x2b = bfhi(ehi[kt][k]);
          float ss = x1a * x1a + x1b * x1b + x2a * x2a + x2b * x2b;
          ss = sum16(ss);
          const float rs = __builtin_amdgcn_rsqf(ss * (1.f / 64.f) + 1e-6f);
          const float* gn = (hs < 8) ? p.qn : p.kn;
          const float sc = (hs < 8) ? 0.125f : 1.f;
          x1a *= rs * gn[2 * i]; x1b *= rs * gn[2 * i + 1]; x2a *= rs * gn[32 + 2 * i]; x2b *= rs * gn[33 + 2 * i];
          const float o1a = (x1a * c0 - x2a * s0) * sc, o2a = (x2a * c0 + x1a * s0) * sc;
          const float o1b = (x1b * c1 - x2b * s1) * sc, o2b = (x2b * c1 + x1b * s1) * sc;
          *(unsigned*)(ptr + 2 * i) = pk2(o1a, o1b); *(unsigned*)(ptr + 32 + 2 * i) = pk2(o2a, o2b);
        }
      }
    }
  }
  {
    u16* dnp = (u16*)(ws + WS_DNP);
    const int q = lane >> 4, cb = lane & 15;
    for (int unit = gw; unit < 12 * (TG / 64); unit += NW) {
      const int s = unit % 12, r = unit / 12, t0 = r * 64;
      const int c = s * 128 + cb * 8;
      f32x4 wlo[5], whi[5];
#pragma unroll
      for (int j = 0; j < 5; ++j) { wlo[j] = *(const f32x4*)(p.dn_conv_w + j * 1536 + c); whi[j] = *(const f32x4*)(p.dn_conv_w + j * 1536 + c + 4); }
      const u16* src = proj + 1536 + c;
      const int ts = t0 + 16 * q, pos_s = (t0 & (L - 1)) + 16 * q;
      const u32x4 zero4 = {0u, 0u, 0u, 0u};
      u32x4 win[5];
      win[0] = (pos_s >= 2) ? *(const u32x4*)(src + (long)(ts - 2) * NPROJ) : zero4;
      win[1] = (pos_s >= 1) ? *(const u32x4*)(src + (long)(ts - 1) * NPROJ) : zero4;
      win[2] = *(const u32x4*)(src + (long)ts * NPROJ);
      win[3] = *(const u32x4*)(src + (long)(ts + 1) * NPROJ);
      u32x4 nw[16];
#pragma unroll
      for (int u = 0; u < 16; ++u) nw[u] = (pos_s + u + 2 < L) ? *(const u32x4*)(src + (long)(ts + u + 2) * NPROJ) : zero4;
      const float qs = (s < 4) ? 0.08838834764831845f : 1.f;
#pragma unroll
      for (int u = 0; u < 16; ++u) {
        win[4] = nw[u];
        float a[8];
#pragma unroll
        for (int e = 0; e < 8; ++e) a[e] = 0.f;
#pragma unroll
        for (int j = 0; j < 5; ++j) {
          a[0] += wlo[j].x * bflo(win[j].x); a[1] += wlo[j].y * bfhi(win[j].x); a[2] += wlo[j].z * bflo(win[j].y); a[3] += wlo[j].w * bfhi(win[j].y);
          a[4] += whi[j].x * bflo(win[j].z); a[5] += whi[j].y * bfhi(win[j].z); a[6] += whi[j].z * bflo(win[j].w); a[7] += whi[j].w * bfhi(win[j].w);
        }
        float ss = 0.f;
#pragma unroll
        for (int e = 0; e < 8; ++e) { a[e] = siluf_(a[e]); ss += a[e] * a[e]; }
        if (s < 8) {
          ss = sum16(ss);
          const float rs = __builtin_amdgcn_rsqf(ss + 1e-6f) * qs;
#pragma unroll
          for (int e = 0; e < 8; ++e) a[e] *= rs;
        }
        u32x4 o = {pk2(a[0], a[1]), pk2(a[2], a[3]), pk2(a[4], a[5]), pk2(a[6], a[7])};
        *(u32x4*)(dnp + (long)(ts + u) * 1536 + c) = o;
#pragma unroll
        for (int j = 0; j < 4; ++j) win[j] = win[j + 1];
      }
    }
  }
}

DI void attn_item(int grp, unsigned char* ws, unsigned char* smem, int item) {
  const int tidx = opaque_tid();
  const int L = (grp == 0) ? 16384 : 2048;
  const int pat = item >> 11, rem = item & 2047, h = rem & 7, bi = rem >> 3;
  const int dsh = pat * 2, d = 1 << dsh;
  const int st = bi >> dsh, r = bi & (d - 1), base = st * (128 << dsh), s0 = base & ~(L - 1);
  const int tid = tidx, lane = tid & 63, w = tid >> 6, c16 = lane & 15, g = lane >> 4;
  const u16* proj = (const u16*)(ws + WS_PROJ);
  unsigned char* Qs = smem; unsigned char* Ks = smem + 16384;
  const unsigned VS = 49152u;
  for (int e = tid; e < 1024; e += 512) {
    const int row = e >> 3, ch = e & 7; const long lt = base + r + (row << dsh);
    const u32x4 v = *(const u32x4*)(proj + lt * NPROJ + h * 64 + ch * 8);
    *(u32x4*)(Qs + row * 128 + ((ch ^ (row & 7)) << 4)) = v;
  }
  for (int e = tid; e < 2048; e += 512) {
    const int row = e >> 3, ch = e & 7; const int lt = base + r + (row - 64) * d;
    const bool valid = (lt >= s0) && (lt < s0 + L);
    u32x4 kv = {0u, 0u, 0u, 0u}, vv = {0u, 0u, 0u, 0u};
    if (valid) { kv = *(const u32x4*)(proj + (long)lt * NPROJ + 512 + h * 64 + ch * 8); vv = *(const u32x4*)(proj + (long)lt * NPROJ + 1024 + h * 64 + ch * 8); }
    *(u32x4*)(Ks + row * 128 + ((ch ^ (row & 7)) << 4)) = kv;
    *(u32x4*)(smem + VS + row * 160 + ch * 16) = vv;
  }
  __syncthreads();
  const int sw = c16 & 7, tb = w & ~1;
  bf16x8 qf[2];
#pragma unroll
  for (int kk = 0; kk < 2; ++kk) qf[kk] = *(const bf16x8*)(Qs + (16 * w + c16) * 128 + (((kk * 4 + g) ^ sw) << 4));
  f32x4 sc[10];
  {
    bf16x8 kf[10][2];
#pragma unroll
    for (int t = 0; t < 10; ++t)
#pragma unroll
      for (int kk = 0; kk < 2; ++kk) kf[t][kk] = *(const bf16x8*)(Ks + ((tb + t) * 16 + c16) * 128 + (((kk * 4 + g) ^ sw) << 4));
    __builtin_amdgcn_sched_barrier(0);
#pragma unroll
    for (int t = 0; t < 10; ++t) {
      f32x4 a = {0.f, 0.f, 0.f, 0.f};
#pragma unroll
      for (int kk = 0; kk < 2; ++kk) a = mfma16(kf[t][kk], qf[kk], a);
      sc[t] = a;
    }
  }
  const int qi = 16 * w + c16;
  float mx = -1e30f;
#pragma unroll
  for (int t = 0; t < 10; ++t)
#pragma unroll
    for (int j = 0; j < 4; ++j) {
      const int kj = (tb + t) * 16 + g * 4 + j - 64;
      const int lt = base + r + kj * d;
      const int df = qi - kj;
      const bool valid = (df <= 64) && (df >= -64) && (lt >= s0) && (lt < s0 + L);
      const float s = valid ? sc[t][j] : -1e30f;
      sc[t][j] = s; mx = fmaxf(mx, s);
    }
  mx = fmaxf(mx, __shfl_xor(mx, 16)); mx = fmaxf(mx, __shfl_xor(mx, 32));
  float den = 0.f;
#pragma unroll
  for (int t = 0; t < 10; ++t)
#pragma unroll
    for (int j = 0; j < 4; ++j) { const float pe = (sc[t][j] > -1e29f) ? __expf(sc[t][j] - mx) : 0.f; sc[t][j] = pe; den += pe; }
  den += __shfl_xor(den, 16); den += __shfl_xor(den, 32);
  f32x4 oa[4];
#pragma unroll
  for (int n = 0; n < 4; ++n) oa[n] = (f32x4){0.f, 0.f, 0.f, 0.f};
  {
    bf16x8 vf[5][4];
#pragma unroll
    for (int tp = 0; tp < 5; ++tp)
#pragma unroll
      for (int n = 0; n < 4; ++n) {
        const unsigned a0 = VS + ((tb + 2 * tp) * 16 + g * 4 + (c16 >> 2)) * 160 + n * 32 + (c16 & 3) * 8;
        const s16x4 lo = __builtin_amdgcn_ds_read_tr16_b64_v4i16((LAS s16x4*)(unsigned long)a0);
        const s16x4 hi = __builtin_amdgcn_ds_read_tr16_b64_v4i16((LAS s16x4*)(unsigned long)(a0 + 16 * 160));
        vf[tp][n] = __builtin_shufflevector(lo, hi, 0, 1, 2, 3, 4, 5, 6, 7);
      }
    __builtin_amdgcn_sched_barrier(0);
#pragma unroll
    for (int tp = 0; tp < 5; ++tp) {
      u32x4 pu = {pk2(sc[2 * tp].x, sc[2 * tp].y), pk2(sc[2 * tp].z, sc[2 * tp].w), pk2(sc[2 * tp + 1].x, sc[2 * tp + 1].y), pk2(sc[2 * tp + 1].z, sc[2 * tp + 1].w)};
      const bf16x8 pa = __builtin_bit_cast(bf16x8, pu);
#pragma unroll
      for (int n = 0; n < 4; ++n) oa[n] = mfma16(vf[tp][n], pa, oa[n]);
    }
  }
  u16* attp = (u16*)(ws + WS_ATTP); float* lse = (float*)(ws + WS_LSE);
  {
    const float inv = 1.f / den;
    const long lt = base + r + ((long)qi << dsh);
    u16* dst = attp + ((long)pat * TG + lt) * 512 + h * 64 + g * 4;
#pragma unroll
    for (int n = 0; n < 4; ++n) {
      u32x2 ov = {pk2(oa[n].x * inv, oa[n].y * inv), pk2(oa[n].z * inv, oa[n].w * inv)};
      *(u32x2*)(dst + n * 16) = ov;
    }
  }
  if (g == 0) { const long lt = base + r + ((long)qi << dsh); lse[((long)pat * TG + lt) * 8 + h] = mx + __logf(den); }
  __syncthreads();
}

DI void dnlocal_item(unsigned char* ws, unsigned char* smem, int item) {
  const int tidx = opaque_tid();
  const int ch = item >> 2, hd = item & 3;
  const int tid = tidx, lane = tid & 63, w = tid >> 6, c16 = lane & 15, g = lane >> 4;
  const int dir = tid >> 8, t8 = tid & 255;
  const u16* dnp = (const u16*)(ws + WS_DNP); const float* gates = (const float*)(ws + WS_GATES);
  unsigned char* Kl = smem; unsigned char* Ql = smem + 17408; unsigned char* Vl = smem + 34816;
  float* KK = (float*)(smem + 51200); float* QKm = (float*)(smem + 67584);
  float* Am = (float*)(smem + 83968);
  float* gcs = (float*)(smem + 116736);
  u16* Xs = (u16*)(smem + 51200);
  unsigned char* opnd = ws + WS_DNOP + (long)item * 2 * DNOP_BYTES;
  const long tok0 = (long)ch * 64;
  for (int e = tid; e < 3072; e += 512) {
    const int which = e >> 10, q = e & 1023, row = q >> 4, c8 = q & 15;
    const u32x4 v = *(const u32x4*)(dnp + (tok0 + row) * 1536 + which * 512 + hd * 128 + c8 * 8);
    unsigned char* dst = (which == 0) ? (Ql + row * 272) : (which == 1) ? (Kl + row * 272) : (Vl + row * 256);
    *(u32x4*)(dst + c8 * 16) = v;
  }
  if (tid < 128) {
    const int dd = tid >> 6, i = tid & 63, ri = dd ? 63 - i : i;
    const float be = gates[(tok0 + ri) * 16 + dd * 4 + hd];
    float gv = gates[(tok0 + ri) * 16 + 8 + dd * 4 + hd];
#pragma unroll
    for (int o = 1; o < 64; o <<= 1) { const float t = __shfl_up(gv, o); if (i >= o) gv += t; }
    gcs[dd * 64 + i] = gv; gcs[128 + dd * 64 + i] = be; gcs[256 + dd * 64 + i] = be * __expf(gv);
  }
  __syncthreads();
  {
    const int which = w >> 2, mt = w & 3;
    const unsigned char* Asrc = which ? Ql : Kl;
    f32x4 a4[4];
#pragma unroll
    for (int n = 0; n < 4; ++n) a4[n] = (f32x4){0.f, 0.f, 0.f, 0.f};
    {
      bf16x8 af[4], bfv[4][4];
#pragma unroll
      for (int kk = 0; kk < 4; ++kk) {
        af[kk] = *(const bf16x8*)(Asrc + (mt * 16 + c16) * 272 + (kk * 4 + g) * 16);
#pragma unroll
        for (int n = 0; n < 4; ++n) bfv[kk][n] = *(const bf16x8*)(Kl + (n * 16 + c16) * 272 + (kk * 4 + g) * 16);
      }
      __builtin_amdgcn_sched_barrier(0);
#pragma unroll
      for (int kk = 0; kk < 4; ++kk)
#pragma unroll
        for (int n = 0; n < 4; ++n) a4[n] = mfma16(af[kk], bfv[kk][n], a4[n]);
    }
    float* dst = which ? QKm : KK;
#pragma unroll
    for (int n = 0; n < 4; ++n)
#pragma unroll
      for (int j = 0; j < 4; ++j) dst[(mt * 16 + g * 4 + j) * 64 + n * 16 + c16] = a4[n][j];
  }
  __syncthreads();
  {
    const float* gc = gcs + dir * 64; const float* be = gcs + 128 + dir * 64;
    u16* qkout = (u16*)(opnd + dir * DNOP_BYTES + OP_QK);
#pragma unroll
    for (int e8 = 0; e8 < 8; ++e8) {
      const int e = t8 + 256 * e8;
      const int i = e >> 5, j = (e & 31) * 2;
      const int ri = dir ? 63 - i : i, rj = dir ? 63 - j : j, rj1 = dir ? 62 - j : j + 1;
      const float gi = gc[i];
      const float d0 = __expf(gi - gc[j]), d1 = __expf(gi - gc[j + 1]);
      const float bi = be[i];
      Am[(dir * 64 + i) * 64 + j] = (j < i) ? bi * KK[ri * 64 + rj] * d0 : 0.f;
      Am[(dir * 64 + i) * 64 + j + 1] = (j + 1 < i) ? bi * KK[ri * 64 + rj1] * d1 : 0.f;
      const float q0 = (j <= i) ? QKm[ri * 64 + rj] * d0 : 0.f, q1 = (j + 1 <= i) ? QKm[ri * 64 + rj1] * d1 : 0.f;
      *(unsigned*)(qkout + i * 64 + kperm(j)) = pk2(q0, q1);
    }
  }
  __syncthreads();
  {
    const bool isu = t8 < 128;
    const unsigned char* src = isu ? (Vl + t8 * 2) : (Kl + (t8 - 128) * 2);
    const int sstr = isu ? 256 : 272;
    const float* scl = gcs + (isu ? 128 : 256) + dir * 64;
    const float* Ad = Am + dir * 4096;
    float X[64];
    f32x4 av[2][16]; float rv[2];
    rv[0] = bf2f(*(const u16*)(src + (dir ? 63 : 0) * sstr)) * scl[0];
#pragma unroll
    for (int i = 0; i < 64; ++i) {
      if (i + 1 < 64) {
        const int rn = dir ? 62 - i : i + 1;
#pragma unroll
        for (int j4 = 0; j4 < (i + 4) / 4; ++j4) av[(i + 1) & 1][j4] = *(const f32x4*)(Ad + (i + 1) * 64 + j4 * 4);
        rv[(i + 1) & 1] = bf2f(*(const u16*)(src + rn * sstr)) * scl[i + 1];
      }
      __builtin_amdgcn_sched_barrier(0);
      float a = rv[i & 1], b = 0.f;
#pragma unroll
      for (int j4 = 0; j4 < (i + 3) / 4; ++j4) {
        if (4 * j4 + 0 < i) a -= av[i & 1][j4].x * X[4 * j4 + 0];
        if (4 * j4 + 1 < i) b -= av[i & 1][j4].y * X[4 * j4 + 1];
        if (4 * j4 + 2 < i) a -= av[i & 1][j4].z * X[4 * j4 + 2];
        if (4 * j4 + 3 < i) b -= av[i & 1][j4].w * X[4 * j4 + 3];
      }
      X[i] = a + b;
      __builtin_amdgcn_sched_barrier(0);
    }
    if (isu) {
      u32x4* dst = (u32x4*)(opnd + dir * DNOP_BYTES + OP_UT + t8 * 128);
#pragma unroll
      for (int q = 0; q < 8; ++q) { u32x4 o = {pk2(X[8 * q], X[8 * q + 1]), pk2(X[8 * q + 2], X[8 * q + 3]), pk2(X[8 * q + 4], X[8 * q + 5]), pk2(X[8 * q + 6], X[8 * q + 7])}; dst[q] = o; }
    } else {
      u16* xd = Xs + dir * 8192 + kperm(t8 - 128);
#pragma unroll
      for (int i = 0; i < 64; ++i) xd[i * 128] = f2bf(-X[i]);
    }
  }
  __syncthreads();
  {
#pragma unroll
    for (int e4 = 0; e4 < 4; ++e4) {
      const int e = tid + 512 * e4;
      const int dd = e >> 10, q = e & 1023;
      *(u32x4*)(opnd + dd * DNOP_BYTES + OP_WN + q * 16) = *(const u32x4*)((const unsigned char*)Xs + dd * 16384 + q * 16);
    }
#pragma unroll
    for (int e4 = 0; e4 < 4; ++e4) {
      const int e = tid + 512 * e4;
      const int dd = e >> 10, q = e & 1023, i = q >> 4, c8 = q & 15, ri = dd ? 63 - i : i;
      const float sc = __expf(gcs[dd * 64 + i]);
      const int kb = c8 >> 2, gg = c8 & 3;
      const u32x2 v0 = *(const u32x2*)(Ql + ri * 272 + (kb * 32 + gg * 4) * 2), v1 = *(const u32x2*)(Ql + ri * 272 + (kb * 32 + 16 + gg * 4) * 2);
      u32x4 o = {pk2(bflo(v0.x) * sc, bfhi(v0.x) * sc), pk2(bflo(v0.y) * sc, bfhi(v0.y) * sc), pk2(bflo(v1.x) * sc, bfhi(v1.x) * sc), pk2(bflo(v1.y) * sc, bfhi(v1.y) * sc)};
      *(u32x4*)(opnd + dd * DNOP_BYTES + OP_QD + q * 16) = o;
    }
    {
      const int dk = t8 & 127, half = t8 >> 7;
      const float gl = gcs[dir * 64 + 63];
      u32x4* dst = (u32x4*)(opnd + dir * DNOP_BYTES + OP_KDT + dk * 128 + half * 64);
#pragma unroll
      for (int q = 0; q < 4; ++q) {
        float v[8];
#pragma unroll
        for (int jj = 0; jj < 8; ++jj) {
          const int i = half * 32 + (jj >> 2) * 16 + q * 4 + (jj & 3), ri = dir ? 63 - i : i;
          v[jj] = bf2f(*(const u16*)(Kl + ri * 272 + dk * 2)) * __expf(gl - gcs[dir * 64 + i]);
        }
        u32x4 o = {pk2(v[0], v[1]), pk2(v[2], v[3]), pk2(v[4], v[5]), pk2(v[6], v[7])};
        dst[q] = o;
      }
      if (t8 == 0) ((float*)(ws + WS_EGL))[item * 2 + dir] = __expf(gl);
    }
  }
  __syncthreads();
}

constexpr int SCAN_BUF = 73728 + 256;
DI void glds4(const void* g, unsigned ldsoff) {
  __builtin_amdgcn_global_load_lds((const __attribute__((address_space(1))) void*)g, (LAS void*)(unsigned long)ldsoff, 4, 0, 0);
}
DI void scan_issue(const unsigned char* src, const float* egp, unsigned ldsbase, int tid) {
  if (tid < 256) {
#pragma unroll
    for (int i = 0; i < 18; ++i) {
      const int q = tid + 256 * i;
      int sq;
      if (i < 8) sq = (q & ~15) | ((q & 15) ^ ((q >> 4) & 15));
      else sq = (q & ~7) | ((q & 7) ^ ((q >> 4) & 7));
      glds16(src + sq * 16, ldsbase + q * 16);
    }
    if (tid < 64) glds4(egp, ldsbase + 73728 + tid * 4);
  }
}
#define SB_ __builtin_amdgcn_sched_barrier(0)
DI void scan_compute(const unsigned char* B, int chk, int dir, int hd, u16* obuf, f32x4 (&S)[8], int w, int c16, int g) {
  const float eg = *(const float*)(B + 73728);
  const int x15 = c16, x7 = (c16 >> 1) & 7;
  bf16x8 sb[4];
#pragma unroll
  for (int kb = 0; kb < 4; ++kb) {
    u32x4 u = {pk2(S[2 * kb].x, S[2 * kb].y), pk2(S[2 * kb].z, S[2 * kb].w), pk2(S[2 * kb + 1].x, S[2 * kb + 1].y), pk2(S[2 * kb + 1].z, S[2 * kb + 1].w)};
    sb[kb] = __builtin_bit_cast(bf16x8, u);
  }
  f32x4 va[4], oa[4];
#pragma unroll
  for (int mt = 0; mt < 4; ++mt) {
    const u32x2 uu = *(const u32x2*)(B + 57344 + (16 * w + c16) * 128 + (((mt * 2 + (g >> 1)) ^ x7) << 4) + (g & 1) * 8);
    va[mt] = (f32x4){bflo(uu.x), bfhi(uu.x), bflo(uu.y), bfhi(uu.y)};
    oa[mt] = (f32x4){0.f, 0.f, 0.f, 0.f};
  }
  const unsigned char* wrow = B + c16 * 256;
  bf16x8 f0[8], f1[8];
#define LDWQ_(dst, kb) _Pragma("unroll") for (int mt = 0; mt < 4; ++mt) { const unsigned char* ap = wrow + mt * 4096 + ((((kb) * 4 + g) ^ x15) << 4); dst[mt] = *(const bf16x8*)ap; dst[4 + mt] = *(const bf16x8*)(ap + 16384); }
#define MMWQ_(src, kb) _Pragma("unroll") for (int mt = 0; mt < 4; ++mt) { va[mt] = mfma16(src[mt], sb[kb], va[mt]); oa[mt] = mfma16(sb[kb], src[4 + mt], oa[mt]); }
  LDWQ_(f0, 0); LDWQ_(f1, 1); SB_;
  MMWQ_(f0, 0); SB_;
  LDWQ_(f0, 2); SB_;
  MMWQ_(f1, 1); SB_;
  LDWQ_(f1, 3); SB_;
  MMWQ_(f0, 2); SB_;
  {
    const unsigned char* qrow = B + 32768 + c16 * 128;
#pragma unroll
    for (int mt = 0; mt < 4; ++mt)
#pragma unroll
      for (int cb = 0; cb < 2; ++cb) f0[mt * 2 + cb] = *(const bf16x8*)(qrow + mt * 2048 + (((cb * 4 + g) ^ x7) << 4));
  }
  SB_;
  MMWQ_(f1, 3); SB_;
#undef LDWQ_
#undef MMWQ_
  bf16x8 vb[2];
#pragma unroll
  for (int cb = 0; cb < 2; ++cb) {
    u32x4 u = {pk2(va[2 * cb].x, va[2 * cb].y), pk2(va[2 * cb].z, va[2 * cb].w), pk2(va[2 * cb + 1].x, va[2 * cb + 1].y), pk2(va[2 * cb + 1].z, va[2 * cb + 1].w)};
    vb[cb] = __builtin_bit_cast(bf16x8, u);
  }
  const unsigned char* krow = B + 40960 + c16 * 128;
#define LDKD_(dst, t0) _Pragma("unroll") for (int t = 0; t < 4; ++t) _Pragma("unroll") for (int cb = 0; cb < 2; ++cb) dst[t * 2 + cb] = *(const bf16x8*)(krow + ((t0) + t) * 2048 + (((cb * 4 + g) ^ x7) << 4));
  LDKD_(f1, 0); SB_;
#pragma unroll
  for (int mt = 0; mt < 4; ++mt)
#pragma unroll
    for (int cb = 0; cb < 2; ++cb) oa[mt] = mfma16(vb[cb], f0[mt * 2 + cb], oa[mt]);
  SB_;
  LDKD_(f0, 4); SB_;
#pragma unroll
  for (int t = 0; t < 4; ++t) {
    f32x4 s = {S[t].x * eg, S[t].y * eg, S[t].z * eg, S[t].w * eg};
#pragma unroll
    for (int cb = 0; cb < 2; ++cb) s = mfma16(f1[t * 2 + cb], vb[cb], s);
    S[t] = s;
  }
  SB_;
#pragma unroll
  for (int t = 0; t < 4; ++t) {
    f32x4 s = {S[4 + t].x * eg, S[4 + t].y * eg, S[4 + t].z * eg, S[4 + t].w * eg};
#pragma unroll
    for (int cb = 0; cb < 2; ++cb) s = mfma16(f0[t * 2 + cb], vb[cb], s);
    S[4 + t] = s;
  }
#undef LDKD_
#pragma unroll
  for (int mt = 0; mt < 4; ++mt) {
    const int i = mt * 16 + c16;
    const long tok = (long)chk * 64 + (dir ? 63 - i : i);
    u32x2 ov = {pk2(oa[mt].x, oa[mt].y), pk2(oa[mt].z, oa[mt].w)};
    *(u32x2*)(obuf + tok * 512 + hd * 128 + 16 * w + g * 4) = ov;
  }
}
#undef SB_

DI void scan_chain(int grp, unsigned char* ws, unsigned char* smem, int chain) {
  const int tidx = opaque_tid();
  const int L = (grp == 0) ? 16384 : 2048, nc = L >> 6;
  const int dir = chain & 1, hd = (chain >> 1) & 3, sq = chain >> 3;
  const int tid = tidx, lane = tid & 63, w = tid >> 6, c16 = lane & 15, g = lane >> 4;
  const int chunk0 = sq * nc;
  const float* egl = (const float*)(ws + WS_EGL);
  u16* obuf = (u16*)(ws + WS_OF) + (long)dir * TG * 512;
  f32x4 S[8];
#pragma unroll
  for (int t = 0; t < 8; ++t) S[t] = (f32x4){0.f, 0.f, 0.f, 0.f};
  __syncthreads();
  {
    const int chk = chunk0 + (dir ? nc - 1 : 0);
    const long it = (long)(chk * 4 + hd) * 2 + dir;
    scan_issue(ws + WS_DNOP + it * DNOP_BYTES, egl + it, 0u, tid);
  }
  __syncthreads();
  for (int m = 0; m < nc; ++m) {
    const int chk = chunk0 + (dir ? nc - 1 - m : m);
    if (m + 1 < nc) {
      const int chn = chunk0 + (dir ? nc - 2 - m : m + 1);
      const long it = (long)(chn * 4 + hd) * 2 + dir;
      scan_issue(ws + WS_DNOP + it * DNOP_BYTES, egl + it, (unsigned)(((m + 1) & 1) * SCAN_BUF), tid);
    }
    scan_compute(smem + (m & 1) * SCAN_BUF, chk, dir, hd, obuf, S, w, c16, g);
    __syncthreads();
  }
}

DI void phase_merge(const Params& p, unsigned char* ws) {
  const int tidx = opaque_tid();
  const int lane = tidx & 63;
  const int gw = blockIdx.x * 8 + (tidx >> 6), NW = gridDim.x * 8;
  const u16* attp = (const u16*)(ws + WS_ATTP); const float* lse = (const float*)(ws + WS_LSE);
  const u16* of = (const u16*)(ws + WS_OF); const u16* proj = (const u16*)(ws + WS_PROJ);
  u16* mix = (u16*)(ws + WS_NBUF);
  f32x4 gn0 = *(const f32x4*)(p.out_norm + (lane & 15) * 8), gn1 = *(const f32x4*)(p.out_norm + (lane & 15) * 8 + 4);
  for (int t0 = gw; t0 < TG; t0 += 4 * NW) {
    float l0[4], l1[4], l2[4]; u32x4 pa[4], pb[4], pc[4], fa[4], fb[4], gg[4];
    const int h = lane >> 3;
#pragma unroll
    for (int k = 0; k < 4; ++k) {
      const long tt = t0 + (long)k * NW, t = tt < TG ? tt : TG - 1;
      l0[k] = lse[((long)0 * TG + t) * 8 + h]; l1[k] = lse[((long)1 * TG + t) * 8 + h]; l2[k] = lse[((long)2 * TG + t) * 8 + h];
      pa[k] = *(const u32x4*)(attp + ((long)0 * TG + t) * 512 + lane * 8);
      pb[k] = *(const u32x4*)(attp + ((long)1 * TG + t) * 512 + lane * 8);
      pc[k] = *(const u32x4*)(attp + ((long)2 * TG + t) * 512 + lane * 8);
      fa[k] = *(const u32x4*)(of + t * 512 + lane * 8);
      fb[k] = *(const u32x4*)(of + ((long)TG + t) * 512 + lane * 8);
      gg[k] = *(const u32x4*)(proj + t * NPROJ + 3072 + lane * 8);
    }
#pragma unroll
    for (int k = 0; k < 4; ++k) {
      const long t = t0 + (long)k * NW;
      if (t >= TG) break;
      {
        const float mx = fmaxf(l0[k], fmaxf(l1[k], l2[k]));
        float w0 = __expf(l0[k] - mx), w1 = __expf(l1[k] - mx), w2 = __expf(l2[k] - mx);
        const float inv = __builtin_amdgcn_rcpf(w0 + w1 + w2); w0 *= inv; w1 *= inv; w2 *= inv;
        const u32x4 a = pa[k], b = pb[k], c = pc[k];
        u32x4 o;
        o.x = pk2(w0 * bflo(a.x) + w1 * bflo(b.x) + w2 * bflo(c.x), w0 * bfhi(a.x) + w1 * bfhi(b.x) + w2 * bfhi(c.x));
        o.y = pk2(w0 * bflo(a.y) + w1 * bflo(b.y) + w2 * bflo(c.y), w0 * bfhi(a.y) + w1 * bfhi(b.y) + w2 * bfhi(c.y));
        o.z = pk2(w0 * bflo(a.z) + w1 * bflo(b.z) + w2 * bflo(c.z), w0 * bfhi(a.z) + w1 * bfhi(b.z) + w2 * bfhi(c.z));
        o.w = pk2(w0 * bflo(a.w) + w1 * bflo(b.w) + w2 * bflo(c.w), w0 * bfhi(a.w) + w1 * bfhi(b.w) + w2 * bfhi(c.w));
        *(u32x4*)(mix + t * 1024 + lane * 8) = o;
      }
      {
        const u32x4 a = fa[k], b = fb[k], g4 = gg[k];
        float o[8] = {bflo(a.x) + bflo(b.x), bfhi(a.x) + bfhi(b.x), bflo(a.y) + bflo(b.y), bfhi(a.y) + bfhi(b.y),
                      bflo(a.z) + bflo(b.z), bfhi(a.z) + bfhi(b.z), bflo(a.w) + bflo(b.w), bfhi(a.w) + bfhi(b.w)};
        float ss = 0.f;
#pragma unroll
        for (int i = 0; i < 8; ++i) ss += o[i] * o[i];
        ss = sum16(ss);
        const float rs = __builtin_amdgcn_rsqf(ss * (1.f / 128.f) + 1e-6f);
        const float gv[8] = {bflo(g4.x), bfhi(g4.x), bflo(g4.y), bfhi(g4.y), bflo(g4.z), bfhi(g4.z), bflo(g4.w), bfhi(g4.w)};
        const float gn[8] = {gn0.x, gn0.y, gn0.z, gn0.w, gn1.x, gn1.y, gn1.z, gn1.w};
        float y[8];
#pragma unroll
        for (int i = 0; i < 8; ++i) y[i] = o[i] * rs * gn[i] * siluf_(gv[i]);
        u32x4 ov = {pk2(y[0], y[1]), pk2(y[2], y[3]), pk2(y[4], y[5]), pk2(y[6], y[7])};
        *(u32x4*)(mix + t * 1024 + 512 + lane * 8) = ov;
      }
    }
  }
}

namespace pg8 {
#define PG8_LAS LAS
constexpr int BM = 256, BK = 64, HALF = 128, HTB = HALF * BK * 2;
DI int lds_byte(int r, int c) { const int st = (r >> 4) * 2 + (c >> 5), rr = r & 15, cc = c & 31, ob = rr * 64 + cc * 2; return st * 1024 + (ob ^ (((ob >> 9) & 1) << 5)); }
DI void stage_rc(int b, int& R, int& C) { const int st = b / 1024, sb = b % 1024, swz = sb ^ (((sb >> 9) & 1) << 5); R = (st >> 1) * 16 + swz / 64; C = (st & 1) * 32 + (swz % 64) / 2; }
DI int perm32(int rho) { const int n = rho >> 4, i = rho & 15; return 8 * (i >> 2) + 4 * n + (i & 3); }
struct Unit { int pm, pn; };
struct Gemm8 { const u16* A; const u16* Bt; int K; };
struct TileOrder {
  int nM, nN, ntiles, G, bperm;
  DI bool next(int i, Unit& u) const {
    const int T = i * G + bperm; if (T >= ntiles) return false;
    const int sg = T / (8 * nN), fm = sg * 8, gsz = (nM - fm) < 8 ? (nM - fm) : 8, idx = T - sg * 8 * nN;
    u.pm = fm + (idx % gsz); u.pn = idx / gsz; return true;
  }
  DI void a_ready(const Unit&) const {}
  DI void done(const Unit&) const {}
};
struct EpiProj {
  static constexpr bool PERM = true, AFTER_DRAIN = false;
  u16* proj;
  DI void operator()(const f32x4 (&acc)[2][2][4][2], const Unit& u, int wr, int wc, int fr, int fq) const {
    const int row0 = u.pm * BM + wr * 64 + fr, col0 = u.pn * BM + wc * 32 + 8 * fq;
#pragma unroll
    for (int ai = 0; ai < 2; ++ai)
#pragma unroll
      for (int m = 0; m < 4; ++m) {
        u16* rowp = proj + (size_t)(row0 + ai * HALF + m * 16) * NPROJ + col0;
#pragma unroll
        for (int bj = 0; bj < 2; ++bj) {
          const f32x4 a0 = acc[ai][bj][m][0], a1 = acc[ai][bj][m][1];
          u32x4 o = {pk2(a0.x, a0.y), pk2(a0.z, a0.w), pk2(a1.x, a1.y), pk2(a1.z, a1.w)};
          *(u32x4*)(rowp + bj * HALF) = o;
        }
      }
  }
};
struct EpiH {
  static constexpr bool PERM = true, AFTER_DRAIN = false;
  const float* xg; float* outg; u16* hb; float* rowsq;
  DI void operator()(const f32x4 (&acc)[2][2][4][2], const Unit& u, int wr, int wc, int fr, int fq) const {
    const int row0 = u.pm * BM + wr * 64 + fr, col0 = u.pn * BM + wc * 32 + 8 * fq;
#pragma unroll
    for (int ai = 0; ai < 2; ++ai) {
      f32x4 xv[4][2][2];
#pragma unroll
      for (int m = 0; m < 4; ++m)
#pragma unroll
        for (int bj = 0; bj < 2; ++bj)
#pragma unroll
          for (int n = 0; n < 2; ++n) xv[m][bj][n] = *(const f32x4*)(xg + (size_t)(row0 + ai * HALF + m * 16) * 1024 + col0 + bj * HALF + n * 4);
#pragma unroll
      for (int m = 0; m < 4; ++m) {
        const size_t row = (size_t)(row0 + ai * HALF + m * 16);
        float s = 0.f;
#pragma unroll
        for (int bj = 0; bj < 2; ++bj) {
          const f32x4 h0 = xv[m][bj][0] + acc[ai][bj][m][0], h1 = xv[m][bj][1] + acc[ai][bj][m][1];
          u32x4 o = {pk2(h0.x, h0.y), pk2(h0.z, h0.w), pk2(h1.x, h1.y), pk2(h1.z, h1.w)};
          *(u32x4*)(hb + row * 1024 + col0 + bj * HALF) = o;
          s += h0.x * h0.x + h0.y * h0.y + h0.z * h0.z + h0.w * h0.w + h1.x * h1.x + h1.y * h1.y + h1.z * h1.z + h1.w * h1.w;
        }
        s += __shfl_xor(s, 16); s += __shfl_xor(s, 32);
        if (fq == 0) rowsq[row * 16 + u.pn * 4 + wc] = s;
      }
    }
  }
};
struct EpiOut {
  static constexpr bool PERM = true, AFTER_DRAIN = false;
  float* outg; const u16* hb;
  DI void operator()(const f32x4 (&acc)[2][2][4][2], const Unit& u, int wr, int wc, int fr, int fq) const {
    const int row0 = u.pm * BM + wr * 64 + fr, col0 = u.pn * BM + wc * 32 + 8 * fq;
#pragma unroll
    for (int ai = 0; ai < 2; ++ai) {
      u32x4 hv[4][2];
#pragma unroll
      for (int m = 0; m < 4; ++m)
#pragma unroll
        for (int bj = 0; bj < 2; ++bj) hv[m][bj] = *(const u32x4*)(hb + (size_t)(row0 + ai * HALF + m * 16) * 1024 + col0 + bj * HALF);
#pragma unroll
      for (int m = 0; m < 4; ++m) {
        float* rowp = outg + (size_t)(row0 + ai * HALF + m * 16) * 1024 + col0;
#pragma unroll
        for (int bj = 0; bj < 2; ++bj) {
          const u32x4 v = hv[m][bj];
          f32x4 h0 = {bflo(v.x), bfhi(v.x), bflo(v.y), bfhi(v.y)}, h1 = {bflo(v.z), bfhi(v.z), bflo(v.w), bfhi(v.w)};
          h0 = h0 + acc[ai][bj][m][0]; h1 = h1 + acc[ai][bj][m][1];
          *(f32x4*)(rowp + bj * HALF) = h0; *(f32x4*)(rowp + bj * HALF + 4) = h1;
        }
      }
    }
  }
};
struct OneUnit {
  Unit u;
  DI bool next(int i, Unit& o) const { if (i != 0) return false; o = u; return true; }
  DI void a_ready(const Unit&) const {}
  DI void done(const Unit&) const {}
};
struct EpiGlu {
  static constexpr bool PERM = true, AFTER_DRAIN = true;
  const float* cw; const float* cb; const float* rowsq; u16* act; int pm, pn, L;
  DI void operator()(const f32x4 (&)[2][2][4][2], const Unit&, int, int, int, int) const {}
  DI void fused(const f32x4 (&acc)[2][2][4][2], const Unit&, int wr, int wc, int fr, int fq, PG8_LAS unsigned char* lds, int wid, int lane) const {
    const int rowbase = pm * 254 - 1;
#pragma unroll
    for (int ai = 0; ai < 2; ++ai) {
      f32x4 rq[4][4];
#pragma unroll
      for (int m = 0; m < 4; ++m) {
        const int rl = ai * HALF + wr * 64 + m * 16 + fr;
        int ar = rowbase + rl; ar = ar < 0 ? 0 : (ar > TG - 1 ? TG - 1 : ar);
        const f32x4* rp = (const f32x4*)(rowsq + (long)ar * 16);
#pragma unroll
        for (int q = 0; q < 4; ++q) rq[m][q] = rp[q];
      }
#pragma unroll
      for (int m = 0; m < 4; ++m) {
        const int rl = ai * HALF + wr * 64 + m * 16 + fr;
        const f32x4 q0 = rq[m][0], q1 = rq[m][1], q2 = rq[m][2], q3 = rq[m][3];
        const float ssq = (q0.x + q0.y + q0.z + q0.w) + (q1.x + q1.y + q1.z + q1.w) + (q2.x + q2.y + q2.z + q2.w) + (q3.x + q3.y + q3.z + q3.w);
        const float rs2 = __builtin_amdgcn_rsqf(ssq * (1.f / 1024.f) + 1e-6f);
#pragma unroll
        for (int bj = 0; bj < 2; ++bj)
#pragma unroll
          for (int n = 0; n < 2; ++n) {
            const int col = bj * HALF + wc * 32 + 8 * fq + 4 * n;
            const f32x4 a = acc[ai][bj][m][n];
            u32x2 o = {pk2(a.x * rs2, a.y * rs2), pk2(a.z * rs2, a.w * rs2)};
            *(PG8_LAS u32x2*)(lds + rl * 520 + col * 2) = o;
          }
      }
    }
    __syncthreads();
    {
      const int hp = lane, rg = wid;
      const int hid = pn * 128 + 2 * hp;
      float cwg[3][2], cwu[3][2], cbg[2], cbu[2];
#pragma unroll
      for (int j = 0; j < 3; ++j) {
        cwg[j][0] = cw[j * 5632 + hid]; cwg[j][1] = cw[j * 5632 + hid + 1];
        cwu[j][0] = cw[j * 5632 + 2816 + hid]; cwu[j][1] = cw[j * 5632 + 2816 + hid + 1];
      }
      cbg[0] = cb[hid]; cbg[1] = cb[hid + 1]; cbu[0] = cb[2816 + hid]; cbu[1] = cb[2816 + hid + 1];
      unsigned gk[34], uk[34];
#pragma unroll
      for (int k = 0; k < 34; ++k) {
        int r = rg * 32 - 1 + k; r = r < 0 ? 0 : (r > 255 ? 255 : r);
        gk[k] = *(const PG8_LAS unsigned*)(lds + r * 520 + hp * 4); uk[k] = *(const PG8_LAS unsigned*)(lds + r * 520 + 256 + hp * 4);
      }
#pragma unroll
      for (int kk = 0; kk < 32; ++kk) {
        const int i = rg * 32 + kk;
        const int lt = rowbase + i;
        if (i >= 1 && i <= 254 && lt < TG) {
          const unsigned gp = gk[kk], gc = gk[kk + 1], gn = gk[kk + 2], up = uk[kk], uc = uk[kk + 1], un = uk[kk + 2];
          const int pos = lt & (L - 1);
          float gp0 = bflo(gp), gp1 = bfhi(gp), up0 = bflo(up), up1 = bfhi(up), gn0 = bflo(gn), gn1 = bfhi(gn), un0 = bflo(un), un1 = bfhi(un);
          if (pos == 0) { gp0 = 0.f; gp1 = 0.f; up0 = 0.f; up1 = 0.f; }
          if (pos == L - 1) { gn0 = 0.f; gn1 = 0.f; un0 = 0.f; un1 = 0.f; }
          const float G0 = cwg[0][0] * gp0 + cwg[1][0] * bflo(gc) + cwg[2][0] * gn0 + cbg[0];
          const float G1 = cwg[0][1] * gp1 + cwg[1][1] * bfhi(gc) + cwg[2][1] * gn1 + cbg[1];
          const float U0 = cwu[0][0] * up0 + cwu[1][0] * bflo(uc) + cwu[2][0] * un0 + cbu[0];
          const float U1 = cwu[0][1] * up1 + cwu[1][1] * bfhi(uc) + cwu[2][1] * un1 + cbu[1];
          *(unsigned*)(act + (long)lt * 2816 + hid) = pk2(siluf_(G0) * U0, siluf_(G1) * U1);
        }
      }
    }
    __syncthreads();
  }
};
template <class Epi, class Sched>
__device__ __forceinline__ void gemm8_phase(PG8_LAS unsigned char* lds, const Gemm8 g, const Sched& S, const Epi& E) {
    constexpr bool STAMP = false; unsigned long long* stamps = nullptr;
    const int tid = opaque_tid(), wid = __builtin_amdgcn_readfirstlane(tid >> 6), lane = tid & 63, wr = wid >> 2, wc = wid & 3, fr = lane & 15, fq = lane >> 4;
    const int K = g.K, nt = K / BK;
    int ts_lo = 0, ts_hi = 0, nts = 0; const unsigned long long rt_entry = 0ull;
#define PG8_STAMP() do { if (STAMP && wid == 0 && nts < 64) { const unsigned long long _c = 0ull; \
        ts_lo = (lane == nts) ? (int)(unsigned)_c : ts_lo; ts_hi = (lane == nts) ? (int)(unsigned)(_c >> 32) : ts_hi; ++nts; } } while (0)
    PG8_STAMP();
    unsigned voffA[2], voffB[2];
#pragma unroll
    for (int i = 0; i < 2; ++i) { int R, C; stage_rc(tid * 16 + i * 8192, R, C); const int Rb = Epi::PERM ? ((R & ~31) + perm32(R & 31)) : R;
        voffA[i] = (unsigned)(R * K + C) * 2u; voffB[i] = (unsigned)(Rb * K + C) * 2u; }
    const size_t kstep = (size_t)(BK * 2);
    const size_t hstep = (size_t)HALF * K * 2;
    const size_t tstep = 2 * hstep;
    const unsigned ldsw = (unsigned)wid * 1024u;
    const int aoff = lds_byte(wr * 64 + fr, fq * 8), boff = lds_byte(wc * 32 + fr, fq * 8);
#define PG8_SA(b, h) (((b) * 2 + (h)) * HTB)
#define PG8_SB(b, h) ((4 + (b) * 2 + (h)) * HTB)
#define PG8_STAGE(bufoff, gbase, voff) do { _Pragma("unroll") for (int _i = 0; _i < 2; ++_i) \
        __builtin_amdgcn_global_load_lds((const unsigned*)((const char*)(gbase) + (voff)[_i]), (PG8_LAS unsigned*)(lds + (bufoff) + ldsw + _i * 8192), 16, 0, 0); } while (0)
#define PG8_LDA(dst, b, h) do { _Pragma("unroll") for (int m = 0; m < 4; ++m) _Pragma("unroll") for (int k = 0; k < 2; ++k) dst[m][k] = *(const PG8_LAS bf16x8*)(lds + PG8_SA(b, h) + aoff + m * 2048 + k * 1024); } while (0)
#define PG8_LDB(dst, b, h) do { _Pragma("unroll") for (int n = 0; n < 2; ++n) _Pragma("unroll") for (int k = 0; k < 2; ++k) dst[n][k] = *(const PG8_LAS bf16x8*)(lds + PG8_SB(b, h) + boff + n * 2048 + k * 1024); } while (0)
#define PG8_MMA(ai, bj, At, Bt) do { __builtin_amdgcn_s_setprio(1); _Pragma("unroll") for (int m = 0; m < 4; ++m) _Pragma("unroll") for (int n = 0; n < 2; ++n) _Pragma("unroll") for (int k = 0; k < 2; ++k) \
        acc[ai][bj][m][n] = __builtin_amdgcn_mfma_f32_16x16x32_bf16(Bt[n][k], At[m][k], acc[ai][bj][m][n], 0, 0, 0); __builtin_amdgcn_s_setprio(0); } while (0)
#define PG8_WAIT_V(n) asm volatile("s_waitcnt vmcnt(" #n ")" ::: "memory")
#define PG8_WAIT_L(n) asm volatile("s_waitcnt lgkmcnt(" #n ")" ::: "memory")
#define PG8_BAR __builtin_amdgcn_s_barrier()
#define PG8_SCHED __builtin_amdgcn_sched_barrier(0)
    Unit cur, nxt; int ui = 0;
    if (!S.next(0, cur)) return;
    f32x4 acc[2][2][4][2];
#pragma unroll
    for (int a = 0; a < 2; ++a)
#pragma unroll
        for (int b = 0; b < 2; ++b)
#pragma unroll
            for (int m = 0; m < 4; ++m)
#pragma unroll
                for (int n = 0; n < 2; ++n) acc[a][b][m][n] = (f32x4){0.f, 0.f, 0.f, 0.f};
    bf16x8 At[4][2], B0[2][2], B1[2][2];
    const char* cA = (const char*)g.A + (size_t)cur.pm * tstep; const char* cB = (const char*)g.Bt + (size_t)cur.pn * tstep;
    S.a_ready(cur);
    PG8_STAGE(PG8_SB(0, 0), cB, voffB); PG8_STAGE(PG8_SA(0, 0), cA, voffA); PG8_STAGE(PG8_SB(0, 1), cB + hstep, voffB); PG8_STAGE(PG8_SA(0, 1), cA + hstep, voffA);
    if (wr == 1) PG8_BAR;
    PG8_WAIT_V(4); PG8_BAR;
    PG8_STAGE(PG8_SB(1, 0), cB + kstep, voffB); PG8_STAGE(PG8_SA(1, 0), cA + kstep, voffA); PG8_STAGE(PG8_SB(1, 1), cB + hstep + kstep, voffB);
    PG8_WAIT_V(6); PG8_BAR;
    PG8_STAMP();
    for (;;) {
        const bool has_next = S.next(ui + 1, nxt);
        const char* nA = has_next ? (const char*)g.A + (size_t)nxt.pm * tstep : cA; const char* nB = has_next ? (const char*)g.Bt + (size_t)nxt.pn * tstep : cB;
        for (int t = 0; t < nt; t += 2) {
            const bool last = (t == nt - 2);
            const char* a1 = cA + (size_t)(t + 1) * kstep;
            const char* a2 = last ? nA : cA + (size_t)(t + 2) * kstep; const char* b2 = last ? nB : cB + (size_t)(t + 2) * kstep;
            const char* a3 = a2 + kstep; const char* b3 = b2 + kstep;
            if (last && has_next) S.a_ready(nxt);
            PG8_LDB(B0, 0, 0); PG8_SCHED; PG8_LDA(At, 0, 0); PG8_STAGE(PG8_SA(1, 1), a1 + hstep, voffA);
            PG8_WAIT_L(8); PG8_BAR; PG8_WAIT_L(0); PG8_MMA(0, 0, At, B0); PG8_BAR; PG8_SCHED;
            PG8_LDB(B1, 0, 1); PG8_STAGE(PG8_SB(0, 0), b2, voffB);
            PG8_BAR; PG8_WAIT_L(0); PG8_MMA(0, 1, At, B1); PG8_BAR;
            PG8_LDA(At, 0, 1); PG8_STAGE(PG8_SA(0, 0), a2, voffA);
            PG8_BAR; PG8_WAIT_L(0); PG8_MMA(1, 0, At, B0); PG8_BAR; PG8_SCHED;
            PG8_STAGE(PG8_SB(0, 1), b2 + hstep, voffB);
            PG8_WAIT_V(6); PG8_BAR; PG8_MMA(1, 1, At, B1); PG8_BAR;
            PG8_LDB(B0, 1, 0); PG8_SCHED; PG8_LDA(At, 1, 0); PG8_STAGE(PG8_SA(0, 1), a2 + hstep, voffA);
            PG8_WAIT_L(8); PG8_BAR; PG8_WAIT_L(0); PG8_MMA(0, 0, At, B0); PG8_BAR; PG8_SCHED;
            PG8_LDB(B1, 1, 1); PG8_STAGE(PG8_SB(1, 0), b3, voffB);
            PG8_BAR; PG8_WAIT_L(0); PG8_MMA(0, 1, At, B1); PG8_BAR;
            PG8_LDA(At, 1, 1); PG8_STAGE(PG8_SA(1, 0), a3, voffA);
            PG8_BAR; PG8_WAIT_L(0); PG8_MMA(1, 0, At, B0); PG8_BAR; PG8_SCHED;
            PG8_STAGE(PG8_SB(1, 1), b3 + hstep, voffB);
            PG8_WAIT_V(6); PG8_BAR; PG8_MMA(1, 1, At, B1); PG8_BAR;
        }
        PG8_STAMP();
        if constexpr (!Epi::AFTER_DRAIN) { E(acc, cur, wr, wc, fr, fq); S.done(cur); }
        PG8_STAMP();
        if (!has_next) break;
#pragma unroll
        for (int a = 0; a < 2; ++a)
#pragma unroll
            for (int b = 0; b < 2; ++b)
#pragma unroll
                for (int m = 0; m < 4; ++m)
#pragma unroll
                    for (int n = 0; n < 2; ++n) acc[a][b][m][n] = (f32x4){0.f, 0.f, 0.f, 0.f};
        cur = nxt; cA = nA; cB = nB; ++ui;
    }
    PG8_WAIT_V(0);
    if (wr == 0) PG8_BAR;
    PG8_BAR;
    if constexpr (Epi::AFTER_DRAIN) { E.fused(acc, cur, wr, wc, fr, fq, lds, wid, lane); S.done(cur); }
    PG8_STAMP();
    if (false) { stamps[lane] = lane < nts ? (((unsigned long long)(unsigned)ts_hi << 32) | (unsigned)ts_lo) : 0ull;
        if (lane == 62) stamps[62] = rt_entry; if (lane == 63) stamps[63] = 0ull; }
#undef PG8_STAMP
#undef PG8_SA
#undef PG8_SB
#undef PG8_STAGE
#undef PG8_LDA
#undef PG8_LDB
#undef PG8_MMA
#undef PG8_WAIT_V
#undef PG8_WAIT_L
#undef PG8_BAR
#undef PG8_SCHED
}
}

template <int MODE>
DI void gemm8_run(int grp, unsigned char* ws, const float* __restrict__ xg, float* __restrict__ outg, int bperm) {
  pg8::Gemm8 g; pg8::TileOrder S;
  const int G = gridDim.x;
  S.G = G; S.bperm = bperm;
  S.nM = TG / 256;
  if (MODE == 1) { g.A = (const u16*)(ws + WS_NBUF2); g.Bt = (const u16*)(ws + WS_WIN); g.K = 1024; S.nN = NPROJ / 256; }
  else if (MODE == 2) { g.A = (const u16*)(ws + WS_NBUF); g.Bt = (const u16*)(ws + WS_WOUT); g.K = 1024; S.nN = 4; }
  else { g.A = (const u16*)(ws + WS_ACT); g.Bt = (const u16*)(ws + WS_WDOWN); g.K = 2816; S.nN = 4; }
  S.ntiles = S.nM * S.nN;
  __syncthreads();
  if (MODE == 1) { pg8::EpiProj E{(u16*)(ws + WS_PROJ)}; pg8::gemm8_phase((LAS unsigned char*)0, g, S, E); }
  else if (MODE == 2) { pg8::EpiH E{xg, outg, (u16*)(ws + WS_HB), (float*)(ws + WS_ROWSQ)}; pg8::gemm8_phase((LAS unsigned char*)0, g, S, E); }
  else { pg8::EpiOut E{outg, (const u16*)(ws + WS_HB)}; pg8::gemm8_phase((LAS unsigned char*)0, g, S, E); }
  __syncthreads();
}


DI void gemm8_glu(const Params& p, int grp, unsigned char* ws, int bperm) {
  const int L = (grp == 0) ? 16384 : 2048;
  const int nM = (TG + 253) / 254, nN = 22, ntiles = nM * nN, G = gridDim.x;
  __syncthreads();
  for (int T = bperm; T < ntiles; T += G) {
    const int sg = T / (8 * nN), fm = sg * 8, gsz = (nM - fm) < 8 ? (nM - fm) : 8, idx = T - sg * 8 * nN;
    const int pm = fm + (idx % gsz), pn = idx / gsz;
    pg8::Gemm8 g; g.A = (const u16*)(ws + WS_HB) + (long)(pm * 254 - 1) * 1024; g.Bt = (const u16*)(ws + WS_WUP); g.K = 1024;
    pg8::OneUnit S; S.u.pm = 0; S.u.pn = pn;
    pg8::EpiGlu E{p.ffn_cw, p.ffn_cb, (const float*)(ws + WS_ROWSQ), (u16*)(ws + WS_ACT), pm, pn, L};
    pg8::gemm8_phase((LAS unsigned char*)0, g, S, E);
  }
}

#define XB_TMO      128
#define XB_XCNT(j)  (256  + 64 * (j))
#define XB_XSUB(j)  (1280 + 64 * (j))
#define XB_XGEN(j)  (2304 + 64 * (j))
#define XB_TOP      3328
#define XB_TOPGEN   3392
#define XCD_BAR_WORDS 3456
#define XB_SPIN_CAP (1u << 18)
DI unsigned xb_ld(unsigned* p)              { return __hip_atomic_load(p, __ATOMIC_RELAXED, __HIP_MEMORY_SCOPE_AGENT); }
DI unsigned xb_add(unsigned* p, unsigned v) { return __hip_atomic_fetch_add(p, v, __ATOMIC_RELAXED, __HIP_MEMORY_SCOPE_AGENT); }
DI unsigned xb_xcc_id() { return (unsigned)__builtin_amdgcn_s_getreg((3 << 11) | 20) & 0xFu; }
#define XB_SPIN(cond, bar) do { unsigned _sp = 0; while (cond) { __builtin_amdgcn_s_sleep(1); \
    if ((++_sp & 255u) == 0u) { if (xb_ld(&(bar)[XB_TMO])) break; if (_sp > XB_SPIN_CAP) { atomicAdd(&(bar)[XB_TMO], 1u); break; } } } } while (0)
struct XcdBarrier { unsigned* bar; unsigned x; volatile LAS unsigned* st; };
DI XcdBarrier xcd_barrier_post(unsigned* bar, volatile LAS unsigned* st) {
  XcdBarrier b; b.bar = bar; b.x = xb_xcc_id(); b.st = st;
  if (opaque_tid() == 0) (void)xb_add(&bar[XB_XCNT(b.x)], 1u);
  return b;
}
DI void xcd_barrier_complete(unsigned* bar, unsigned x, unsigned& nloc, unsigned& nx) {
  const unsigned G = gridDim.x * gridDim.y * gridDim.z;
  unsigned sum, cnt, mine, sp = 0u;
  for (;;) {
    sum = 0u; cnt = 0u; mine = 0u;
#pragma unroll
    for (unsigned j = 0; j < 16; ++j) { const unsigned c = xb_ld(&bar[XB_XCNT(j)]); sum += c; cnt += (c > 0u) ? 1u : 0u; mine = (j == x) ? c : mine; }
    if (sum == G) break;
    __builtin_amdgcn_s_sleep(1);
    if ((++sp & 255u) == 0u) { if (xb_ld(&bar[XB_TMO])) break; if (sp > XB_SPIN_CAP) { atomicAdd(&bar[XB_TMO], 1u); break; } }
  }
  nloc = mine > 0u ? mine : 1u; nx = cnt > 0u ? cnt : 1u;
}
DI void xcd_barrier(const XcdBarrier& b) {
  asm volatile("s_waitcnt vmcnt(0)" ::: "memory");
  __syncthreads();
  if (opaque_tid() == 0) {
    unsigned* bar = b.bar;
    __builtin_amdgcn_s_waitcnt(0);
    unsigned nloc = b.st[0], nx = b.st[1];
    if (nloc == 0u) { xcd_barrier_complete(bar, b.x, nloc, nx); b.st[0] = nloc; b.st[1] = nx; }
    const unsigned old = xb_add(&bar[XB_XSUB(b.x)], 1u);
    const unsigned gen = old / nloc;
    if (old + 1u == (gen + 1u) * nloc) {
      __builtin_amdgcn_fence(__ATOMIC_RELEASE, "agent");
      asm volatile("s_waitcnt vmcnt(0)" ::: "memory");
      const unsigned og = xb_add(&bar[XB_TOP], 1u);
      const unsigned tg = og / nx;
      if (og + 1u == (tg + 1u) * nx) xb_add(&bar[XB_TOPGEN], 1u);
      else XB_SPIN(xb_ld(&bar[XB_TOPGEN]) == tg, bar);
      __builtin_amdgcn_fence(__ATOMIC_ACQUIRE, "agent");
      xb_add(&bar[XB_XGEN(b.x)], 1u);
      asm volatile("s_waitcnt vmcnt(0)" ::: "memory");
    } else {
      XB_SPIN(xb_ld(&bar[XB_XGEN(b.x)]) == gen, bar);
      __builtin_amdgcn_fence(__ATOMIC_ACQUIRE, "agent");
      asm volatile("s_waitcnt vmcnt(0)" ::: "memory");
    }
  }
  __syncthreads();
}

extern __shared__ __attribute__((aligned(16))) unsigned char smem[];

__global__ void __launch_bounds__(512) mk_fwd(Params p) {
  cg::grid_group grid = cg::this_grid();
  unsigned char* ws = p.ws;
  volatile LAS unsigned* xst = (volatile LAS unsigned*)(unsigned long)(LDS_BYTES - 16);
  if (opaque_tid() == 0) { xst[0] = 0u; xst[1] = 0u; }
  __syncthreads();
  const XcdBarrier xb = xcd_barrier_post((unsigned*)(ws + WS_BAR), xst);
  if (opaque_tid() == 0) xst[2] = xb_add(&xb.bar[XCD_BAR_WORDS + 32 * xb.x], 1u);
  int bperm = blockIdx.x;
  {
    const long gtid = (long)blockIdx.x * 512 + opaque_tid(), nthr = (long)gridDim.x * 512;
    conv_weight(p.w_in, 3600, 1024, NPROJ, (u16*)(ws + WS_WIN), 0, nullptr, gtid, nthr);
    conv_weight(p.w_out, 1024, 1024, 1024, (u16*)(ws + WS_WOUT), 0, nullptr, gtid, nthr);
    conv_weight(p.w_up, 5632, 1024, 5632, (u16*)(ws + WS_WUP), 1, p.norm2, gtid, nthr);
    conv_weight(p.w_down, 1024, 2816, 1024, (u16*)(ws + WS_WDOWN), 0, nullptr, gtid, nthr);
  }
  const bool beside = (gridDim.x >= 64);
#pragma unroll 1
  for (int grp = 0; grp < 3; ++grp) {
    const int gsc = __builtin_amdgcn_readfirstlane(grp);
    const float* xg = p.xgrp[gsc] + (long)(gsc >> 1) * TG * 1024;
    float* outg = p.out + (long)gsc * TG * 1024;
    if (!(grp == 1 && beside)) { REP(0) { phase_norm<0>(p, xg, ws, smem); __syncthreads(); } }
    if (grp == 0) {
      grid.sync();
      unsigned off = 0u;
#pragma unroll
      for (unsigned j = 0; j < 16; ++j) { const unsigned c = xb_ld(&xb.bar[XB_XCNT(j)]); off += (j < xb.x) ? c : 0u; }
      bperm = __builtin_amdgcn_readfirstlane((int)(off + xst[2]));
    } else GSYNC();
    REP(1) gemm8_run<1>(grp, ws, xg, outg, bperm);
    GSYNC();
    phase_prep(p, grp, ws);
    GSYNC();
    {
      REP(4) for (int it = blockIdx.x; it < 2048; it += gridDim.x) dnlocal_item(ws, smem, it);
    }
    GSYNC();
    {
      const int nchains = (grp == 0) ? 16 : 128;
      REP(3) for (int c = blockIdx.x; c < nchains; c += gridDim.x) scan_chain(grp, ws, smem, c);
      unsigned* qctr = xb.bar + XCD_BAR_WORDS + 32 * 16 + 32 * grp;
      for (;;) {
        if (opaque_tid() == 0) xst[3] = xb_add(qctr, 1u);
        __syncthreads();
        const int it = __builtin_amdgcn_readfirstlane((int)xst[3]);
        if (it >= 6144) break;
        attn_item(grp, ws, smem, it);
      }
      if (grp == 0 && beside && blockIdx.x >= 16) { __syncthreads(); phase_norm<16>(p, p.xs, ws, smem); __syncthreads(); }
    }
    GSYNC();
    REP(5) phase_merge(p, ws);
    GSYNC();
    REP(8) gemm8_run<2>(grp, ws, xg, outg, bperm);
    GSYNC();
    REP(9) gemm8_glu(p, grp, ws, bperm);
    GSYNC();
    REP(11) gemm8_run<4>(grp, ws, xg, outg, bperm);
  }
}

extern "C" void kernel_launch(void* const* d_in, const int* in_sizes, int n_in, void* d_out, int out_size,
                              void* d_ws, size_t ws_size, hipStream_t stream) {
  static int grid_blocks = 0;
  if (!grid_blocks) {
    int dev = 0, cus = 0, per_cu = 0;
    (void)hipGetDevice(&dev);
    (void)hipDeviceGetAttribute(&cus, hipDeviceAttributeMultiprocessorCount, dev);
    (void)hipFuncSetAttribute((const void*)mk_fwd, hipFuncAttributeMaxDynamicSharedMemorySize, LDS_BYTES);
    (void)hipOccupancyMaxActiveBlocksPerMultiprocessor(&per_cu, (const void*)mk_fwd, 512, LDS_BYTES);
    if (per_cu < 1) per_cu = 1;
    grid_blocks = cus * per_cu;
    if (ws_size < 947 * MiB) fprintf(stderr, "workspace too small: %zu\n", ws_size);
  }
  Params p{};
  p.xp = (const float*)d_in[0]; p.xs = (const float*)d_in[1]; p.norm1 = (const float*)d_in[2]; p.w_in = (const float*)d_in[3];
  p.qn = (const float*)d_in[4]; p.kn = (const float*)d_in[5]; p.dn_conv_w = (const float*)d_in[6]; p.a_log = (const float*)d_in[7];
  p.dt_bias = (const float*)d_in[8]; p.out_norm = (const float*)d_in[9]; p.w_out = (const float*)d_in[10]; p.norm2 = (const float*)d_in[11];
  p.w_up = (const float*)d_in[12]; p.ffn_cw = (const float*)d_in[13]; p.ffn_cb = (const float*)d_in[14]; p.w_down = (const float*)d_in[15];
  p.out = (float*)d_out; p.ws = (unsigned char*)d_ws;
  p.xgrp[0] = p.xp; p.xgrp[1] = p.xs; p.xgrp[2] = p.xs;
  (void)hipMemsetAsync((unsigned char*)d_ws + WS_BAR, 0, 16384, stream);
  void* args[] = {&p};
  hipError_t e = hipLaunchCooperativeKernel((void*)mk_fwd, dim3(grid_blocks), dim3(512), args, LDS_BYTES, stream);
  if (e != hipSuccess) fprintf(stderr, "cooperative launch failed: %s (grid %d)\n", hipGetErrorString(e), grid_blocks);
}
```

```cpp
#include <hip/hip_runtime.h>
#include <hip/hip_cooperative_groups.h>
#include <cstdio>
namespace cg = cooperative_groups;

typedef unsigned short u16;
typedef __attribute__((ext_vector_type(8))) short bf16x8;
typedef __attribute__((ext_vector_type(4))) float f32x4;
typedef __attribute__((ext_vector_type(4))) unsigned u32x4;
typedef __attribute__((ext_vector_type(2))) unsigned u32x2;
typedef short s16x4 __attribute__((ext_vector_type(4)));
typedef __bf16 bf2_t __attribute__((ext_vector_type(2)));
typedef float f2_t __attribute__((ext_vector_type(2)));
#define DI __device__ __forceinline__

constexpr int TG = 32768;
constexpr int NPROJ = 3584;
constexpr size_t MiB = 1u << 20;
constexpr size_t WS_WIN = 0, WS_WOUT = 7 * MiB, WS_WUP = 9 * MiB, WS_WDOWN = 20 * MiB;
constexpr size_t WS_GATES = 27 * MiB, WS_LSE = 29 * MiB, WS_ROWSQ = 32 * MiB, WS_EGL = 34 * MiB;
constexpr size_t WS_BAR = 34 * MiB + 512 * 1024;
constexpr size_t WS_NBUF = 35 * MiB;
constexpr size_t WS_PROJ = 99 * MiB;
constexpr size_t WS_HB = WS_PROJ, WS_ACT = WS_PROJ + 64 * MiB;
constexpr size_t WS_DNP = 339 * MiB, WS_ATTP = 435 * MiB, WS_DNOP = 531 * MiB, WS_OF = 819 * MiB;
constexpr size_t WS_NBUF2 = 883 * MiB;
constexpr int DNOP_BYTES = 73728;
constexpr int OP_WN = 0, OP_QD = 16384, OP_QK = 32768, OP_KDT = 40960, OP_UT = 57344;
constexpr int LDS_BYTES = 163840;
#ifndef PROBE_MASK
#define PROBE_MASK 0
#endif
#define GSYNC() do { xcd_barrier(xb); if ((PROBE_MASK >> 7) & 1) xcd_barrier(xb); } while (0)
#define REP(bit) for (int rep_ = 0; rep_ < (((PROBE_MASK) >> (bit)) & 1) + 1; ++rep_)

struct Params {
  const float *xp, *xs, *norm1, *w_in, *qn, *kn, *dn_conv_w, *a_log, *dt_bias, *out_norm, *w_out, *norm2, *w_up, *ffn_cw, *ffn_cb, *w_down;
  float* out; unsigned char* ws;
  unsigned char* pbase[2];
  const float* xgrp[3];
};

DI float bf2f(unsigned v) { return __uint_as_float(v << 16); }
DI float bflo(unsigned v) { return __uint_as_float(v << 16); }
DI float bfhi(unsigned v) { return __uint_as_float(v & 0xffff0000u); }
DI unsigned pk2(float lo, float hi) { f2_t v = {lo, hi}; bf2_t r = __builtin_convertvector(v, bf2_t); return __builtin_bit_cast(unsigned, r); }
DI u16 f2bf(float x) { return (u16)(pk2(x, 0.f) & 0xffffu); }
DI int opaque_tid() {
  const int wv = __builtin_amdgcn_readfirstlane((int)threadIdx.x >> 6);
  int ln;
  asm volatile("v_mbcnt_lo_u32_b32 %0, -1, 0\n\tv_mbcnt_hi_u32_b32 %0, -1, %0" : "=v"(ln));
  return (wv << 6) | ln; }
DI float dpp_f(float v, const int ctrl_sel) {
  const int x = __float_as_int(v);
  int r;
  if (ctrl_sel == 0) r = __builtin_amdgcn_update_dpp(x, x, 0xB1, 0xF, 0xF, true);
  else if (ctrl_sel == 1) r = __builtin_amdgcn_update_dpp(x, x, 0x4E, 0xF, 0xF, true);
  else if (ctrl_sel == 2) r = __builtin_amdgcn_update_dpp(x, x, 0x141, 0xF, 0xF, true);
  else r = __builtin_amdgcn_update_dpp(x, x, 0x140, 0xF, 0xF, true);
  return __int_as_float(r);
}
DI float sum16(float v) {
  v += dpp_f(v, 0); v += dpp_f(v, 1); v += dpp_f(v, 2); v += dpp_f(v, 3);
  return v;
}
DI float wave_sum(float v) {
  v = sum16(v);
  v += __shfl_xor(v, 16); v += __shfl_xor(v, 32);
  return v;
}
DI f32x4 mfma16(bf16x8 a, bf16x8 b, f32x4 c) { return __builtin_amdgcn_mfma_f32_16x16x32_bf16(a, b, c, 0, 0, 0); }
#define LAS __attribute__((address_space(3)))
DI void glds16(const void* g, unsigned ldsoff) {
  __builtin_amdgcn_global_load_lds((const __attribute__((address_space(1))) void*)g, (LAS void*)(unsigned long)ldsoff, 16, 0, 0);
}
DI int kperm(int k) { return (k & ~31) | (((k >> 2) & 3) << 3) | (((k >> 4) & 1) << 2) | (k & 3); }
DI float sigmoidf_(float x) { return __builtin_amdgcn_rcpf(1.f + __expf(-x)); }
DI float siluf_(float x) { return x * __builtin_amdgcn_rcpf(1.f + __expf(-x)); }

DI void conv_weight(const float* __restrict__ W, int Nsrc, int K, int Nout, u16* __restrict__ WT, int mode, const float* __restrict__ scale,
                    long gtid, long nthr) {
  const int kgn = K >> 3;
  for (long idx = gtid; idx < (long)Nout * kgn; idx += nthr) {
    const int n = (int)(idx % Nout), kg = (int)(idx / Nout);
    int src = n;
    if (mode == 1) { const int pn = n >> 8, ct = n & 255; src = (ct < 128) ? (pn * 128 + ct) : (2816 + pn * 128 + ct - 128); }
    float v[8];
#pragma unroll
    for (int j = 0; j < 8; ++j) { const int k = kg * 8 + j; const float s = scale ? scale[k] : 1.f; v[j] = W[(long)k * Nsrc + src] * s; }
    u32x4 o = {pk2(v[0], v[1]), pk2(v[2], v[3]), pk2(v[4], v[5]), pk2(v[6], v[7])};
    *(u32x4*)(WT + (long)n * K + kg * 8) = o;
  }
}

template <int B0>
DI void phase_norm(const Params& p, const float* __restrict__ xg, unsigned char* ws, unsigned char* smem) {
  const int b0 = B0, nb = (int)gridDim.x - B0;
  const int tidx = opaque_tid();
  f32x4* gw4 = (f32x4*)smem;
  float* gwf = (float*)smem;
  for (int e = tidx; e < 1024 * 16; e += 512) {
    const int k = e >> 4, jg = e & 15;
    const int ln = (k >> 2) & 63, j = k >> 8, ee = k & 3, q = jg >> 2, cmp = jg & 3;
    gwf[((((j * 4 + ee) * 4 + q) * 64 + ln) << 2) + cmp] = p.w_in[(long)k * 3600 + 3584 + jg];
  }
  __syncthreads();
  const int wave = tidx >> 6, lane = tidx & 63;
  u16* nbuf = (u16*)(ws + WS_NBUF2); float* gates = (float*)(ws + WS_GATES);
  const int bl = (int)blockIdx.x - b0;
  f32x4 vn[4];
  {
    const f32x4* xr = (const f32x4*)(xg + (long)(bl * 8 + wave) * 1024);
#pragma unroll
    for (int j = 0; j < 4; ++j) vn[j] = xr[lane + 64 * j];
  }
  for (int row = bl * 8 + wave; row < TG; row += nb * 8) {
    f32x4 v[4]; float ss = 0.f;
#pragma unroll
    for (int j = 0; j < 4; ++j) { v[j] = vn[j]; ss += v[j].x * v[j].x + v[j].y * v[j].y + v[j].z * v[j].z + v[j].w * v[j].w; }
    {
      const int rn = row + nb * 8;
      const f32x4* xr = (const f32x4*)(xg + (long)(rn < TG ? rn : row) * 1024);
#pragma unroll
      for (int j = 0; j < 4; ++j) vn[j] = xr[lane + 64 * j];
    }
    ss = wave_sum(ss);
    const float rs = rsqrtf(ss * (1.f / 1024.f) + 1e-6f);
    float ga[16];
#pragma unroll
    for (int i = 0; i < 16; ++i) ga[i] = 0.f;
#pragma unroll
    for (int j = 0; j < 4; ++j) {
      const f32x4 nw = ((const f32x4*)p.norm1)[lane + 64 * j];
      v[j].x *= rs * nw.x; v[j].y *= rs * nw.y; v[j].z *= rs * nw.z; v[j].w *= rs * nw.w;
      u32x2 o = {pk2(v[j].x, v[j].y), pk2(v[j].z, v[j].w)};
      *(u32x2*)(nbuf + (long)row * 1024 + 4 * (lane + 64 * j)) = o;
#pragma unroll
      for (int e = 0; e < 4; ++e) {
        const float xv = v[j][e];
#pragma unroll
        for (int q = 0; q < 4; ++q) {
          const f32x4 w4 = gw4[((j * 4 + e) * 4 + q) * 64 + lane];
          ga[4 * q + 0] += xv * w4.x; ga[4 * q + 1] += xv * w4.y; ga[4 * q + 2] += xv * w4.z; ga[4 * q + 3] += xv * w4.w;
        }
        __builtin_amdgcn_sched_barrier(0);
      }
    }
    float r = 0.f;
#pragma unroll
    for (int i = 0; i < 16; ++i) { const float s = wave_sum(ga[i]); r = (lane == i) ? s : r; }
    if (lane < 16) {
      float o;
      if (lane < 8) o = sigmoidf_(r);
      else { const int jj = lane - 8; const float z = r + p.dt_bias[jj]; const float ez = __expf(z); const float sp = (z > 20.f) ? z : ((ez < 0.02f) ? ez * (1.f - ez * (0.5f - ez * (1.f / 3.f))) : __logf(1.f + ez)); o = -__expf(p.a_log[jj]) * sp; }
      gates[(long)row * 16 + lane] = o;
    }
  }
}

DI void phase_prep(const Params& p, int grp, unsigned char* ws, u16* proj) {
  const int tidx = opaque_tid();
  const int L = (grp == 0) ? 16384 : 2048;
  const int lane = tidx & 63;
  const int gw = blockIdx.x * 8 + (tidx >> 6), NW = gridDim.x * 8;
  {
    const int i = lane & 15;
    const float f0 = exp2f(-(float)(2 * i) * (13.287712379549449f / 32.f)), f1 = exp2f(-(float)(2 * i + 1) * (13.287712379549449f / 32.f));
    for (int tb = gw; tb < TG; tb += 4 * NW) {
      unsigned elo[4][4], ehi[4][4];
#pragma unroll
      for (int kt = 0; kt < 4; ++kt)
#pragma unroll
        for (int k = 0; k < 4; ++k) {
          const int tt = tb + kt * NW, t = tt < TG ? tt : TG - 1, hs = (lane >> 4) + 4 * k;
          const u16* ptr = proj + (long)t * NPROJ + hs * 64;
          elo[kt][k] = *(const unsigned*)(ptr + 2 * i); ehi[kt][k] = *(const unsigned*)(ptr + 32 + 2 * i);
        }
#pragma unroll
      for (int kt = 0; kt < 4; ++kt) {
        const int t = tb + kt * NW;
        if (t >= TG) break;
        float s0, c0, s1, c1;
        {
          const float pos = (float)(t & (L - 1));
          __sincosf(pos * f0, &s0, &c0); __sincosf(pos * f1, &s1, &c1);
        }
#pragma unroll
        for (int k = 0; k < 4; ++k) {
          const int hs = (lane >> 4) + 4 * k;
          u16* ptr = proj + (long)t * NPROJ + hs * 64;
          float x1a = bflo(elo[kt][k]), x1b = bfhi(elo[kt][k]), x2a = bflo(ehi[kt][k]), x2b = bfhi(ehi[kt][k]);
          float ss = x1a * x1a + x1b * x1b + x2a * x2a + x2b * x2b;
          ss = sum16(ss);
          const float rs = __builtin_amdgcn_rsqf(ss * (1.f / 64.f) + 1e-6f);
          const float* gn = (hs < 8) ? p.qn : p.kn;
          const float sc = (hs < 8) ? 0.125f : 1.f;
          x1a *= rs * gn[2 * i]; x1b *= rs * gn[2 * i + 1]; x2a *= rs * gn[32 + 2 * i]; x2b *= rs * gn[33 + 2 * i];
          const float o1a = (x1a * c0 - x2a * s0) * sc, o2a = (x2a * c0 + x1a * s0) * sc;
          const float o1b = (x1b * c1 - x2b * s1) * sc, o2b = (x2b * c1 + x1b * s1) * sc;
          *(unsigned*)(ptr + 2 * i) = pk2(o1a, o1b); *(unsigned*)(ptr + 32 + 2 * i) = pk2(o2a, o2b);
        }
      }
    }
  }
  {
    u16* dnp = (u16*)(ws + WS_DNP);
    const int q = lane >> 4, cb = lane & 15;
    for (int unit = gw; unit < 12 * (TG / 64); unit += NW) {
      const int s = unit % 12, r = unit / 12, t0 = r * 64;
      const int c = s * 128 + cb * 8;
      f32x4 wlo[5], whi[5];
#pragma unroll
      for (int j = 0; j < 5; ++j) { wlo[j] = *(const f32x4*)(p.dn_conv_w + j * 1536 + c); whi[j] = *(const f32x4*)(p.dn_conv_w + j * 1536 + c + 4); }
      const u16* src = proj + 1536 + c;
      const int ts = t0 + 16 * q, pos_s = (t0 & (L - 1)) + 16 * q;
      const u32x4 zero4 = {0u, 0u, 0u, 0u};
      u32x4 win[5];
      win[0] = (pos_s >= 2) ? *(const u32x4*)(src + (long)(ts - 2) * NPROJ) : zero4;
      win[1] = (pos_s >= 1) ? *(const u32x4*)(src + (long)(ts - 1) * NPROJ) : zero4;
      win[2] = *(const u32x4*)(src + (long)ts * NPROJ);
      win[3] = *(const u32x4*)(src + (long)(ts + 1) * NPROJ);
      u32x4 nw[16];
#pragma unroll
      for (int u = 0; u < 16; ++u) nw[u] = (pos_s + u + 2 < L) ? *(const u32x4*)(src + (long)(ts + u + 2) * NPROJ) : zero4;
      const float qs = (s < 4) ? 0.08838834764831845f : 1.f;
#pragma unroll
      for (int u = 0; u < 16; ++u) {
        win[4] = nw[u];
        float a[8];
#pragma unroll
        for (int e = 0; e < 8; ++e) a[e] = 0.f;
#pragma unroll
        for (int j = 0; j < 5; ++j) {
          a[0] += wlo[j].x * bflo(win[j].x); a[1] += wlo[j].y * bfhi(win[j].x); a[2] += wlo[j].z * bflo(win[j].y); a[3] += wlo[j].w * bfhi(win[j].y);
          a[4] += whi[j].x * bflo(win[j].z); a[5] += whi[j].y * bfhi(win[j].z); a[6] += whi[j].z * bflo(win[j].w); a[7] += whi[j].w * bfhi(win[j].w);
        }
        float ss = 0.f;
#pragma unroll
        for (int e = 0; e < 8; ++e) { a[e] = siluf_(a[e]); ss += a[e] * a[e]; }
        if (s < 8) {
          ss = sum16(ss);
          const float rs = __builtin_amdgcn_rsqf(ss + 1e-6f) * qs;
#pragma unroll
          for (int e = 0; e < 8; ++e) a[e] *= rs;
        }
        u32x4 o = {pk2(a[0], a[1]), pk2(a[2], a[3]), pk2(a[4], a[5]), pk2(a[6], a[7])};
        *(u32x4*)(dnp + (long)(ts + u) * 1536 + c) = o;
#pragma unroll
        for (int j = 0; j < 4; ++j) win[j] = win[j + 1];
      }
    }
  }
}

DI void attn_item(int grp, unsigned char* ws, unsigned char* smem, int item, const u16* proj) {
  const int tidx = opaque_tid();
  const int L = (grp == 0) ? 16384 : 2048;
  const int pat = item >> 11, rem = item & 2047, h = rem & 7, bi = rem >> 3;
  const int dsh = pat * 2, d = 1 << dsh;
  const int st = bi >> dsh, r = bi & (d - 1), base = st * (128 << dsh), s0 = base & ~(L - 1);
  const int tid = tidx, lane = tid & 63, w = tid >> 6, c16 = lane & 15, g = lane >> 4;
  unsigned char* Qs = smem; unsigned char* Ks = smem + 16384;
  const unsigned VS = 49152u;
  for (int e = tid; e < 1024; e += 512) {
    const int row = e >> 3, ch = e & 7; const long lt = base + r + (row << dsh);
    const u32x4 v = *(const u32x4*)(proj + lt * NPROJ + h * 64 + ch * 8);
    *(u32x4*)(Qs + row * 128 + ((ch ^ (row & 7)) << 4)) = v;
  }
  for (int e = tid; e < 2048; e += 512) {
    const int row = e >> 3, ch = e & 7; const int lt = base + r + (row - 64) * d;
    const bool valid = (lt >= s0) && (lt < s0 + L);
    u32x4 kv = {0u, 0u, 0u, 0u}, vv = {0u, 0u, 0u, 0u};
    if (valid) { kv = *(const u32x4*)(proj + (long)lt * NPROJ + 512 + h * 64 + ch * 8); vv = *(const u32x4*)(proj + (long)lt * NPROJ + 1024 + h * 64 + ch * 8); }
    *(u32x4*)(Ks + row * 128 + ((ch ^ (row & 7)) << 4)) = kv;
    *(u32x4*)(smem + VS + row * 160 + ch * 16) = vv;
  }
  __syncthreads();
  const int sw = c16 & 7, tb = w & ~1;
  bf16x8 qf[2];
#pragma unroll
  for (int kk = 0; kk < 2; ++kk) qf[kk] = *(const bf16x8*)(Qs + (16 * w + c16) * 128 + (((kk * 4 + g) ^ sw) << 4));
  f32x4 sc[10];
  {
    bf16x8 kf[10][2];
#pragma unroll
    for (int t = 0; t < 10; ++t)
#pragma unroll
      for (int kk = 0; kk < 2; ++kk) kf[t][kk] = *(const bf16x8*)(Ks + ((tb + t) * 16 + c16) * 128 + (((kk * 4 + g) ^ sw) << 4));
    __builtin_amdgcn_sched_barrier(0);
#pragma unroll
    for (int t = 0; t < 10; ++t) {
      f32x4 a = {0.f, 0.f, 0.f, 0.f};
#pragma unroll
      for (int kk = 0; kk < 2; ++kk) a = mfma16(kf[t][kk], qf[kk], a);
      sc[t] = a;
    }
  }
  const int qi = 16 * w + c16;
  float mx = -1e30f;
#pragma unroll
  for (int t = 0; t < 10; ++t)
#pragma unroll
    for (int j = 0; j < 4; ++j) {
      const int kj = (tb + t) * 16 + g * 4 + j - 64;
      const int lt = base + r + kj * d;
      const int df = qi - kj;
      const bool valid = (df <= 64) && (df >= -64) && (lt >= s0) && (lt < s0 + L);
      const float s = valid ? sc[t][j] : -1e30f;
      sc[t][j] = s; mx = fmaxf(mx, s);
    }
  mx = fmaxf(mx, __shfl_xor(mx, 16)); mx = fmaxf(mx, __shfl_xor(mx, 32));
  float den = 0.f;
#pragma unroll
  for (int t = 0; t < 10; ++t)
#pragma unroll
    for (int j = 0; j < 4; ++j) { const float pe = (sc[t][j] > -1e29f) ? __expf(sc[t][j] - mx) : 0.f; sc[t][j] = pe; den += pe; }
  den += __shfl_xor(den, 16); den += __shfl_xor(den, 32);
  f32x4 oa[4];
#pragma unroll
  for (int n = 0; n < 4; ++n) oa[n] = (f32x4){0.f, 0.f, 0.f, 0.f};
  {
    bf16x8 vf[5][4];
#pragma unroll
    for (int tp = 0; tp < 5; ++tp)
#pragma unroll
      for (int n = 0; n < 4; ++n) {
        const unsigned a0 = VS + ((tb + 2 * tp) * 16 + g * 4 + (c16 >> 2)) * 160 + n * 32 + (c16 & 3) * 8;
        const s16x4 lo = __builtin_amdgcn_ds_read_tr16_b64_v4i16((LAS s16x4*)(unsigned long)a0);
        const s16x4 hi = __builtin_amdgcn_ds_read_tr16_b64_v4i16((LAS s16x4*)(unsigned long)(a0 + 16 * 160));
        vf[tp][n] = __builtin_shufflevector(lo, hi, 0, 1, 2, 3, 4, 5, 6, 7);
      }
    __builtin_amdgcn_sched_barrier(0);
#pragma unroll
    for (int tp = 0; tp < 5; ++tp) {
      u32x4 pu = {pk2(sc[2 * tp].x, sc[2 * tp].y), pk2(sc[2 * tp].z, sc[2 * tp].w), pk2(sc[2 * tp + 1].x, sc[2 * tp + 1].y), pk2(sc[2 * tp + 1].z, sc[2 * tp + 1].w)};
      const bf16x8 pa = __builtin_bit_cast(bf16x8, pu);
#pragma unroll
      for (int n = 0; n < 4; ++n) oa[n] = mfma16(vf[tp][n], pa, oa[n]);
    }
  }
  u16* attp = (u16*)(ws + WS_ATTP); float* lse = (float*)(ws + WS_LSE);
  {
    const float inv = 1.f / den;
    const long lt = base + r + ((long)qi << dsh);
    u16* dst = attp + ((long)pat * TG + lt) * 512 + h * 64 + g * 4;
#pragma unroll
    for (int n = 0; n < 4; ++n) {
      u32x2 ov = {pk2(oa[n].x * inv, oa[n].y * inv), pk2(oa[n].z * inv, oa[n].w * inv)};
      *(u32x2*)(dst + n * 16) = ov;
    }
  }
  if (g == 0) { const long lt = base + r + ((long)qi << dsh); lse[((long)pat * TG + lt) * 8 + h] = mx + __logf(den); }
  __syncthreads();
}

DI void dnlocal_item(unsigned char* ws, unsigned char* smem, int item) {
  const int tidx = opaque_tid();
  const int ch = item >> 2, hd = item & 3;
  const int tid = tidx, lane = tid & 63, w = tid >> 6, c16 = lane & 15, g = lane >> 4;
  const int dir = tid >> 8, t8 = tid & 255;
  const u16* dnp = (const u16*)(ws + WS_DNP); const float* gates = (const float*)(ws + WS_GATES);
  unsigned char* Kl = smem; unsigned char* Ql = smem + 17408; unsigned char* Vl = smem + 34816;
  float* KK = (float*)(smem + 51200); float* QKm = (float*)(smem + 67584);
  float* Am = (float*)(smem + 83968);
  float* gcs = (float*)(smem + 116736);
  u16* Xs = (u16*)(smem + 51200);
  unsigned char* opnd = ws + WS_DNOP + (long)item * 2 * DNOP_BYTES;
  const long tok0 = (long)ch * 64;
  for (int e = tid; e < 3072; e += 512) {
    const int which = e >> 10, q = e & 1023, row = q >> 4, c8 = q & 15;
    const u32x4 v = *(const u32x4*)(dnp + (tok0 + row) * 1536 + which * 512 + hd * 128 + c8 * 8);
    unsigned char* dst = (which == 0) ? (Ql + row * 272) : (which == 1) ? (Kl + row * 272) : (Vl + row * 256);
    *(u32x4*)(dst + c8 * 16) = v;
  }
  if (tid < 128) {
    const int dd = tid >> 6, i = tid & 63, ri = dd ? 63 - i : i;
    const float be = gates[(tok0 + ri) * 16 + dd * 4 + hd];
    float gv = gates[(tok0 + ri) * 16 + 8 + dd * 4 + hd];
#pragma unroll
    for (int o = 1; o < 64; o <<= 1) { const float t = __shfl_up(gv, o); if (i >= o) gv += t; }
    gcs[dd * 64 + i] = gv; gcs[128 + dd * 64 + i] = be; gcs[256 + dd * 64 + i] = be * __expf(gv);
  }
  __syncthreads();
  {
    const int which = w >> 2, mt = w & 3;
    const unsigned char* Asrc = which ? Ql : Kl;
    f32x4 a4[4];
#pragma unroll
    for (int n = 0; n < 4; ++n) a4[n] = (f32x4){0.f, 0.f, 0.f, 0.f};
    {
      bf16x8 af[4], bfv[4][4];
#pragma unroll
      for (int kk = 0; kk < 4; ++kk) {
        af[kk] = *(const bf16x8*)(Asrc + (mt * 16 + c16) * 272 + (kk * 4 + g) * 16);
#pragma unroll
        for (int n = 0; n < 4; ++n) bfv[kk][n] = *(const bf16x8*)(Kl + (n * 16 + c16) * 272 + (kk * 4 + g) * 16);
      }
      __builtin_amdgcn_sched_barrier(0);
#pragma unroll
      for (int kk = 0; kk < 4; ++kk)
#pragma unroll
        for (int n = 0; n < 4; ++n) a4[n] = mfma16(af[kk], bfv[kk][n], a4[n]);
    }
    float* dst = which ? QKm : KK;
#pragma unroll
    for (int n = 0; n < 4; ++n)
#pragma unroll
      for (int j = 0; j < 4; ++j) dst[(mt * 16 + g * 4 + j) * 64 + n * 16 + c16] = a4[n][j];
  }
  __syncthreads();
  {
    const float* gc = gcs + dir * 64; const float* be = gcs + 128 + dir * 64;
    u16* qkout = (u16*)(opnd + dir * DNOP_BYTES + OP_QK);
#pragma unroll
    for (int e8 = 0; e8 < 8; ++e8) {
      const int e = t8 + 256 * e8;
      const int i = e >> 5, j = (e & 31) * 2;
      const int ri = dir ? 63 - i : i, rj = dir ? 63 - j : j, rj1 = dir ? 62 - j : j + 1;
      const float gi = gc[i];
      const float d0 = __expf(gi - gc[j]), d1 = __expf(gi - gc[j + 1]);
      const float bi = be[i];
      Am[(dir * 64 + i) * 64 + j] = (j < i) ? bi * KK[ri * 64 + rj] * d0 : 0.f;
      Am[(dir * 64 + i) * 64 + j + 1] = (j + 1 < i) ? bi * KK[ri * 64 + rj1] * d1 : 0.f;
      const float q0 = (j <= i) ? QKm[ri * 64 + rj] * d0 : 0.f, q1 = (j + 1 <= i) ? QKm[ri * 64 + rj1] * d1 : 0.f;
      *(unsigned*)(qkout + i * 64 + kperm(j)) = pk2(q0, q1);
    }
  }
  __syncthreads();
  {
    const bool isu = t8 < 128;
    const unsigned char* src = isu ? (Vl + t8 * 2) : (Kl + (t8 - 128) * 2);
    const int sstr = isu ? 256 : 272;
    const float* scl = gcs + (isu ? 128 : 256) + dir * 64;
    const float* Ad = Am + dir * 4096;
    float X[64];
    f32x4 av[2][16]; float rv[2];
    rv[0] = bf2f(*(const u16*)(src + (dir ? 63 : 0) * sstr)) * scl[0];
#pragma unroll
    for (int i = 0; i < 64; ++i) {
      if (i + 1 < 64) {
        const int rn = dir ? 62 - i : i + 1;
#pragma unroll
        for (int j4 = 0; j4 < (i + 4) / 4; ++j4) av[(i + 1) & 1][j4] = *(const f32x4*)(Ad + (i + 1) * 64 + j4 * 4);
        rv[(i + 1) & 1] = bf2f(*(const u16*)(src + rn * sstr)) * scl[i + 1];
      }
      __builtin_amdgcn_sched_barrier(0);
      float a = rv[i & 1], b = 0.f;
#pragma unroll
      for (int j4 = 0; j4 < (i + 3) / 4; ++j4) {
        if (4 * j4 + 0 < i) a -= av[i & 1][j4].x * X[4 * j4 + 0];
        if (4 * j4 + 1 < i) b -= av[i & 1][j4].y * X[4 * j4 + 1];
        if (4 * j4 + 2 < i) a -= av[i & 1][j4].z * X[4 * j4 + 2];
        if (4 * j4 + 3 < i) b -= av[i & 1][j4].w * X[4 * j4 + 3];
      }
      X[i] = a + b;
      __builtin_amdgcn_sched_barrier(0);
    }
    if (isu) {
      u32x4* dst = (u32x4*)(opnd + dir * DNOP_BYTES + OP_UT + t8 * 128);
#pragma unroll
      for (int q = 0; q < 8; ++q) { u32x4 o = {pk2(X[8 * q], X[8 * q + 1]), pk2(X[8 * q + 2], X[8 * q + 3]), pk2(X[8 * q + 4], X[8 * q + 5]), pk2(X[8 * q + 6], X[8 * q + 7])}; dst[q] = o; }
    } else {
      u16* xd = Xs + dir * 8192 + kperm(t8 - 128);
#pragma unroll
      for (int i = 0; i < 64; ++i) xd[i * 128] = f2bf(-X[i]);
    }
  }
  __syncthreads();
  {
#pragma unroll
    for (int e4 = 0; e4 < 4; ++e4) {
      const int e = tid + 512 * e4;
      const int dd = e >> 10, q = e & 1023;
      *(u32x4*)(opnd + dd * DNOP_BYTES + OP_WN + q * 16) = *(const u32x4*)((const unsigned char*)Xs + dd * 16384 + q * 16);
    }
#pragma unroll
    for (int e4 = 0; e4 < 4; ++e4) {
      const int e = tid + 512 * e4;
      const int dd = e >> 10, q = e & 1023, i = q >> 4, c8 = q & 15, ri = dd ? 63 - i : i;
      const float sc = __expf(gcs[dd * 64 + i]);
      const int kb = c8 >> 2, gg = c8 & 3;
      const u32x2 v0 = *(const u32x2*)(Ql + ri * 272 + (kb * 32 + gg * 4) * 2), v1 = *(const u32x2*)(Ql + ri * 272 + (kb * 32 + 16 + gg * 4) * 2);
      u32x4 o = {pk2(bflo(v0.x) * sc, bfhi(v0.x) * sc), pk2(bflo(v0.y) * sc, bfhi(v0.y) * sc), pk2(bflo(v1.x) * sc, bfhi(v1.x) * sc), pk2(bflo(v1.y) * sc, bfhi(v1.y) * sc)};
      *(u32x4*)(opnd + dd * DNOP_BYTES + OP_QD + q * 16) = o;
    }
    {
      const int dk = t8 & 127, half = t8 >> 7;
      const float gl = gcs[dir * 64 + 63];
      u32x4* dst = (u32x4*)(opnd + dir * DNOP_BYTES + OP_KDT + dk * 128 + half * 64);
#pragma unroll
      for (int q = 0; q < 4; ++q) {
        float v[8];
#pragma unroll
        for (int jj = 0; jj < 8; ++jj) {
          const int i = half * 32 + (jj >> 2) * 16 + q * 4 + (jj & 3), ri = dir ? 63 - i : i;
          v[jj] = bf2f(*(const u16*)(Kl + ri * 272 + dk * 2)) * __expf(gl - gcs[dir * 64 + i]);
        }
        u32x4 o = {pk2(v[0], v[1]), pk2(v[2], v[3]), pk2(v[4], v[5]), pk2(v[6], v[7])};
        dst[q] = o;
      }
      if (t8 == 0) ((float*)(ws + WS_EGL))[item * 2 + dir] = __expf(gl);
    }
  }
  __syncthreads();
}

constexpr int SCAN_BUF = 73728 + 256;
DI void glds4(const void* g, unsigned ldsoff) {
  __builtin_amdgcn_global_load_lds((const __attribute__((address_space(1))) void*)g, (LAS void*)(unsigned long)ldsoff, 4, 0, 0);
}
DI void scan_issue(const unsigned char* src, const float* egp, unsigned ldsbase, int tid) {
  if (tid < 256) {
#pragma unroll
    for (int i = 0; i < 18; ++i) {
      const int q = tid + 256 * i;
      int sq;
      if (i < 8) sq = (q & ~15) | ((q & 15) ^ ((q >> 4) & 15));
      else sq = (q & ~7) | ((q & 7) ^ ((q >> 4) & 7));
      glds16(src + sq * 16, ldsbase + q * 16);
    }
    if (tid < 64) glds4(egp, ldsbase + 73728 + tid * 4);
  }
}
#define SB_ __builtin_amdgcn_sched_barrier(0)
DI void scan_compute(const unsigned char* B, int chk, int dir, int hd, u16* obuf, f32x4 (&S)[8], int w, int c16, int g) {
  const float eg = *(const float*)(B + 73728);
  const int x15 = c16, x7 = (c16 >> 1) & 7;
  bf16x8 sb[4];
#pragma unroll
  for (int kb = 0; kb < 4; ++kb) {
    u32x4 u = {pk2(S[2 * kb].x, S[2 * kb].y), pk2(S[2 * kb].z, S[2 * kb].w), pk2(S[2 * kb + 1].x, S[2 * kb + 1].y), pk2(S[2 * kb + 1].z, S[2 * kb + 1].w)};
    sb[kb] = __builtin_bit_cast(bf16x8, u);
  }
  f32x4 va[4], oa[4];
#pragma unroll
  for (int mt = 0; mt < 4; ++mt) {
    const u32x2 uu = *(const u32x2*)(B + 57344 + (16 * w + c16) * 128 + (((mt * 2 + (g >> 1)) ^ x7) << 4) + (g & 1) * 8);
    va[mt] = (f32x4){bflo(uu.x), bfhi(uu.x), bflo(uu.y), bfhi(uu.y)};
    oa[mt] = (f32x4){0.f, 0.f, 0.f, 0.f};
  }
  const unsigned char* wrow = B + c16 * 256;
  bf16x8 f0[8], f1[8];
#define LDWQ_(dst, kb) _Pragma("unroll") for (int mt = 0; mt < 4; ++mt) { const unsigned char* ap = wrow + mt * 4096 + ((((kb) * 4 + g) ^ x15) << 4); dst[mt] = *(const bf16x8*)ap; dst[4 + mt] = *(const bf16x8*)(ap + 16384); }
#define MMWQ_(src, kb) _Pragma("unroll") for (int mt = 0; mt < 4; ++mt) { va[mt] = mfma16(src[mt], sb[kb], va[mt]); oa[mt] = mfma16(sb[kb], src[4 + mt], oa[mt]); }
  LDWQ_(f0, 0); LDWQ_(f1, 1); SB_;
  MMWQ_(f0, 0); SB_;
  LDWQ_(f0, 2); SB_;
  MMWQ_(f1, 1); SB_;
  LDWQ_(f1, 3); SB_;
  MMWQ_(f0, 2); SB_;
  {
    const unsigned char* qrow = B + 32768 + c16 * 128;
#pragma unroll
    for (int mt = 0; mt < 4; ++mt)
#pragma unroll
      for (int cb = 0; cb < 2; ++cb) f0[mt * 2 + cb] = *(const bf16x8*)(qrow + mt * 2048 + (((cb * 4 + g) ^ x7) << 4));
  }
  SB_;
  MMWQ_(f1, 3); SB_;
#undef LDWQ_
#undef MMWQ_
  bf16x8 vb[2];
#pragma unroll
  for (int cb = 0; cb < 2; ++cb) {
    u32x4 u = {pk2(va[2 * cb].x, va[2 * cb].y), pk2(va[2 * cb].z, va[2 * cb].w), pk2(va[2 * cb + 1].x, va[2 * cb + 1].y), pk2(va[2 * cb + 1].z, va[2 * cb + 1].w)};
    vb[cb] = __builtin_bit_cast(bf16x8, u);
  }
  const unsigned char* krow = B + 40960 + c16 * 128;
#define LDKD_(dst, t0) _Pragma("unroll") for (int t = 0; t < 4; ++t) _Pragma("unroll") for (int cb = 0; cb < 2; ++cb) dst[t * 2 + cb] = *(const bf16x8*)(krow + ((t0) + t) * 2048 + (((cb * 4 + g) ^ x7) << 4));
  LDKD_(f1, 0); SB_;
#pragma unroll
  for (int mt = 0; mt < 4; ++mt)
#pragma unroll
    for (int cb = 0; cb < 2; ++cb) oa[mt] = mfma16(vb[cb], f0[mt * 2 + cb], oa[mt]);
  SB_;
  LDKD_(f0, 4); SB_;
#pragma unroll
  for (int t = 0; t < 4; ++t) {
    f32x4 s = {S[t].x * eg, S[t].y * eg, S[t].z * eg, S[t].w * eg};
#pragma unroll
    for (int cb = 0; cb < 2; ++cb) s = mfma16(f1[t * 2 + cb], vb[cb], s);
    S[t] = s;
  }
  SB_;
#pragma unroll
  for (int t = 0; t < 4; ++t) {
    f32x4 s = {S[4 + t].x * eg, S[4 + t].y * eg, S[4 + t].z * eg, S[4 + t].w * eg};
#pragma unroll
    for (int cb = 0; cb < 2; ++cb) s = mfma16(f0[t * 2 + cb], vb[cb], s);
    S[4 + t] = s;
  }
#undef LDKD_
#pragma unroll
  for (int mt = 0; mt < 4; ++mt) {
    const int i = mt * 16 + c16;
    const long tok = (long)chk * 64 + (dir ? 63 - i : i);
    u32x2 ov = {pk2(oa[mt].x, oa[mt].y), pk2(oa[mt].z, oa[mt].w)};
    *(u32x2*)(obuf + tok * 512 + hd * 128 + 16 * w + g * 4) = ov;
  }
}
#undef SB_

DI void scan_chain(int grp, unsigned char* ws, unsigned char* smem, int chain) {
  const int tidx = opaque_tid();
  const int L = (grp == 0) ? 16384 : 2048, nc = L >> 6;
  const int dir = chain & 1, hd = (chain >> 1) & 3, sq = chain >> 3;
  const int tid = tidx, lane = tid & 63, w = tid >> 6, c16 = lane & 15, g = lane >> 4;
  const int chunk0 = sq * nc;
  const float* egl = (const float*)(ws + WS_EGL);
  u16* obuf = (u16*)(ws + WS_OF) + (long)dir * TG * 512;
  f32x4 S[8];
#pragma unroll
  for (int t = 0; t < 8; ++t) S[t] = (f32x4){0.f, 0.f, 0.f, 0.f};
  __syncthreads();
  {
    const int chk = chunk0 + (dir ? nc - 1 : 0);
    const long it = (long)(chk * 4 + hd) * 2 + dir;
    scan_issue(ws + WS_DNOP + it * DNOP_BYTES, egl + it, 0u, tid);
  }
  __syncthreads();
  for (int m = 0; m < nc; ++m) {
    const int chk = chunk0 + (dir ? nc - 1 - m : m);
    if (m + 1 < nc) {
      const int chn = chunk0 + (dir ? nc - 2 - m : m + 1);
      const long it = (long)(chn * 4 + hd) * 2 + dir;
      scan_issue(ws + WS_DNOP + it * DNOP_BYTES, egl + it, (unsigned)(((m + 1) & 1) * SCAN_BUF), tid);
    }
    scan_compute(smem + (m & 1) * SCAN_BUF, chk, dir, hd, obuf, S, w, c16, g);
    __syncthreads();
  }
}

DI void phase_merge(const Params& p, unsigned char* ws, const u16* proj) {
  const int tidx = opaque_tid();
  const int lane = tidx & 63;
  const int gw = blockIdx.x * 8 + (tidx >> 6), NW = gridDim.x * 8;
  const u16* attp = (const u16*)(ws + WS_ATTP); const float* lse = (const float*)(ws + WS_LSE);
  const u16* of = (const u16*)(ws + WS_OF);
  u16* mix = (u16*)(ws + WS_NBUF);
  f32x4 gn0 = *(const f32x4*)(p.out_norm + (lane & 15) * 8), gn1 = *(const f32x4*)(p.out_norm + (lane & 15) * 8 + 4);
  for (int t0 = gw; t0 < TG; t0 += 4 * NW) {
    float l0[4], l1[4], l2[4]; u32x4 pa[4], pb[4], pc[4], fa[4], fb[4], gg[4];
    const int h = lane >> 3;
#pragma unroll
    for (int k = 0; k < 4; ++k) {
      const long tt = t0 + (long)k * NW, t = tt < TG ? tt : TG - 1;
      l0[k] = lse[((long)0 * TG + t) * 8 + h]; l1[k] = lse[((long)1 * TG + t) * 8 + h]; l2[k] = lse[((long)2 * TG + t) * 8 + h];
      pa[k] = *(const u32x4*)(attp + ((long)0 * TG + t) * 512 + lane * 8);
      pb[k] = *(const u32x4*)(attp + ((long)1 * TG + t) * 512 + lane * 8);
      pc[k] = *(const u32x4*)(attp + ((long)2 * TG + t) * 512 + lane * 8);
      fa[k] = *(const u32x4*)(of + t * 512 + lane * 8);
      fb[k] = *(const u32x4*)(of + ((long)TG + t) * 512 + lane * 8);
      gg[k] = *(const u32x4*)(proj + t * NPROJ + 3072 + lane * 8);
    }
#pragma unroll
    for (int k = 0; k < 4; ++k) {
      const long t = t0 + (long)k * NW;
      if (t >= TG) break;
      {
        const float mx = fmaxf(l0[k], fmaxf(l1[k], l2[k]));
        float w0 = __expf(l0[k] - mx), w1 = __expf(l1[k] - mx), w2 = __expf(l2[k] - mx);
        const float inv = __builtin_amdgcn_rcpf(w0 + w1 + w2); w0 *= inv; w1 *= inv; w2 *= inv;
        const u32x4 a = pa[k], b = pb[k], c = pc[k];
        u32x4 o;
        o.x = pk2(w0 * bflo(a.x) + w1 * bflo(b.x) + w2 * bflo(c.x), w0 * bfhi(a.x) + w1 * bfhi(b.x) + w2 * bfhi(c.x));
        o.y = pk2(w0 * bflo(a.y) + w1 * bflo(b.y) + w2 * bflo(c.y), w0 * bfhi(a.y) + w1 * bfhi(b.y) + w2 * bfhi(c.y));
        o.z = pk2(w0 * bflo(a.z) + w1 * bflo(b.z) + w2 * bflo(c.z), w0 * bfhi(a.z) + w1 * bfhi(b.z) + w2 * bfhi(c.z));
        o.w = pk2(w0 * bflo(a.w) + w1 * bflo(b.w) + w2 * bflo(c.w), w0 * bfhi(a.w) + w1 * bfhi(b.w) + w2 * bfhi(c.w));
        *(u32x4*)(mix + t * 1024 + lane * 8) = o;
      }
      {
        const u32x4 a = fa[k], b = fb[k], g4 = gg[k];
        float o[8] = {bflo(a.x) + bflo(b.x), bfhi(a.x) + bfhi(b.x), bflo(a.y) + bflo(b.y), bfhi(a.y) + bfhi(b.y),
                      bflo(a.z) + bflo(b.z), bfhi(a.z) + bfhi(b.z), bflo(a.w) + bflo(b.w), bfhi(a.w) + bfhi(b.w)};
        float ss = 0.f;
#pragma unroll
        for (int i = 0; i < 8; ++i) ss += o[i] * o[i];
        ss = sum16(ss);
        const float rs = __builtin_amdgcn_rsqf(ss * (1.f / 128.f) + 1e-6f);
        const float gv[8] = {bflo(g4.x), bfhi(g4.x), bflo(g4.y), bfhi(g4.y), bflo(g4.z), bfhi(g4.z), bflo(g4.w), bfhi(g4.w)};
        const float gn[8] = {gn0.x, gn0.y, gn0.z, gn0.w, gn1.x, gn1.y, gn1.z, gn1.w};
        float y[8];
#pragma unroll
        for (int i = 0; i < 8; ++i) y[i] = o[i] * rs * gn[i] * siluf_(gv[i]);
        u32x4 ov = {pk2(y[0], y[1]), pk2(y[2], y[3]), pk2(y[4], y[5]), pk2(y[6], y[7])};
        *(u32x4*)(mix + t * 1024 + 512 + lane * 8) = ov;
      }
    }
  }
}

namespace pg8 {
#define PG8_LAS LAS
constexpr int BM = 256, BK = 64, HALF = 128, HTB = HALF * BK * 2;
DI int lds_byte(int r, int c) { const int st = (r >> 4) * 2 + (c >> 5), rr = r & 15, cc = c & 31, ob = rr * 64 + cc * 2; return st * 1024 + (ob ^ (((ob >> 9) & 1) << 5)); }
DI void stage_rc(int b, int& R, int& C) { const int st = b / 1024, sb = b % 1024, swz = sb ^ (((sb >> 9) & 1) << 5); R = (st >> 1) * 16 + swz / 64; C = (st & 1) * 32 + (swz % 64) / 2; }
DI int perm32(int rho) { const int n = rho >> 4, i = rho & 15; return 8 * (i >> 2) + 4 * n + (i & 3); }
struct Unit { int pm, pn; };
struct Gemm8 { const u16* A; const u16* Bt; int K; };
struct TileOrder {
  int nM, nN, ntiles, G, bperm;
  DI bool next(int i, Unit& u) const {
    const int T = i * G + bperm; if (T >= ntiles) return false;
    const int sg = T / (8 * nN), fm = sg * 8, gsz = (nM - fm) < 8 ? (nM - fm) : 8, idx = T - sg * 8 * nN;
    u.pm = fm + (idx % gsz); u.pn = idx / gsz; return true;
  }
  DI void a_ready(const Unit&) const {}
  DI void done(const Unit&) const {}
};
struct EpiProj {
  static constexpr bool PERM = true, AFTER_DRAIN = false;
  u16* proj;
  DI void operator()(const f32x4 (&acc)[2][2][4][2], const Unit& u, int wr, int wc, int fr, int fq) const {
    const int row0 = u.pm * BM + wr * 64 + fr, col0 = u.pn * BM + wc * 32 + 8 * fq;
#pragma unroll
    for (int ai = 0; ai < 2; ++ai)
#pragma unroll
      for (int m = 0; m < 4; ++m) {
        u16* rowp = proj + (size_t)(row0 + ai * HALF + m * 16) * NPROJ + col0;
#pragma unroll
        for (int bj = 0; bj < 2; ++bj) {
          const f32x4 a0 = acc[ai][bj][m][0], a1 = acc[ai][bj][m][1];
          u32x4 o = {pk2(a0.x, a0.y), pk2(a0.z, a0.w), pk2(a1.x, a1.y), pk2(a1.z, a1.w)};
          *(u32x4*)(rowp + bj * HALF) = o;
        }
      }
  }
};
struct EpiH {
  static constexpr bool PERM = true, AFTER_DRAIN = false;
  const float* xg; float* outg; u16* hb; float* rowsq;
  DI void operator()(const f32x4 (&acc)[2][2][4][2], const Unit& u, int wr, int wc, int fr, int fq) const {
    const int row0 = u.pm * BM + wr * 64 + fr, col0 = u.pn * BM + wc * 32 + 8 * fq;
#pragma unroll
    for (int ai = 0; ai < 2; ++ai) {
      f32x4 xv[4][2][2];
#pragma unroll
      for (int m = 0; m < 4; ++m)
#pragma unroll
        for (int bj = 0; bj < 2; ++bj)
#pragma unroll
          for (int n = 0; n < 2; ++n) xv[m][bj][n] = *(const f32x4*)(xg + (size_t)(row0 + ai * HALF + m * 16) * 1024 + col0 + bj * HALF + n * 4);
#pragma unroll
      for (int m = 0; m < 4; ++m) {
        const size_t row = (size_t)(row0 + ai * HALF + m * 16);
        float s = 0.f;
#pragma unroll
        for (int bj = 0; bj < 2; ++bj) {
          const f32x4 h0 = xv[m][bj][0] + acc[ai][bj][m][0], h1 = xv[m][bj][1] + acc[ai][bj][m][1];
          u32x4 o = {pk2(h0.x, h0.y), pk2(h0.z, h0.w), pk2(h1.x, h1.y), pk2(h1.z, h1.w)};
          *(u32x4*)(hb + row * 1024 + col0 + bj * HALF) = o;
          s += h0.x * h0.x + h0.y * h0.y + h0.z * h0.z + h0.w * h0.w + h1.x * h1.x + h1.y * h1.y + h1.z * h1.z + h1.w * h1.w;
        }
        s += __shfl_xor(s, 16); s += __shfl_xor(s, 32);
        if (fq == 0) rowsq[row * 16 + u.pn * 4 + wc] = s;
      }
    }
  }
};
struct EpiOut {
  static constexpr bool PERM = true, AFTER_DRAIN = false;
  float* outg; const u16* hb;
  DI void operator()(const f32x4 (&acc)[2][2][4][2], const Unit& u, int wr, int wc, int fr, int fq) const {
    const int row0 = u.pm * BM + wr * 64 + fr, col0 = u.pn * BM + wc * 32 + 8 * fq;
#pragma unroll
    for (int ai = 0; ai < 2; ++ai) {
      u32x4 hv[4][2];
#pragma unroll
      for (int m = 0; m < 4; ++m)
#pragma unroll
        for (int bj = 0; bj < 2; ++bj) hv[m][bj] = *(const u32x4*)(hb + (size_t)(row0 + ai * HALF + m * 16) * 1024 + col0 + bj * HALF);
#pragma unroll
      for (int m = 0; m < 4; ++m) {
        float* rowp = outg + (size_t)(row0 + ai * HALF + m * 16) * 1024 + col0;
#pragma unroll
        for (int bj = 0; bj < 2; ++bj) {
          const u32x4 v = hv[m][bj];
          f32x4 h0 = {bflo(v.x), bfhi(v.x), bflo(v.y), bfhi(v.y)}, h1 = {bflo(v.z), bfhi(v.z), bflo(v.w), bfhi(v.w)};
          h0 = h0 + acc[ai][bj][m][0]; h1 = h1 + acc[ai][bj][m][1];
          *(f32x4*)(rowp + bj * HALF) = h0; *(f32x4*)(rowp + bj * HALF + 4) = h1;
        }
      }
    }
  }
};
struct OneUnit {
  Unit u;
  DI bool next(int i, Unit& o) const { if (i != 0) return false; o = u; return true; }
  DI void a_ready(const Unit&) const {}
  DI void done(const Unit&) const {}
};
struct EpiGlu {
  static constexpr bool PERM = true, AFTER_DRAIN = true;
  const float* cw; const float* cb; const float* rowsq; u16* act; int pm, pn, L;
  DI void operator()(const f32x4 (&)[2][2][4][2], const Unit&, int, int, int, int) const {}
  DI void fused(const f32x4 (&acc)[2][2][4][2], const Unit&, int wr, int wc, int fr, int fq, PG8_LAS unsigned char* lds, int wid, int lane) const {
    const int rowbase = pm * 254 - 1;
#pragma unroll
    for (int ai = 0; ai < 2; ++ai) {
      f32x4 rq[4][4];
#pragma unroll
      for (int m = 0; m < 4; ++m) {
        const int rl = ai * HALF + wr * 64 + m * 16 + fr;
        int ar = rowbase + rl; ar = ar < 0 ? 0 : (ar > TG - 1 ? TG - 1 : ar);
        const f32x4* rp = (const f32x4*)(rowsq + (long)ar * 16);
#pragma unroll
        for (int q = 0; q < 4; ++q) rq[m][q] = rp[q];
      }
#pragma unroll
      for (int m = 0; m < 4; ++m) {
        const int rl = ai * HALF + wr * 64 + m * 16 + fr;
        const f32x4 q0 = rq[m][0], q1 = rq[m][1], q2 = rq[m][2], q3 = rq[m][3];
        const float ssq = (q0.x + q0.y + q0.z + q0.w) + (q1.x + q1.y + q1.z + q1.w) + (q2.x + q2.y + q2.z + q2.w) + (q3.x + q3.y + q3.z + q3.w);
        const float rs2 = __builtin_amdgcn_rsqf(ssq * (1.f / 1024.f) + 1e-6f);
#pragma unroll
        for (int bj = 0; bj < 2; ++bj)
#pragma unroll
          for (int n = 0; n < 2; ++n) {
            const int col = bj * HALF + wc * 32 + 8 * fq + 4 * n;
            const f32x4 a = acc[ai][bj][m][n];
            u32x2 o = {pk2(a.x * rs2, a.y * rs2), pk2(a.z * rs2, a.w * rs2)};
            *(PG8_LAS u32x2*)(lds + rl * 520 + col * 2) = o;
          }
      }
    }
    __syncthreads();
    {
      const int hp = lane, rg = wid;
      const int hid = pn * 128 + 2 * hp;
      float cwg[3][2], cwu[3][2], cbg[2], cbu[2];
#pragma unroll
      for (int j = 0; j < 3; ++j) {
        cwg[j][0] = cw[j * 5632 + hid]; cwg[j][1] = cw[j * 5632 + hid + 1];
        cwu[j][0] = cw[j * 5632 + 2816 + hid]; cwu[j][1] = cw[j * 5632 + 2816 + hid + 1];
      }
      cbg[0] = cb[hid]; cbg[1] = cb[hid + 1]; cbu[0] = cb[2816 + hid]; cbu[1] = cb[2816 + hid + 1];
      unsigned gk[34], uk[34];
#pragma unroll
      for (int k = 0; k < 34; ++k) {
        int r = rg * 32 - 1 + k; r = r < 0 ? 0 : (r > 255 ? 255 : r);
        gk[k] = *(const PG8_LAS unsigned*)(lds + r * 520 + hp * 4); uk[k] = *(const PG8_LAS unsigned*)(lds + r * 520 + 256 + hp * 4);
      }
#pragma unroll
      for (int kk = 0; kk < 32; ++kk) {
        const int i = rg * 32 + kk;
        const int lt = rowbase + i;
        if (i >= 1 && i <= 254 && lt < TG) {
          const unsigned gp = gk[kk], gc = gk[kk + 1], gn = gk[kk + 2], up = uk[kk], uc = uk[kk + 1], un = uk[kk + 2];
          const int pos = lt & (L - 1);
          float gp0 = bflo(gp), gp1 = bfhi(gp), up0 = bflo(up), up1 = bfhi(up), gn0 = bflo(gn), gn1 = bfhi(gn), un0 = bflo(un), un1 = bfhi(un);
          if (pos == 0) { gp0 = 0.f; gp1 = 0.f; up0 = 0.f; up1 = 0.f; }
          if (pos == L - 1) { gn0 = 0.f; gn1 = 0.f; un0 = 0.f; un1 = 0.f; }
          const float G0 = cwg[0][0] * gp0 + cwg[1][0] * bflo(gc) + cwg[2][0] * gn0 + cbg[0];
          const float G1 = cwg[0][1] * gp1 + cwg[1][1] * bfhi(gc) + cwg[2][1] * gn1 + cbg[1];
          const float U0 = cwu[0][0] * up0 + cwu[1][0] * bflo(uc) + cwu[2][0] * un0 + cbu[0];
          const float U1 = cwu[0][1] * up1 + cwu[1][1] * bfhi(uc) + cwu[2][1] * un1 + cbu[1];
          *(unsigned*)(act + (long)lt * 2816 + hid) = pk2(siluf_(G0) * U0, siluf_(G1) * U1);
        }
      }
    }
    __syncthreads();
  }
};
template <class Epi, class Sched>
__device__ __forceinline__ void gemm8_phase(PG8_LAS unsigned char* lds, const Gemm8 g, const Sched& S, const Epi& E) {
    constexpr bool STAMP = false; unsigned long long* stamps = nullptr;
    const int tid = opaque_tid(), wid = __builtin_amdgcn_readfirstlane(tid >> 6), lane = tid & 63, wr = wid >> 2, wc = wid & 3, fr = lane & 15, fq = lane >> 4;
    const int K = g.K, nt = K / BK;
    int ts_lo = 0, ts_hi = 0, nts = 0; const unsigned long long rt_entry = 0ull;
#define PG8_STAMP() do { if (STAMP && wid == 0 && nts < 64) { const unsigned long long _c = 0ull; \
        ts_lo = (lane == nts) ? (int)(unsigned)_c : ts_lo; ts_hi = (lane == nts) ? (int)(unsigned)(_c >> 32) : ts_hi; ++nts; } } while (0)
    PG8_STAMP();
    unsigned voffA[2], voffB[2];
#pragma unroll
    for (int i = 0; i < 2; ++i) { int R, C; stage_rc(tid * 16 + i * 8192, R, C); const int Rb = Epi::PERM ? ((R & ~31) + perm32(R & 31)) : R;
        voffA[i] = (unsigned)(R * K + C) * 2u; voffB[i] = (unsigned)(Rb * K + C) * 2u; }
    const size_t kstep = (size_t)(BK * 2);
    const size_t hstep = (size_t)HALF * K * 2;
    const size_t tstep = 2 * hstep;
    const unsigned ldsw = (unsigned)wid * 1024u;
    const int aoff = lds_byte(wr * 64 + fr, fq * 8), boff = lds_byte(wc * 32 + fr, fq * 8);
#define PG8_SA(b, h) (((b) * 2 + (h)) * HTB)
#define PG8_SB(b, h) ((4 + (b) * 2 + (h)) * HTB)
#define PG8_STAGE(bufoff, gbase, voff) do { _Pragma("unroll") for (int _i = 0; _i < 2; ++_i) \
        __builtin_amdgcn_global_load_lds((const unsigned*)((const char*)(gbase) + (voff)[_i]), (PG8_LAS unsigned*)(lds + (bufoff) + ldsw + _i * 8192), 16, 0, 0); } while (0)
#define PG8_LDA(dst, b, h) do { _Pragma("unroll") for (int m = 0; m < 4; ++m) _Pragma("unroll") for (int k = 0; k < 2; ++k) dst[m][k] = *(const PG8_LAS bf16x8*)(lds + PG8_SA(b, h) + aoff + m * 2048 + k * 1024); } while (0)
#define PG8_LDB(dst, b, h) do { _Pragma("unroll") for (int n = 0; n < 2; ++n) _Pragma("unroll") for (int k = 0; k < 2; ++k) dst[n][k] = *(const PG8_LAS bf16x8*)(lds + PG8_SB(b, h) + boff + n * 2048 + k * 1024); } while (0)
#define PG8_MMA(ai, bj, At, Bt) do { __builtin_amdgcn_s_setprio(1); _Pragma("unroll") for (int m = 0; m < 4; ++m) _Pragma("unroll") for (int n = 0; n < 2; ++n) _Pragma("unroll") for (int k = 0; k < 2; ++k) \
        acc[ai][bj][m][n] = __builtin_amdgcn_mfma_f32_16x16x32_bf16(Bt[n][k], At[m][k], acc[ai][bj][m][n], 0, 0, 0); __builtin_amdgcn_s_setprio(0); } while (0)
#define PG8_WAIT_V(n) asm volatile("s_waitcnt vmcnt(" #n ")" ::: "memory")
#define PG8_WAIT_L(n) asm volatile("s_waitcnt lgkmcnt(" #n ")" ::: "memory")
#define PG8_BAR __builtin_amdgcn_s_barrier()
#define PG8_SCHED __builtin_amdgcn_sched_barrier(0)
    Unit cur, nxt; int ui = 0;
    if (!S.next(0, cur)) return;
    f32x4 acc[2][2][4][2];
#pragma unroll
    for (int a = 0; a < 2; ++a)
#pragma unroll
        for (int b = 0; b < 2; ++b)
#pragma unroll
            for (int m = 0; m < 4; ++m)
#pragma unroll
                for (int n = 0; n < 2; ++n) acc[a][b][m][n] = (f32x4){0.f, 0.f, 0.f, 0.f};
    bf16x8 At[4][2], B0[2][2], B1[2][2];
    const char* cA = (const char*)g.A + (size_t)cur.pm * tstep; const char* cB = (const char*)g.Bt + (size_t)cur.pn * tstep;
    S.a_ready(cur);
    PG8_STAGE(PG8_SB(0, 0), cB, voffB); PG8_STAGE(PG8_SA(0, 0), cA, voffA); PG8_STAGE(PG8_SB(0, 1), cB + hstep, voffB); PG8_STAGE(PG8_SA(0, 1), cA + hstep, voffA);
    if (wr == 1) PG8_BAR;
    PG8_WAIT_V(4); PG8_BAR;
    PG8_STAGE(PG8_SB(1, 0), cB + kstep, voffB); PG8_STAGE(PG8_SA(1, 0), cA + kstep, voffA); PG8_STAGE(PG8_SB(1, 1), cB + hstep + kstep, voffB);
    PG8_WAIT_V(6); PG8_BAR;
    PG8_STAMP();
    for (;;) {
        const bool has_next = S.next(ui + 1, nxt);
        const char* nA = has_next ? (const char*)g.A + (size_t)nxt.pm * tstep : cA; const char* nB = has_next ? (const char*)g.Bt + (size_t)nxt.pn * tstep : cB;
        for (int t = 0; t < nt; t += 2) {
            const bool last = (t == nt - 2);
            const char* a1 = cA + (size_t)(t + 1) * kstep;
            const char* a2 = last ? nA : cA + (size_t)(t + 2) * kstep; const char* b2 = last ? nB : cB + (size_t)(t + 2) * kstep;
            const char* a3 = a2 + kstep; const char* b3 = b2 + kstep;
            if (last && has_next) S.a_ready(nxt);
            PG8_LDB(B0, 0, 0); PG8_SCHED; PG8_LDA(At, 0, 0); PG8_STAGE(PG8_SA(1, 1), a1 + hstep, voffA);
            PG8_WAIT_L(8); PG8_BAR; PG8_WAIT_L(0); PG8_MMA(0, 0, At, B0); PG8_BAR; PG8_SCHED;
            PG8_LDB(B1, 0, 1); PG8_STAGE(PG8_SB(0, 0), b2, voffB);
            PG8_BAR; PG8_WAIT_L(0); PG8_MMA(0, 1, At, B1); PG8_BAR;
            PG8_LDA(At, 0, 1); PG8_STAGE(PG8_SA(0, 0), a2, voffA);
            PG8_BAR; PG8_WAIT_L(0); PG8_MMA(1, 0, At, B0); PG8_BAR; PG8_SCHED;
            PG8_STAGE(PG8_SB(0, 1), b2 + hstep, voffB);
            PG8_WAIT_V(6); PG8_BAR; PG8_MMA(1, 1, At, B1); PG8_BAR;
            PG8_LDB(B0, 1, 0); PG8_SCHED; PG8_LDA(At, 1, 0); PG8_STAGE(PG8_SA(0, 1), a2 + hstep, voffA);
            PG8_WAIT_L(8); PG8_BAR; PG8_WAIT_L(0); PG8_MMA(0, 0, At, B0); PG8_BAR; PG8_SCHED;
            PG8_LDB(B1, 1, 1); PG8_STAGE(PG8_SB(1, 0), b3, voffB);
            PG8_BAR; PG8_WAIT_L(0); PG8_MMA(0, 1, At, B1); PG8_BAR;
            PG8_LDA(At, 1, 1); PG8_STAGE(PG8_SA(1, 0), a3, voffA);
            PG8_BAR; PG8_WAIT_L(0); PG8_MMA(1, 0, At, B0); PG8_BAR; PG8_SCHED;
            PG8_STAGE(PG8_SB(1, 1), b3 + hstep, voffB);
            PG8_WAIT_V(6); PG8_BAR; PG8_MMA(1, 1, At, B1); PG8_BAR;
        }
        PG8_STAMP();
        if constexpr (!Epi::AFTER_DRAIN) { E(acc, cur, wr, wc, fr, fq); S.done(cur); }
        PG8_STAMP();
        if (!has_next) break;
#pragma unroll
        for (int a = 0; a < 2; ++a)
#pragma unroll
            for (int b = 0; b < 2; ++b)
#pragma unroll
                for (int m = 0; m < 4; ++m)
#pragma unroll
                    for (int n = 0; n < 2; ++n) acc[a][b][m][n] = (f32x4){0.f, 0.f, 0.f, 0.f};
        cur = nxt; cA = nA; cB = nB; ++ui;
    }
    PG8_WAIT_V(0);
    if (wr == 0) PG8_BAR;
    PG8_BAR;
    if constexpr (Epi::AFTER_DRAIN) { E.fused(acc, cur, wr, wc, fr, fq, lds, wid, lane); S.done(cur); }
    PG8_STAMP();
    if (false) { stamps[lane] = lane < nts ? (((unsigned long long)(unsigned)ts_hi << 32) | (unsigned)ts_lo) : 0ull;
        if (lane == 62) stamps[62] = rt_entry; if (lane == 63) stamps[63] = 0ull; }
#undef PG8_STAMP
#undef PG8_SA
#undef PG8_SB
#undef PG8_STAGE
#undef PG8_LDA
#undef PG8_LDB
#undef PG8_MMA
#undef PG8_WAIT_V
#undef PG8_WAIT_L
#undef PG8_BAR
#undef PG8_SCHED
}
}

template <int MODE>
DI void gemm8_run(int grp, unsigned char* ws, const float* __restrict__ xg, float* __restrict__ outg, int bperm, int G, u16* projdst) {
  pg8::Gemm8 g; pg8::TileOrder S;
  S.G = G; S.bperm = bperm;
  S.nM = TG / 256;
  if (MODE == 1) { g.A = (const u16*)(ws + WS_NBUF2); g.Bt = (const u16*)(ws + WS_WIN); g.K = 1024; S.nN = NPROJ / 256; }
  else if (MODE == 2) { g.A = (const u16*)(ws + WS_NBUF); g.Bt = (const u16*)(ws + WS_WOUT); g.K = 1024; S.nN = 4; }
  else { g.A = (const u16*)(ws + WS_ACT); g.Bt = (const u16*)(ws + WS_WDOWN); g.K = 2816; S.nN = 4; }
  S.ntiles = S.nM * S.nN;
  __syncthreads();
  if (MODE == 1) { pg8::EpiProj E{projdst}; pg8::gemm8_phase((LAS unsigned char*)0, g, S, E); }
  else if (MODE == 2) { pg8::EpiH E{xg, outg, (u16*)(ws + WS_HB), (float*)(ws + WS_ROWSQ)}; pg8::gemm8_phase((LAS unsigned char*)0, g, S, E); }
  else { pg8::EpiOut E{outg, (const u16*)(ws + WS_HB)}; pg8::gemm8_phase((LAS unsigned char*)0, g, S, E); }
  __syncthreads();
}


DI void gemm8_glu(const Params& p, int grp, unsigned char* ws, int bperm) {
  const int L = (grp == 0) ? 16384 : 2048;
  const int nM = (TG + 253) / 254, nN = 22, ntiles = nM * nN, G = gridDim.x;
  __syncthreads();
  for (int T = bperm; T < ntiles; T += G) {
    const int sg = T / (8 * nN), fm = sg * 8, gsz = (nM - fm) < 8 ? (nM - fm) : 8, idx = T - sg * 8 * nN;
    const int pm = fm + (idx % gsz), pn = idx / gsz;
    pg8::Gemm8 g; g.A = (const u16*)(ws + WS_HB) + (long)(pm * 254 - 1) * 1024; g.Bt = (const u16*)(ws + WS_WUP); g.K = 1024;
    pg8::OneUnit S; S.u.pm = 0; S.u.pn = pn;
    pg8::EpiGlu E{p.ffn_cw, p.ffn_cb, (const float*)(ws + WS_ROWSQ), (u16*)(ws + WS_ACT), pm, pn, L};
    pg8::gemm8_phase((LAS unsigned char*)0, g, S, E);
  }
}

#define XB_TMO      128
#define XB_XCNT(j)  (256  + 64 * (j))
#define XB_XSUB(j)  (1280 + 64 * (j))
#define XB_XGEN(j)  (2304 + 64 * (j))
#define XB_TOP      3328
#define XB_TOPGEN   3392
#define XCD_BAR_WORDS 3456
#define XB_SPIN_CAP (1u << 18)
DI unsigned xb_ld(unsigned* p)              { return __hip_atomic_load(p, __ATOMIC_RELAXED, __HIP_MEMORY_SCOPE_AGENT); }
DI unsigned xb_add(unsigned* p, unsigned v) { return __hip_atomic_fetch_add(p, v, __ATOMIC_RELAXED, __HIP_MEMORY_SCOPE_AGENT); }
DI unsigned xb_xcc_id() { return (unsigned)__builtin_amdgcn_s_getreg((3 << 11) | 20) & 0xFu; }
#define XB_SPIN(cond, bar) do { unsigned _sp = 0; while (cond) { __builtin_amdgcn_s_sleep(1); \
    if ((++_sp & 255u) == 0u) { if (xb_ld(&(bar)[XB_TMO])) break; if (_sp > XB_SPIN_CAP) { atomicAdd(&(bar)[XB_TMO], 1u); break; } } } } while (0)
struct XcdBarrier { unsigned* bar; unsigned x; volatile LAS unsigned* st; };
DI XcdBarrier xcd_barrier_post(unsigned* bar, volatile LAS unsigned* st) {
  XcdBarrier b; b.bar = bar; b.x = xb_xcc_id(); b.st = st;
  if (opaque_tid() == 0) (void)xb_add(&bar[XB_XCNT(b.x)], 1u);
  return b;
}
DI void xcd_barrier_complete(unsigned* bar, unsigned x, unsigned& nloc, unsigned& nx) {
  const unsigned G = gridDim.x * gridDim.y * gridDim.z;
  unsigned sum, cnt, mine, sp = 0u;
  for (;;) {
    sum = 0u; cnt = 0u; mine = 0u;
#pragma unroll
    for (unsigned j = 0; j < 16; ++j) { const unsigned c = xb_ld(&bar[XB_XCNT(j)]); sum += c; cnt += (c > 0u) ? 1u : 0u; mine = (j == x) ? c : mine; }
    if (sum == G) break;
    __builtin_amdgcn_s_sleep(1);
    if ((++sp & 255u) == 0u) { if (xb_ld(&bar[XB_TMO])) break; if (sp > XB_SPIN_CAP) { atomicAdd(&bar[XB_TMO], 1u); break; } }
  }
  nloc = mine > 0u ? mine : 1u; nx = cnt > 0u ? cnt : 1u;
}
DI void xcd_barrier(const XcdBarrier& b) {
  asm volatile("s_waitcnt vmcnt(0)" ::: "memory");
  __syncthreads();
  if (opaque_tid() == 0) {
    unsigned* bar = b.bar;
    __builtin_amdgcn_s_waitcnt(0);
    unsigned nloc = b.st[0], nx = b.st[1];
    if (nloc == 0u) { xcd_barrier_complete(bar, b.x, nloc, nx); b.st[0] = nloc; b.st[1] = nx; }
    const unsigned old = xb_add(&bar[XB_XSUB(b.x)], 1u);
    const unsigned gen = old / nloc;
    if (old + 1u == (gen + 1u) * nloc) {
      __builtin_amdgcn_fence(__ATOMIC_RELEASE, "agent");
      asm volatile("s_waitcnt vmcnt(0)" ::: "memory");
      const unsigned og = xb_add(&bar[XB_TOP], 1u);
      const unsigned tg = og / nx;
      if (og + 1u == (tg + 1u) * nx) xb_add(&bar[XB_TOPGEN], 1u);
      else XB_SPIN(xb_ld(&bar[XB_TOPGEN]) == tg, bar);
      __builtin_amdgcn_fence(__ATOMIC_ACQUIRE, "agent");
      xb_add(&bar[XB_XGEN(b.x)], 1u);
      asm volatile("s_waitcnt vmcnt(0)" ::: "memory");
    } else {
      XB_SPIN(xb_ld(&bar[XB_XGEN(b.x)]) == gen, bar);
      __builtin_amdgcn_fence(__ATOMIC_ACQUIRE, "agent");
      asm volatile("s_waitcnt vmcnt(0)" ::: "memory");
    }
  }
  __syncthreads();
}

extern __shared__ __attribute__((aligned(16))) unsigned char smem[];

__global__ void __launch_bounds__(512) mk_fwd(Params p) {
  cg::grid_group grid = cg::this_grid();
  unsigned char* ws = p.ws;
  volatile LAS unsigned* xst = (volatile LAS unsigned*)(unsigned long)(LDS_BYTES - 16);
  if (opaque_tid() == 0) { xst[0] = 0u; xst[1] = 0u; }
  __syncthreads();
  const XcdBarrier xb = xcd_barrier_post((unsigned*)(ws + WS_BAR), xst);
  if (opaque_tid() == 0) xst[2] = xb_add(&xb.bar[XCD_BAR_WORDS + 32 * xb.x], 1u);
  int bperm = blockIdx.x;
  {
    const long gtid = (long)blockIdx.x * 512 + opaque_tid(), nthr = (long)gridDim.x * 512;
    conv_weight(p.w_in, 3600, 1024, NPROJ, (u16*)(ws + WS_WIN), 0, nullptr, gtid, nthr);
    conv_weight(p.w_out, 1024, 1024, 1024, (u16*)(ws + WS_WOUT), 0, nullptr, gtid, nthr);
    conv_weight(p.w_up, 5632, 1024, 5632, (u16*)(ws + WS_WUP), 1, p.norm2, gtid, nthr);
    conv_weight(p.w_down, 1024, 2816, 1024, (u16*)(ws + WS_WDOWN), 0, nullptr, gtid, nthr);
  }
  const bool beside = (gridDim.x >= 64);
#pragma unroll 1
  for (int grp = 0; grp < 3; ++grp) {
    const int gsc = __builtin_amdgcn_readfirstlane(grp);
    const float* xg = p.xgrp[gsc] + (long)(gsc >> 1) * TG * 1024;
    float* outg = p.out + (long)gsc * TG * 1024;
    const int psel = (gsc == 1 && beside) ? 1 : 0;
    u16* projg = (u16*)(p.pbase[psel] + (psel ? (size_t)TG * 1024 * sizeof(float) : WS_PROJ));
    if (!(grp == 1 && beside)) { REP(0) { phase_norm<0>(p, xg, ws, smem); __syncthreads(); } }
    if (grp == 0) {
      grid.sync();
      unsigned off = 0u;
#pragma unroll
      for (unsigned j = 0; j < 16; ++j) { const unsigned c = xb_ld(&xb.bar[XB_XCNT(j)]); off += (j < xb.x) ? c : 0u; }
      bperm = __builtin_amdgcn_readfirstlane((int)(off + xst[2]));
    } else GSYNC();
    if (!(grp == 1 && beside)) { REP(1) gemm8_run<1>(grp, ws, xg, outg, bperm, (int)gridDim.x, projg); GSYNC(); }
    phase_prep(p, grp, ws, projg);
    GSYNC();
    {
      REP(4) for (int it = blockIdx.x; it < 2048; it += gridDim.x) dnlocal_item(ws, smem, it);
    }
    GSYNC();
    {
      const int nchains = (grp == 0) ? 16 : 128;
      REP(3) for (int c = blockIdx.x; c < nchains; c += gridDim.x) scan_chain(grp, ws, smem, c);
      unsigned* qctr = xb.bar + XCD_BAR_WORDS + 32 * 16 + 32 * grp;
      for (;;) {
        if (opaque_tid() == 0) xst[3] = xb_add(qctr, 1u);
        __syncthreads();
        const int it = __builtin_amdgcn_readfirstlane((int)xst[3]);
        if (it >= 6144) break;
        attn_item(grp, ws, smem, it, projg);
      }
      if (grp == 0 && beside && blockIdx.x >= 16) {
        __syncthreads(); phase_norm<16>(p, p.xs, ws, smem);
        {
          asm volatile("s_waitcnt vmcnt(0)" ::: "memory");
          __syncthreads();
          if (opaque_tid() == 0) {
            unsigned* sb = xb.bar + XCD_BAR_WORDS + 32 * 40;
            __builtin_amdgcn_fence(__ATOMIC_RELEASE, "agent");
            asm volatile("s_waitcnt vmcnt(0)" ::: "memory");
            xb_add(sb, 1u);
            XB_SPIN(xb_ld(sb) < gridDim.x - 16u, xb.bar);
            __builtin_amdgcn_fence(__ATOMIC_ACQUIRE, "agent");
            asm volatile("s_waitcnt vmcnt(0)" ::: "memory");
          }
          __syncthreads();
        }
        const int G2 = (int)gridDim.x - 16, b2 = (int)blockIdx.x - 16;
        const int slot = ((G2 & 7) == 0) ? ((b2 & 7) * (G2 >> 3) + (b2 >> 3)) : b2;
        gemm8_run<1>(1, ws, p.xs, p.out, slot, G2, (u16*)(p.pbase[1] + (size_t)TG * 1024 * sizeof(float)));
      }
    }
    GSYNC();
    REP(5) phase_merge(p, ws, projg);
    GSYNC();
    REP(8) gemm8_run<2>(grp, ws, xg, outg, bperm, (int)gridDim.x, nullptr);
    GSYNC();
    REP(9) gemm8_glu(p, grp, ws, bperm);
    GSYNC();
    REP(11) gemm8_run<4>(grp, ws, xg, outg, bperm, (int)gridDim.x, nullptr);
  }
}

extern "C" void kernel_launch(void* const* d_in, const int* in_sizes, int n_in, void* d_out, int out_size,
                              void* d_ws, size_t ws_size, hipStream_t stream) {
  static int grid_blocks = 0;
  if (!grid_blocks) {
    int dev = 0, cus = 0, per_cu = 0;
    (void)hipGetDevice(&dev);
    (void)hipDeviceGetAttribute(&cus, hipDeviceAttributeMultiprocessorCount, dev);
    (void)hipFuncSetAttribute((const void*)mk_fwd, hipFuncAttributeMaxDynamicSharedMemorySize, LDS_BYTES);
    (void)hipOccupancyMaxActiveBlocksPerMultiprocessor(&per_cu, (const void*)mk_fwd, 512, LDS_BYTES);
    if (per_cu < 1) per_cu = 1;
    grid_blocks = cus * per_cu;
    if (ws_size < 947 * MiB) fprintf(stderr, "workspace too small: %zu\n", ws_size);
  }
  Params p{};
  p.xp = (const float*)d_in[0]; p.xs = (const float*)d_in[1]; p.norm1 = (const float*)d_in[2]; p.w_in = (const float*)d_in[3];
  p.qn = (const float*)d_in[4]; p.kn = (const float*)d_in[5]; p.dn_conv_w = (const float*)d_in[6]; p.a_log = (const float*)d_in[7];
  p.dt_bias = (const float*)d_in[8]; p.out_norm = (const float*)d_in[9]; p.w_out = (const float*)d_in[10]; p.norm2 = (const float*)d_in[11];
  p.w_up = (const float*)d_in[12]; p.ffn_cw = (const float*)d_in[13]; p.ffn_cb = (const float*)d_in[14]; p.w_down = (const float*)d_in[15];
  p.out = (float*)d_out; p.ws = (unsigned char*)d_ws;
  p.xgrp[0] = p.xp; p.xgrp[1] = p.xs; p.xgrp[2] = p.xs;
  p.pbase[0] = (unsigned char*)d_ws; p.pbase[1] = (unsigned char*)d_out;
  (void)hipMemsetAsync((unsigned char*)d_ws + WS_BAR, 0, 16384, stream);
  void* args[] = {&p};
  hipError_t e = hipLaunchCooperativeKernel((void*)mk_fwd, dim3(grid_blocks), dim3(512), args, LDS_BYTES, stream);
  if (e != hipSuccess) fprintf(stderr, "cooperative launch failed: %s (grid %d)\n", hipGetErrorString(e), grid_blocks);
}
```

```cpp
#include <hip/hip_runtime.h>
#include <hip/hip_cooperative_groups.h>
#include <cstdio>
namespace cg = cooperative_groups;

typedef unsigned short u16;
typedef __attribute__((ext_vector_type(8))) short bf16x8;
typedef __attribute__((ext_vector_type(4))) float f32x4;
typedef __attribute__((ext_vector_type(4))) unsigned u32x4;
typedef __attribute__((ext_vector_type(2))) unsigned u32x2;
typedef short s16x4 __attribute__((ext_vector_type(4)));
typedef __bf16 bf2_t __attribute__((ext_vector_type(2)));
typedef float f2_t __attribute__((ext_vector_type(2)));
#define DI __device__ __forceinline__

constexpr int TG = 32768;
constexpr int NPROJ = 3584;
constexpr size_t MiB = 1u << 20;
constexpr size_t WS_WIN = 0, WS_WOUT = 7 * MiB, WS_WUP = 9 * MiB, WS_WDOWN = 20 * MiB;
constexpr size_t WS_GATES = 27 * MiB, WS_LSE = 29 * MiB, WS_ROWSQ = 32 * MiB, WS_EGL = 34 * MiB;
constexpr size_t WS_BAR = 34 * MiB + 512 * 1024;
constexpr size_t WS_NBUF = 35 * MiB;
constexpr size_t WS_PROJ = 99 * MiB;
constexpr size_t WS_HB = WS_PROJ, WS_ACT = WS_PROJ + 64 * MiB;
constexpr size_t WS_DNP = 339 * MiB, WS_ATTP = 435 * MiB, WS_DNOP = 531 * MiB, WS_OF = 819 * MiB;
constexpr size_t WS_NBUF2 = 883 * MiB;
constexpr int DNOP_BYTES = 73728;
constexpr int OP_WN = 0, OP_QD = 16384, OP_QK = 32768, OP_KDT = 40960, OP_UT = 57344;
constexpr int LDS_BYTES = 163840;
#ifndef PROBE_MASK
#define PROBE_MASK 0
#endif
#define GSYNC() do { xcd_barrier(xb); if ((PROBE_MASK >> 7) & 1) xcd_barrier(xb); } while (0)
#define REP(bit) for (int rep_ = 0; rep_ < (((PROBE_MASK) >> (bit)) & 1) + 1; ++rep_)

struct Params {
  const float *xp, *xs, *norm1, *w_in, *qn, *kn, *dn_conv_w, *a_log, *dt_bias, *out_norm, *w_out, *norm2, *w_up, *ffn_cw, *ffn_cb, *w_down;
  float* out; unsigned char* ws;
  unsigned char* pbase[2];
  const float* xgrp[3];
};

DI float bf2f(unsigned v) { return __uint_as_float(v << 16); }
DI float bflo(unsigned v) { return __uint_as_float(v << 16); }
DI float bfhi(unsigned v) { return __uint_as_float(v & 0xffff0000u); }
DI unsigned pk2(float lo, float hi) { f2_t v = {lo, hi}; bf2_t r = __builtin_convertvector(v, bf2_t); return __builtin_bit_cast(unsigned, r); }
DI u16 f2bf(float x) { return (u16)(pk2(x, 0.f) & 0xffffu); }
DI int opaque_tid() {
  const int wv = __builtin_amdgcn_readfirstlane((int)threadIdx.x >> 6);
  int ln;
  asm volatile("v_mbcnt_lo_u32_b32 %0, -1, 0\n\tv_mbcnt_hi_u32_b32 %0, -1, %0" : "=v"(ln));
  return (wv << 6) | ln; }
DI float dpp_f(float v, const int ctrl_sel) {
  const int x = __float_as_int(v);
  int r;
  if (ctrl_sel == 0) r = __builtin_amdgcn_update_dpp(x, x, 0xB1, 0xF, 0xF, true);
  else if (ctrl_sel == 1) r = __builtin_amdgcn_update_dpp(x, x, 0x4E, 0xF, 0xF, true);
  else if (ctrl_sel == 2) r = __builtin_amdgcn_update_dpp(x, x, 0x141, 0xF, 0xF, true);
  else r = __builtin_amdgcn_update_dpp(x, x, 0x140, 0xF, 0xF, true);
  return __int_as_float(r);
}
DI float sum16(float v) {
  v += dpp_f(v, 0); v += dpp_f(v, 1); v += dpp_f(v, 2); v += dpp_f(v, 3);
  return v;
}
DI float wave_sum(float v) {
  v = sum16(v);
  v += __shfl_xor(v, 16); v += __shfl_xor(v, 32);
  return v;
}
DI f32x4 mfma16(bf16x8 a, bf16x8 b, f32x4 c) { return __builtin_amdgcn_mfma_f32_16x16x32_bf16(a, b, c, 0, 0, 0); }
#define LAS __attribute__((address_space(3)))
DI void glds16(const void* g, unsigned ldsoff) {
  __builtin_amdgcn_global_load_lds((const __attribute__((address_space(1))) void*)g, (LAS void*)(unsigned long)ldsoff, 16, 0, 0);
}
DI int kperm(int k) { return (k & ~31) | (((k >> 2) & 3) << 3) | (((k >> 4) & 1) << 2) | (k & 3); }
DI float sigmoidf_(float x) { return __builtin_amdgcn_rcpf(1.f + __expf(-x)); }
DI float siluf_(float x) { return x * __builtin_amdgcn_rcpf(1.f + __expf(-x)); }

DI void conv_weight(const float* __restrict__ W, int Nsrc, int K, int Nout, u16* __restrict__ WT, int mode, const float* __restrict__ scale,
                    long gtid, long nthr) {
  const int kgn = K >> 3;
  for (long idx = gtid; idx < (long)Nout * kgn; idx += nthr) {
    const int n = (int)(idx % Nout), kg = (int)(idx / Nout);
    int src = n;
    if (mode == 1) { const int pn = n >> 8, ct = n & 255; src = (ct < 128) ? (pn * 128 + ct) : (2816 + pn * 128 + ct - 128); }
    float v[8];
#pragma unroll
    for (int j = 0; j < 8; ++j) { const int k = kg * 8 + j; const float s = scale ? scale[k] : 1.f; v[j] = W[(long)k * Nsrc + src] * s; }
    u32x4 o = {pk2(v[0], v[1]), pk2(v[2], v[3]), pk2(v[4], v[5]), pk2(v[6], v[7])};
    *(u32x4*)(WT + (long)n * K + kg * 8) = o;
  }
}

template <int B0>
DI void phase_norm(const Params& p, const float* __restrict__ xg, unsigned char* ws, unsigned char* smem) {
  const int b0 = B0, nb = (int)gridDim.x - B0;
  const int tidx = opaque_tid();
  f32x4* gw4 = (f32x4*)smem;
  float* gwf = (float*)smem;
  for (int e = tidx; e < 1024 * 16; e += 512) {
    const int k = e >> 4, jg = e & 15;
    const int ln = (k >> 2) & 63, j = k >> 8, ee = k & 3, q = jg >> 2, cmp = jg & 3;
    gwf[((((j * 4 + ee) * 4 + q) * 64 + ln) << 2) + cmp] = p.w_in[(long)k * 3600 + 3584 + jg];
  }
  __syncthreads();
  const int wave = tidx >> 6, lane = tidx & 63;
  u16* nbuf = (u16*)(ws + WS_NBUF2); float* gates = (float*)(ws + WS_GATES);
  const int bl = (int)blockIdx.x - b0;
  f32x4 vn[4];
  {
    const f32x4* xr = (const f32x4*)(xg + (long)(bl * 8 + wave) * 1024);
#pragma unroll
    for (int j = 0; j < 4; ++j) vn[j] = xr[lane + 64 * j];
  }
  for (int row = bl * 8 + wave; row < TG; row += nb * 8) {
    f32x4 v[4]; float ss = 0.f;
#pragma unroll
    for (int j = 0; j < 4; ++j) { v[j] = vn[j]; ss += v[j].x * v[j].x + v[j].y * v[j].y + v[j].z * v[j].z + v[j].w * v[j].w; }
    {
      const int rn = row + nb * 8;
      const f32x4* xr = (const f32x4*)(xg + (long)(rn < TG ? rn : row) * 1024);
#pragma unroll
      for (int j = 0; j < 4; ++j) vn[j] = xr[lane + 64 * j];
    }
    ss = wave_sum(ss);
    const float rs = rsqrtf(ss * (1.f / 1024.f) + 1e-6f);
    float ga[16];
#pragma unroll
    for (int i = 0; i < 16; ++i) ga[i] = 0.f;
#pragma unroll
    for (int j = 0; j < 4; ++j) {
      const f32x4 nw = ((const f32x4*)p.norm1)[lane + 64 * j];
      v[j].x *= rs * nw.x; v[j].y *= rs * nw.y; v[j].z *= rs * nw.z; v[j].w *= rs * nw.w;
      u32x2 o = {pk2(v[j].x, v[j].y), pk2(v[j].z, v[j].w)};
      *(u32x2*)(nbuf + (long)row * 1024 + 4 * (lane + 64 * j)) = o;
#pragma unroll
      for (int e = 0; e < 4; ++e) {
        const float xv = v[j][e];
#pragma unroll
        for (int q = 0; q < 4; ++q) {
          const f32x4 w4 = gw4[((j * 4 + e) * 4 + q) * 64 + lane];
          ga[4 * q + 0] += xv * w4.x; ga[4 * q + 1] += xv * w4.y; ga[4 * q + 2] += xv * w4.z; ga[4 * q + 3] += xv * w4.w;
        }
        __builtin_amdgcn_sched_barrier(0);
      }
    }
    float r = 0.f;
#pragma unroll
    for (int i = 0; i < 16; ++i) { const float s = wave_sum(ga[i]); r = (lane == i) ? s : r; }
    if (lane < 16) {
      float o;
      if (lane < 8) o = sigmoidf_(r);
      else { const int jj = lane - 8; const float z = r + p.dt_bias[jj]; const float ez = __expf(z); const float sp = (z > 20.f) ? z : ((ez < 0.02f) ? ez * (1.f - ez * (0.5f - ez * (1.f / 3.f))) : __logf(1.f + ez)); o = -__expf(p.a_log[jj]) * sp; }
      gates[(long)row * 16 + lane] = o;
    }
  }
}

DI void phase_prep(const Params& p, int grp, unsigned char* ws, u16* proj) {
  const int tidx = opaque_tid();
  const int L = (grp == 0) ? 16384 : 2048;
  const int lane = tidx & 63;
  const int gw = blockIdx.x * 8 + (tidx >> 6), NW = gridDim.x * 8;
  {
    const int i = lane & 15;
    const float f0 = exp2f(-(float)(2 * i) * (13.287712379549449f / 32.f)), f1 = exp2f(-(float)(2 * i + 1) * (13.287712379549449f / 32.f));
    for (int tb = gw; tb < TG; tb += 4 * NW) {
      unsigned elo[4][4], ehi[4][4];
#pragma unroll
      for (int kt = 0; kt < 4; ++kt)
#pragma unroll
        for (int k = 0; k < 4; ++k) {
          const int tt = tb + kt * NW, t = tt < TG ? tt : TG - 1, hs = (lane >> 4) + 4 * k;
          const u16* ptr = proj + (long)t * NPROJ + hs * 64;
          elo[kt][k] = *(const unsigned*)(ptr + 2 * i); ehi[kt][k] = *(const unsigned*)(ptr + 32 + 2 * i);
        }
#pragma unroll
      for (int kt = 0; kt < 4; ++kt) {
        const int t = tb + kt * NW;
        if (t >= TG) break;
        float s0, c0, s1, c1;
        {
          const float pos = (float)(t & (L - 1));
          __sincosf(pos * f0, &s0, &c0); __sincosf(pos * f1, &s1, &c1);
        }
#pragma unroll
        for (int k = 0; k < 4; ++k) {
          const int hs = (lane >> 4) + 4 * k;
          u16* ptr = proj + (long)t * NPROJ + hs * 64;
          float x1a = bflo(elo[kt][k]), x1b = bfhi(elo[kt][k]), x2a = bflo(ehi[kt][k]), x2b = bfhi(ehi[kt][k]);
          float ss = x1a * x1a + x1b * x1b + x2a * x2a + x2b * x2b;
          ss = sum16(ss);
          const float rs = __builtin_amdgcn_rsqf(ss * (1.f / 64.f) + 1e-6f);
          const float* gn = (hs < 8) ? p.qn : p.kn;
          const float sc = (hs < 8) ? 0.125f : 1.f;
          x1a *= rs * gn[2 * i]; x1b *= rs * gn[2 * i + 1]; x2a *= rs * gn[32 + 2 * i]; x2b *= rs * gn[33 + 2 * i];
          const float o1a = (x1a * c0 - x2a * s0) * sc, o2a = (x2a * c0 + x1a * s0) * sc;
          const float o1b = (x1b * c1 - x2b * s1) * sc, o2b = (x2b * c1 + x1b * s1) * sc;
          *(unsigned*)(ptr + 2 * i) = pk2(o1a, o1b); *(unsigned*)(ptr + 32 + 2 * i) = pk2(o2a, o2b);
        }
      }
    }
  }
  {
    u16* dnp = (u16*)(ws + WS_DNP);
    const int q = lane >> 4, cb = lane & 15;
    for (int unit = gw; unit < 12 * (TG / 64); unit += NW) {
      const int s = unit % 12, r = unit / 12, t0 = r * 64;
      const int c = s * 128 + cb * 8;
      f32x4 wlo[5], whi[5];
#pragma unroll
      for (int j = 0; j < 5; ++j) { wlo[j] = *(const f32x4*)(p.dn_conv_w + j * 1536 + c); whi[j] = *(const f32x4*)(p.dn_conv_w + j * 1536 + c + 4); }
      const u16* src = proj + 1536 + c;
      const int ts = t0 + 16 * q, pos_s = (t0 & (L - 1)) + 16 * q;
      const u32x4 zero4 = {0u, 0u, 0u, 0u};
      u32x4 win[5];
      win[0] = (pos_s >= 2) ? *(const u32x4*)(src + (long)(ts - 2) * NPROJ) : zero4;
      win[1] = (pos_s >= 1) ? *(const u32x4*)(src + (long)(ts - 1) * NPROJ) : zero4;
      win[2] = *(const u32x4*)(src + (long)ts * NPROJ);
      win[3] = *(const u32x4*)(src + (long)(ts + 1) * NPROJ);
      u32x4 nw[16];
#pragma unroll
      for (int u = 0; u < 16; ++u) nw[u] = (pos_s + u + 2 < L) ? *(const u32x4*)(src + (long)(ts + u + 2) * NPROJ) : zero4;
      const float qs = (s < 4) ? 0.08838834764831845f : 1.f;
#pragma unroll
      for (int u = 0; u < 16; ++u) {
        win[4] = nw[u];
        float a[8];
#pragma unroll
        for (int e = 0; e < 8; ++e) a[e] = 0.f;
#pragma unroll
        for (int j = 0; j < 5; ++j) {
          a[0] += wlo[j].x * bflo(win[j].x); a[1] += wlo[j].y * bfhi(win[j].x); a[2] += wlo[j].z * bflo(win[j].y); a[3] += wlo[j].w * bfhi(win[j].y);
          a[4] += whi[j].x * bflo(win[j].z); a[5] += whi[j].y * bfhi(win[j].z); a[6] += whi[j].z * bflo(win[j].w); a[7] += whi[j].w * bfhi(win[j].w);
        }
        float ss = 0.f;
#pragma unroll
        for (int e = 0; e < 8; ++e) { a[e] = siluf_(a[e]); ss += a[e] * a[e]; }
        if (s < 8) {
          ss = sum16(ss);
          const float rs = __builtin_amdgcn_rsqf(ss + 1e-6f) * qs;
#pragma unroll
          for (int e = 0; e < 8; ++e) a[e] *= rs;
        }
        u32x4 o = {pk2(a[0], a[1]), pk2(a[2], a[3]), pk2(a[4], a[5]), pk2(a[6], a[7])};
        *(u32x4*)(dnp + (long)(ts + u) * 1536 + c) = o;
#pragma unroll
        for (int j = 0; j < 4; ++j) win[j] = win[j + 1];
      }
    }
  }
}

DI void attn_item(int grp, unsigned char* ws, unsigned char* smem, int item, const u16* proj) {
  const int tidx = opaque_tid();
  const int L = (grp == 0) ? 16384 : 2048;
  const int pat = item >> 11, rem = item & 2047, h = rem & 7, bi = rem >> 3;
  const int dsh = pat * 2, d = 1 << dsh;
  const int st = bi >> dsh, r = bi & (d - 1), base = st * (128 << dsh), s0 = base & ~(L - 1);
  const int tid = tidx, lane = tid & 63, w = tid >> 6, c16 = lane & 15, g = lane >> 4;
  unsigned char* Qs = smem; unsigned char* Ks = smem + 16384;
  const unsigned VS = 49152u;
  for (int e = tid; e < 1024; e += 512) {
    const int row = e >> 3, ch = e & 7; const long lt = base + r + (row << dsh);
    const u32x4 v = *(const u32x4*)(proj + lt * NPROJ + h * 64 + ch * 8);
    *(u32x4*)(Qs + row * 128 + ((ch ^ (row & 7)) << 4)) = v;
  }
  for (int e = tid; e < 2048; e += 512) {
    const int row = e >> 3, ch = e & 7; const int lt = base + r + (row - 64) * d;
    const bool valid = (lt >= s0) && (lt < s0 + L);
    u32x4 kv = {0u, 0u, 0u, 0u}, vv = {0u, 0u, 0u, 0u};
    if (valid) { kv = *(const u32x4*)(proj + (long)lt * NPROJ + 512 + h * 64 + ch * 8); vv = *(const u32x4*)(proj + (long)lt * NPROJ + 1024 + h * 64 + ch * 8); }
    *(u32x4*)(Ks + row * 128 + ((ch ^ (row & 7)) << 4)) = kv;
    *(u32x4*)(smem + VS + row * 160 + ch * 16) = vv;
  }
  __syncthreads();
  const int sw = c16 & 7, tb = w & ~1;
  bf16x8 qf[2];
#pragma unroll
  for (int kk = 0; kk < 2; ++kk) qf[kk] = *(const bf16x8*)(Qs + (16 * w + c16) * 128 + (((kk * 4 + g) ^ sw) << 4));
  f32x4 sc[10];
  {
    bf16x8 kf[10][2];
#pragma unroll
    for (int t = 0; t < 10; ++t)
#pragma unroll
      for (int kk = 0; kk < 2; ++kk) kf[t][kk] = *(const bf16x8*)(Ks + ((tb + t) * 16 + c16) * 128 + (((kk * 4 + g) ^ sw) << 4));
    __builtin_amdgcn_sched_barrier(0);
#pragma unroll
    for (int t = 0; t < 10; ++t) {
      f32x4 a = {0.f, 0.f, 0.f, 0.f};
#pragma unroll
      for (int kk = 0; kk < 2; ++kk) a = mfma16(kf[t][kk], qf[kk], a);
      sc[t] = a;
    }
  }
  const int qi = 16 * w + c16;
  float mx = -1e30f;
#pragma unroll
  for (int t = 0; t < 10; ++t)
#pragma unroll
    for (int j = 0; j < 4; ++j) {
      const int kj = (tb + t) * 16 + g * 4 + j - 64;
      const int lt = base + r + kj * d;
      const int df = qi - kj;
      const bool valid = (df <= 64) && (df >= -64) && (lt >= s0) && (lt < s0 + L);
      const float s = valid ? sc[t][j] : -1e30f;
      sc[t][j] = s; mx = fmaxf(mx, s);
    }
  mx = fmaxf(mx, __shfl_xor(mx, 16)); mx = fmaxf(mx, __shfl_xor(mx, 32));
  float den = 0.f;
#pragma unroll
  for (int t = 0; t < 10; ++t)
#pragma unroll
    for (int j = 0; j < 4; ++j) { const float pe = (sc[t][j] > -1e29f) ? __expf(sc[t][j] - mx) : 0.f; sc[t][j] = pe; den += pe; }
  den += __shfl_xor(den, 16); den += __shfl_xor(den, 32);
  f32x4 oa[4];
#pragma unroll
  for (int n = 0; n < 4; ++n) oa[n] = (f32x4){0.f, 0.f, 0.f, 0.f};
  {
    bf16x8 vf[5][4];
#pragma unroll
    for (int tp = 0; tp < 5; ++tp)
#pragma unroll
      for (int n = 0; n < 4; ++n) {
        const unsigned a0 = VS + ((tb + 2 * tp) * 16 + g * 4 + (c16 >> 2)) * 160 + n * 32 + (c16 & 3) * 8;
        const s16x4 lo = __builtin_amdgcn_ds_read_tr16_b64_v4i16((LAS s16x4*)(unsigned long)a0);
        const s16x4 hi = __builtin_amdgcn_ds_read_tr16_b64_v4i16((LAS s16x4*)(unsigned long)(a0 + 16 * 160));
        vf[tp][n] = __builtin_shufflevector(lo, hi, 0, 1, 2, 3, 4, 5, 6, 7);
      }
    __builtin_amdgcn_sched_barrier(0);
#pragma unroll
    for (int tp = 0; tp < 5; ++tp) {
      u32x4 pu = {pk2(sc[2 * tp].x, sc[2 * tp].y), pk2(sc[2 * tp].z, sc[2 * tp].w), pk2(sc[2 * tp + 1].x, sc[2 * tp + 1].y), pk2(sc[2 * tp + 1].z, sc[2 * tp + 1].w)};
      const bf16x8 pa = __builtin_bit_cast(bf16x8, pu);
#pragma unroll
      for (int n = 0; n < 4; ++n) oa[n] = mfma16(vf[tp][n], pa, oa[n]);
    }
  }
  u16* attp = (u16*)(ws + WS_ATTP); float* lse = (float*)(ws + WS_LSE);
  {
    const float inv = 1.f / den;
    const long lt = base + r + ((long)qi << dsh);
    u16* dst = attp + ((long)pat * TG + lt) * 512 + h * 64 + g * 4;
#pragma unroll
    for (int n = 0; n < 4; ++n) {
      u32x2 ov = {pk2(oa[n].x * inv, oa[n].y * inv), pk2(oa[n].z * inv, oa[n].w * inv)};
      *(u32x2*)(dst + n * 16) = ov;
    }
  }
  if (g == 0) { const long lt = base + r + ((long)qi << dsh); lse[((long)pat * TG + lt) * 8 + h] = mx + __logf(den); }
  __syncthreads();
}

DI void dnlocal_item(unsigned char* ws, unsigned char* smem, int item) {
  const int tidx = opaque_tid();
  const int ch = item >> 2, hd = item & 3;
  const int tid = tidx, lane = tid & 63, w = tid >> 6, c16 = lane & 15, g = lane >> 4;
  const int dir = tid >> 8, t8 = tid & 255;
  const u16* dnp = (const u16*)(ws + WS_DNP); const float* gates = (const float*)(ws + WS_GATES);
  unsigned char* Kl = smem; unsigned char* Ql = smem + 17408; unsigned char* Vl = smem + 34816;
  float* KK = (float*)(smem + 51200); float* QKm = (float*)(smem + 67584);
  float* Am = (float*)(smem + 83968);
  float* gcs = (float*)(smem + 116736);
  u16* Xs = (u16*)(smem + 51200);
  unsigned char* opnd = ws + WS_DNOP + (long)item * 2 * DNOP_BYTES;
  const long tok0 = (long)ch * 64;
  for (int e = tid; e < 3072; e += 512) {
    const int which = e >> 10, q = e & 1023, row = q >> 4, c8 = q & 15;
    const u32x4 v = *(const u32x4*)(dnp + (tok0 + row) * 1536 + which * 512 + hd * 128 + c8 * 8);
    unsigned char* dst = (which == 0) ? (Ql + row * 272) : (which == 1) ? (Kl + row * 272) : (Vl + row * 256);
    *(u32x4*)(dst + c8 * 16) = v;
  }
  if (tid < 128) {
    const int dd = tid >> 6, i = tid & 63, ri = dd ? 63 - i : i;
    const float be = gates[(tok0 + ri) * 16 + dd * 4 + hd];
    float gv = gates[(tok0 + ri) * 16 + 8 + dd * 4 + hd];
#pragma unroll
    for (int o = 1; o < 64; o <<= 1) { const float t = __shfl_up(gv, o); if (i >= o) gv += t; }
    gcs[dd * 64 + i] = gv; gcs[128 + dd * 64 + i] = be; gcs[256 + dd * 64 + i] = be * __expf(gv);
  }
  __syncthreads();
  {
    const int which = w >> 2, mt = w & 3;
    const unsigned char* Asrc = which ? Ql : Kl;
    f32x4 a4[4];
#pragma unroll
    for (int n = 0; n < 4; ++n) a4[n] = (f32x4){0.f, 0.f, 0.f, 0.f};
    {
      bf16x8 af[4], bfv[4][4];
#pragma unroll
      for (int kk = 0; kk < 4; ++kk) {
        af[kk] = *(const bf16x8*)(Asrc + (mt * 16 + c16) * 272 + (kk * 4 + g) * 16);
#pragma unroll
        for (int n = 0; n < 4; ++n) bfv[kk][n] = *(const bf16x8*)(Kl + (n * 16 + c16) * 272 + (kk * 4 + g) * 16);
      }
      __builtin_amdgcn_sched_barrier(0);
#pragma unroll
      for (int kk = 0; kk < 4; ++kk)
#pragma unroll
        for (int n = 0; n < 4; ++n) a4[n] = mfma16(af[kk], bfv[kk][n], a4[n]);
    }
    float* dst = which ? QKm : KK;
#pragma unroll
    for (int n = 0; n < 4; ++n)
#pragma unroll
      for (int j = 0; j < 4; ++j) dst[(mt * 16 + g * 4 + j) * 64 + n * 16 + c16] = a4[n][j];
  }
  __syncthreads();
  {
    const float* gc = gcs + dir * 64; const float* be = gcs + 128 + dir * 64;
    u16* qkout = (u16*)(opnd + dir * DNOP_BYTES + OP_QK);
#pragma unroll
    for (int e8 = 0; e8 < 8; ++e8) {
      const int e = t8 + 256 * e8;
      const int i = e >> 5, j = (e & 31) * 2;
      const int ri = dir ? 63 - i : i, rj = dir ? 63 - j : j, rj1 = dir ? 62 - j : j + 1;
      const float gi = gc[i];
      const float d0 = __expf(gi - gc[j]), d1 = __expf(gi - gc[j + 1]);
      const float bi = be[i];
      Am[(dir * 64 + i) * 64 + j] = (j < i) ? bi * KK[ri * 64 + rj] * d0 : 0.f;
      Am[(dir * 64 + i) * 64 + j + 1] = (j + 1 < i) ? bi * KK[ri * 64 + rj1] * d1 : 0.f;
      const float q0 = (j <= i) ? QKm[ri * 64 + rj] * d0 : 0.f, q1 = (j + 1 <= i) ? QKm[ri * 64 + rj1] * d1 : 0.f;
      *(unsigned*)(qkout + i * 64 + kperm(j)) = pk2(q0, q1);
    }
  }
  __syncthreads();
  {
    const bool isu = t8 < 128;
    const unsigned char* src = isu ? (Vl + t8 * 2) : (Kl + (t8 - 128) * 2);
    const int sstr = isu ? 256 : 272;
    const float* scl = gcs + (isu ? 128 : 256) + dir * 64;
    const float* Ad = Am + dir * 4096;
    float X[64];
    f32x4 av[2][16]; float rv[2];
    rv[0] = bf2f(*(const u16*)(src + (dir ? 63 : 0) * sstr)) * scl[0];
#pragma unroll
    for (int i = 0; i < 64; ++i) {
      if (i + 1 < 64) {
        const int rn = dir ? 62 - i : i + 1;
#pragma unroll
        for (int j4 = 0; j4 < (i + 4) / 4; ++j4) av[(i + 1) & 1][j4] = *(const f32x4*)(Ad + (i + 1) * 64 + j4 * 4);
        rv[(i + 1) & 1] = bf2f(*(const u16*)(src + rn * sstr)) * scl[i + 1];
      }
      __builtin_amdgcn_sched_barrier(0);
      float a = rv[i & 1], b = 0.f;
#pragma unroll
      for (int j4 = 0; j4 < (i + 3) / 4; ++j4) {
        if (4 * j4 + 0 < i) a -= av[i & 1][j4].x * X[4 * j4 + 0];
        if (4 * j4 + 1 < i) b -= av[i & 1][j4].y * X[4 * j4 + 1];
        if (4 * j4 + 2 < i) a -= av[i & 1][j4].z * X[4 * j4 + 2];
        if (4 * j4 + 3 < i) b -= av[i & 1][j4].w * X[4 * j4 + 3];
      }
      X[i] = a + b;
      __builtin_amdgcn_sched_barrier(0);
    }
    if (isu) {
      u32x4* dst = (u32x4*)(opnd + dir * DNOP_BYTES + OP_UT + t8 * 128);
#pragma unroll
      for (int q = 0; q < 8; ++q) { u32x4 o = {pk2(X[8 * q], X[8 * q + 1]), pk2(X[8 * q + 2], X[8 * q + 3]), pk2(X[8 * q + 4], X[8 * q + 5]), pk2(X[8 * q + 6], X[8 * q + 7])}; dst[q] = o; }
    } else {
      u16* xd = Xs + dir * 8192 + kperm(t8 - 128);
#pragma unroll
      for (int i = 0; i < 64; ++i) xd[i * 128] = f2bf(-X[i]);
    }
  }
  __syncthreads();
  {
#pragma unroll
    for (int e4 = 0; e4 < 4; ++e4) {
      const int e = tid + 512 * e4;
      const int dd = e >> 10, q = e & 1023;
      *(u32x4*)(opnd + dd * DNOP_BYTES + OP_WN + q * 16) = *(const u32x4*)((const unsigned char*)Xs + dd * 16384 + q * 16);
    }
#pragma unroll
    for (int e4 = 0; e4 < 4; ++e4) {
      const int e = tid + 512 * e4;
      const int dd = e >> 10, q = e & 1023, i = q >> 4, c8 = q & 15, ri = dd ? 63 - i : i;
      const float sc = __expf(gcs[dd * 64 + i]);
      const int kb = c8 >> 2, gg = c8 & 3;
      const u32x2 v0 = *(const u32x2*)(Ql + ri * 272 + (kb * 32 + gg * 4) * 2), v1 = *(const u32x2*)(Ql + ri * 272 + (kb * 32 + 16 + gg * 4) * 2);
      u32x4 o = {pk2(bflo(v0.x) * sc, bfhi(v0.x) * sc), pk2(bflo(v0.y) * sc, bfhi(v0.y) * sc), pk2(bflo(v1.x) * sc, bfhi(v1.x) * sc), pk2(bflo(v1.y) * sc, bfhi(v1.y) * sc)};
      *(u32x4*)(opnd + dd * DNOP_BYTES + OP_QD + q * 16) = o;
    }
    {
      const int dk = t8 & 127, half = t8 >> 7;
      const float gl = gcs[dir * 64 + 63];
      u32x4* dst = (u32x4*)(opnd + dir * DNOP_BYTES + OP_KDT + dk * 128 + half * 64);
#pragma unroll
      for (int q = 0; q < 4; ++q) {
        float v[8];
#pragma unroll
        for (int jj = 0; jj < 8; ++jj) {
          const int i = half * 32 + (jj >> 2) * 16 + q * 4 + (jj & 3), ri = dir ? 63 - i : i;
          v[jj] = bf2f(*(const u16*)(Kl + ri * 272 + dk * 2)) * __expf(gl - gcs[dir * 64 + i]);
        }
        u32x4 o = {pk2(v[0], v[1]), pk2(v[2], v[3]), pk2(v[4], v[5]), pk2(v[6], v[7])};
        dst[q] = o;
      }
      if (t8 == 0) ((float*)(ws + WS_EGL))[item * 2 + dir] = __expf(gl);
    }
  }
  __syncthreads();
}

constexpr int SCAN_BUF = 73728 + 256;
DI void glds4(const void* g, unsigned ldsoff) {
  __builtin_amdgcn_global_load_lds((const __attribute__((address_space(1))) void*)g, (LAS void*)(unsigned long)ldsoff, 4, 0, 0);
}
DI void scan_issue(const unsigned char* src, const float* egp, unsigned ldsbase, int tid) {
  if (tid < 256) {
#pragma unroll
    for (int i = 0; i < 18; ++i) {
      const int q = tid + 256 * i;
      int sq;
      if (i < 8) sq = (q & ~15) | ((q & 15) ^ ((q >> 4) & 15));
      else sq = (q & ~7) | ((q & 7) ^ ((q >> 4) & 7));
      glds16(src + sq * 16, ldsbase + q * 16);
    }
    if (tid < 64) glds4(egp, ldsbase + 73728 + tid * 4);
  }
}
#define SB_ __builtin_amdgcn_sched_barrier(0)
DI void scan_compute(const unsigned char* B, int chk, int dir, int hd, u16* obuf, f32x4 (&S)[8], int w, int c16, int g) {
  const float eg = *(const float*)(B + 73728);
  const int x15 = c16, x7 = (c16 >> 1) & 7;
  bf16x8 sb[4];
#pragma unroll
  for (int kb = 0; kb < 4; ++kb) {
    u32x4 u = {pk2(S[2 * kb].x, S[2 * kb].y), pk2(S[2 * kb].z, S[2 * kb].w), pk2(S[2 * kb + 1].x, S[2 * kb + 1].y), pk2(S[2 * kb + 1].z, S[2 * kb + 1].w)};
    sb[kb] = __builtin_bit_cast(bf16x8, u);
  }
  f32x4 va[4], oa[4];
#pragma unroll
  for (int mt = 0; mt < 4; ++mt) {
    const u32x2 uu = *(const u32x2*)(B + 57344 + (16 * w + c16) * 128 + (((mt * 2 + (g >> 1)) ^ x7) << 4) + (g & 1) * 8);
    va[mt] = (f32x4){bflo(uu.x), bfhi(uu.x), bflo(uu.y), bfhi(uu.y)};
    oa[mt] = (f32x4){0.f, 0.f, 0.f, 0.f};
  }
  const unsigned char* wrow = B + c16 * 256;
  bf16x8 f0[8], f1[8];
#define LDWQ_(dst, kb) _Pragma("unroll") for (int mt = 0; mt < 4; ++mt) { const unsigned char* ap = wrow + mt * 4096 + ((((kb) * 4 + g) ^ x15) << 4); dst[mt] = *(const bf16x8*)ap; dst[4 + mt] = *(const bf16x8*)(ap + 16384); }
#define MMWQ_(src, kb) _Pragma("unroll") for (int mt = 0; mt < 4; ++mt) { va[mt] = mfma16(src[mt], sb[kb], va[mt]); oa[mt] = mfma16(sb[kb], src[4 + mt], oa[mt]); }
  LDWQ_(f0, 0); LDWQ_(f1, 1); SB_;
  MMWQ_(f0, 0); SB_;
  LDWQ_(f0, 2); SB_;
  MMWQ_(f1, 1); SB_;
  LDWQ_(f1, 3); SB_;
  MMWQ_(f0, 2); SB_;
  {
    const unsigned char* qrow = B + 32768 + c16 * 128;
#pragma unroll
    for (int mt = 0; mt < 4; ++mt)
#pragma unroll
      for (int cb = 0; cb < 2; ++cb) f0[mt * 2 + cb] = *(const bf16x8*)(qrow + mt * 2048 + (((cb * 4 + g) ^ x7) << 4));
  }
  SB_;
  MMWQ_(f1, 3); SB_;
#undef LDWQ_
#undef MMWQ_
  bf16x8 vb[2];
#pragma unroll
  for (int cb = 0; cb < 2; ++cb) {
    u32x4 u = {pk2(va[2 * cb].x, va[2 * cb].y), pk2(va[2 * cb].z, va[2 * cb].w), pk2(va[2 * cb + 1].x, va[2 * cb + 1].y), pk2(va[2 * cb + 1].z, va[2 * cb + 1].w)};
    vb[cb] = __builtin_bit_cast(bf16x8, u);
  }
  const unsigned char* krow = B + 40960 + c16 * 128;
#define LDKD_(dst, t0) _Pragma("unroll") for (int t = 0; t < 4; ++t) _Pragma("unroll") for (int cb = 0; cb < 2; ++cb) dst[t * 2 + cb] = *(const bf16x8*)(krow + ((t0) + t) * 2048 + (((cb * 4 + g) ^ x7) << 4));
  LDKD_(f1, 0); SB_;
#pragma unroll
  for (int mt = 0; mt < 4; ++mt)
#pragma unroll
    for (int cb = 0; cb < 2; ++cb) oa[mt] = mfma16(vb[cb], f0[mt * 2 + cb], oa[mt]);
  SB_;
  LDKD_(f0, 4); SB_;
#pragma unroll
  for (int t = 0; t < 4; ++t) {
    f32x4 s = {S[t].x * eg, S[t].y * eg, S[t].z * eg, S[t].w * eg};
#pragma unroll
    for (int cb = 0; cb < 2; ++cb) s = mfma16(f1[t * 2 + cb], vb[cb], s);
    S[t] = s;
  }
  SB_;
#pragma unroll
  for (int t = 0; t < 4; ++t) {
    f32x4 s = {S[4 + t].x * eg, S[4 + t].y * eg, S[4 + t].z * eg, S[4 + t].w * eg};
#pragma unroll
    for (int cb = 0; cb < 2; ++cb) s = mfma16(f0[t * 2 + cb], vb[cb], s);
    S[4 + t] = s;
  }
#undef LDKD_
#pragma unroll
  for (int mt = 0; mt < 4; ++mt) {
    const int i = mt * 16 + c16;
    const long tok = (long)chk * 64 + (dir ? 63 - i : i);
    u32x2 ov = {pk2(oa[mt].x, oa[mt].y), pk2(oa[mt].z, oa[mt].w)};
    *(u32x2*)(obuf + tok * 512 + hd * 128 + 16 * w + g * 4) = ov;
  }
}
#undef SB_

DI void scan_chain(int grp, unsigned char* ws, unsigned char* smem, int chain) {
  const int tidx = opaque_tid();
  const int L = (grp == 0) ? 16384 : 2048, nc = L >> 6;
  const int dir = chain & 1, hd = (chain >> 1) & 3, sq = chain >> 3;
  const int tid = tidx, lane = tid & 63, w = tid >> 6, c16 = lane & 15, g = lane >> 4;
  const int chunk0 = sq * nc;
  const float* egl = (const float*)(ws + WS_EGL);
  u16* obuf = (u16*)(ws + WS_OF) + (long)dir * TG * 512;
  f32x4 S[8];
#pragma unroll
  for (int t = 0; t < 8; ++t) S[t] = (f32x4){0.f, 0.f, 0.f, 0.f};
  __syncthreads();
  {
    const int chk = chunk0 + (dir ? nc - 1 : 0);
    const long it = (long)(chk * 4 + hd) * 2 + dir;
    scan_issue(ws + WS_DNOP + it * DNOP_BYTES, egl + it, 0u, tid);
  }
  __syncthreads();
  for (int m = 0; m < nc; ++m) {
    const int chk = chunk0 + (dir ? nc - 1 - m : m);
    if (m + 1 < nc) {
      const int chn = chunk0 + (dir ? nc - 2 - m : m + 1);
      const long it = (long)(chn * 4 + hd) * 2 + dir;
      scan_issue(ws + WS_DNOP + it * DNOP_BYTES, egl + it, (unsigned)(((m + 1) & 1) * SCAN_BUF), tid);
    }
    scan_compute(smem + (m & 1) * SCAN_BUF, chk, dir, hd, obuf, S, w, c16, g);
    __syncthreads();
  }
}

DI void phase_merge(const Params& p, unsigned char* ws, const u16* proj) {
  const int tidx = opaque_tid();
  const int lane = tidx & 63;
  const int gw = blockIdx.x * 8 + (tidx >> 6), NW = gridDim.x * 8;
  const u16* attp = (const u16*)(ws + WS_ATTP); const float* lse = (const float*)(ws + WS_LSE);
  const u16* of = (const u16*)(ws + WS_OF);
  u16* mix = (u16*)(ws + WS_NBUF);
  f32x4 gn0 = *(const f32x4*)(p.out_norm + (lane & 15) * 8), gn1 = *(const f32x4*)(p.out_norm + (lane & 15) * 8 + 4);
  for (int t0 = gw; t0 < TG; t0 += 4 * NW) {
    float l0[4], l1[4], l2[4]; u32x4 pa[4], pb[4], pc[4], fa[4], fb[4], gg[4];
    const int h = lane >> 3;
#pragma unroll
    for (int k = 0; k < 4; ++k) {
      const long tt = t0 + (long)k * NW, t = tt < TG ? tt : TG - 1;
      l0[k] = lse[((long)0 * TG + t) * 8 + h]; l1[k] = lse[((long)1 * TG + t) * 8 + h]; l2[k] = lse[((long)2 * TG + t) * 8 + h];
      pa[k] = *(const u32x4*)(attp + ((long)0 * TG + t) * 512 + lane * 8);
      pb[k] = *(const u32x4*)(attp + ((long)1 * TG + t) * 512 + lane * 8);
      pc[k] = *(const u32x4*)(attp + ((long)2 * TG + t) * 512 + lane * 8);
      fa[k] = *(const u32x4*)(of + t * 512 + lane * 8);
      fb[k] = *(const u32x4*)(of + ((long)TG + t) * 512 + lane * 8);
      gg[k] = *(const u32x4*)(proj + t * NPROJ + 3072 + lane * 8);
    }
#pragma unroll
    for (int k = 0; k < 4; ++k) {
      const long t = t0 + (long)k * NW;
      if (t >= TG) break;
      {
        const float mx = fmaxf(l0[k], fmaxf(l1[k], l2[k]));
        float w0 = __expf(l0[k] - mx), w1 = __expf(l1[k] - mx), w2 = __expf(l2[k] - mx);
        const float inv = __builtin_amdgcn_rcpf(w0 + w1 + w2); w0 *= inv; w1 *= inv; w2 *= inv;
        const u32x4 a = pa[k], b = pb[k], c = pc[k];
        u32x4 o;
        o.x = pk2(w0 * bflo(a.x) + w1 * bflo(b.x) + w2 * bflo(c.x), w0 * bfhi(a.x) + w1 * bfhi(b.x) + w2 * bfhi(c.x));
        o.y = pk2(w0 * bflo(a.y) + w1 * bflo(b.y) + w2 * bflo(c.y), w0 * bfhi(a.y) + w1 * bfhi(b.y) + w2 * bfhi(c.y));
        o.z = pk2(w0 * bflo(a.z) + w1 * bflo(b.z) + w2 * bflo(c.z), w0 * bfhi(a.z) + w1 * bfhi(b.z) + w2 * bfhi(c.z));
        o.w = pk2(w0 * bflo(a.w) + w1 * bflo(b.w) + w2 * bflo(c.w), w0 * bfhi(a.w) + w1 * bfhi(b.w) + w2 * bfhi(c.w));
        *(u32x4*)(mix + t * 1024 + lane * 8) = o;
      }
      {
        const u32x4 a = fa[k], b = fb[k], g4 = gg[k];
        float o[8] = {bflo(a.x) + bflo(b.x), bfhi(a.x) + bfhi(b.x), bflo(a.y) + bflo(b.y), bfhi(a.y) + bfhi(b.y),
                      bflo(a.z) + bflo(b.z), bfhi(a.z) + bfhi(b.z), bflo(a.w) + bflo(b.w), bfhi(a.w) + bfhi(b.w)};
        float ss = 0.f;
#pragma unroll
        for (int i = 0; i < 8; ++i) ss += o[i] * o[i];
        ss = sum16(ss);
        const float rs = __builtin_amdgcn_rsqf(ss * (1.f / 128.f) + 1e-6f);
        const float gv[8] = {bflo(g4.x), bfhi(g4.x), bflo(g4.y), bfhi(g4.y), bflo(g4.z), bfhi(g4.z), bflo(g4.w), bfhi(g4.w)};
        const float gn[8] = {gn0.x, gn0.y, gn0.z, gn0.w, gn1.x, gn1.y, gn1.z, gn1.w};
        float y[8];
#pragma unroll
        for (int i = 0; i < 8; ++i) y[i] = o[i] * rs * gn[i] * siluf_(gv[i]);
        u32x4 ov = {pk2(y[0], y[1]), pk2(y[2], y[3]), pk2(y[4], y[5]), pk2(y[6], y[7])};
        *(u32x4*)(mix + t * 1024 + 512 + lane * 8) = ov;
      }
    }
  }
}

namespace pg8 {
#define PG8_LAS LAS
constexpr int BM = 256, BK = 64, HALF = 128, HTB = HALF * BK * 2;
DI int lds_byte(int r, int c) { const int st = (r >> 4) * 2 + (c >> 5), rr = r & 15, cc = c & 31, ob = rr * 64 + cc * 2; return st * 1024 + (ob ^ (((ob >> 9) & 1) << 5)); }
DI void stage_rc(int b, int& R, int& C) { const int st = b / 1024, sb = b % 1024, swz = sb ^ (((sb >> 9) & 1) << 5); R = (st >> 1) * 16 + swz / 64; C = (st & 1) * 32 + (swz % 64) / 2; }
DI int perm32(int rho) { const int n = rho >> 4, i = rho & 15; return 8 * (i >> 2) + 4 * n + (i & 3); }
struct Unit { int pm, pn; };
struct Gemm8 { const u16* A; const u16* Bt; int K; };
struct TileOrder {
  int nM, nN, ntiles, G, bperm;
  DI bool next(int i, Unit& u) const {
    const int T = i * G + bperm; if (T >= ntiles) return false;
    const int sg = T / (8 * nN), fm = sg * 8, gsz = (nM - fm) < 8 ? (nM - fm) : 8, idx = T - sg * 8 * nN;
    u.pm = fm + (idx % gsz); u.pn = idx / gsz; return true;
  }
  DI void a_ready(const Unit&) const {}
  DI void done(const Unit&) const {}
};
struct EpiProj {
  static constexpr bool PERM = true, AFTER_DRAIN = false;
  u16* proj;
  DI void operator()(const f32x4 (&acc)[2][2][4][2], const Unit& u, int wr, int wc, int fr, int fq) const {
    const int row0 = u.pm * BM + wr * 64 + fr, col0 = u.pn * BM + wc * 32 + 8 * fq;
#pragma unroll
    for (int ai = 0; ai < 2; ++ai)
#pragma unroll
      for (int m = 0; m < 4; ++m) {
        u16* rowp = proj + (size_t)(row0 + ai * HALF + m * 16) * NPROJ + col0;
#pragma unroll
        for (int bj = 0; bj < 2; ++bj) {
          const f32x4 a0 = acc[ai][bj][m][0], a1 = acc[ai][bj][m][1];
          u32x4 o = {pk2(a0.x, a0.y), pk2(a0.z, a0.w), pk2(a1.x, a1.y), pk2(a1.z, a1.w)};
          *(u32x4*)(rowp + bj * HALF) = o;
        }
      }
  }
};
struct EpiH {
  static constexpr bool PERM = true, AFTER_DRAIN = false;
  const float* xg; float* outg; u16* hb; float* rowsq;
  DI void operator()(const f32x4 (&acc)[2][2][4][2], const Unit& u, int wr, int wc, int fr, int fq) const {
    const int row0 = u.pm * BM + wr * 64 + fr, col0 = u.pn * BM + wc * 32 + 8 * fq;
#pragma unroll
    for (int ai = 0; ai < 2; ++ai) {
      f32x4 xv[4][2][2];
#pragma unroll
      for (int m = 0; m < 4; ++m)
#pragma unroll
        for (int bj = 0; bj < 2; ++bj)
#pragma unroll
          for (int n = 0; n < 2; ++n) xv[m][bj][n] = *(const f32x4*)(xg + (size_t)(row0 + ai * HALF + m * 16) * 1024 + col0 + bj * HALF + n * 4);
#pragma unroll
      for (int m = 0; m < 4; ++m) {
        const size_t row = (size_t)(row0 + ai * HALF + m * 16);
        float s = 0.f;
#pragma unroll
        for (int bj = 0; bj < 2; ++bj) {
          const f32x4 h0 = xv[m][bj][0] + acc[ai][bj][m][0], h1 = xv[m][bj][1] + acc[ai][bj][m][1];
          u32x4 o = {pk2(h0.x, h0.y), pk2(h0.z, h0.w), pk2(h1.x, h1.y), pk2(h1.z, h1.w)};
          *(u32x4*)(hb + row * 1024 + col0 + bj * HALF) = o;
          s += h0.x * h0.x + h0.y * h0.y + h0.z * h0.z + h0.w * h0.w + h1.x * h1.x + h1.y * h1.y + h1.z * h1.z + h1.w * h1.w;
        }
        s += __shfl_xor(s, 16); s += __shfl_xor(s, 32);
        if (fq == 0) rowsq[row * 16 + u.pn * 4 + wc] = s;
      }
    }
  }
};
struct EpiOut {
  static constexpr bool PERM = true, AFTER_DRAIN = false;
  float* outg; const u16* hb;
  DI void operator()(const f32x4 (&acc)[2][2][4][2], const Unit& u, int wr, int wc, int fr, int fq) const {
    const int row0 = u.pm * BM + wr * 64 + fr, col0 = u.pn * BM + wc * 32 + 8 * fq;
#pragma unroll
    for (int ai = 0; ai < 2; ++ai) {
      u32x4 hv[4][2];
#pragma unroll
      for (int m = 0; m < 4; ++m)
#pragma unroll
        for (int bj = 0; bj < 2; ++bj) hv[m][bj] = *(const u32x4*)(hb + (size_t)(row0 + ai * HALF + m * 16) * 1024 + col0 + bj * HALF);
#pragma unroll
      for (int m = 0; m < 4; ++m) {
        float* rowp = outg + (size_t)(row0 + ai * HALF + m * 16) * 1024 + col0;
#pragma unroll
        for (int bj = 0; bj < 2; ++bj) {
          const u32x4 v = hv[m][bj];
          f32x4 h0 = {bflo(v.x), bfhi(v.x), bflo(v.y), bfhi(v.y)}, h1 = {bflo(v.z), bfhi(v.z), bflo(v.w), bfhi(v.w)};
          h0 = h0 + acc[ai][bj][m][0]; h1 = h1 + acc[ai][bj][m][1];
          *(f32x4*)(rowp + bj * HALF) = h0; *(f32x4*)(rowp + bj * HALF + 4) = h1;
        }
      }
    }
  }
};
struct OneUnit {
  Unit u;
  DI bool next(int i, Unit& o) const { if (i != 0) return false; o = u; return true; }
  DI void a_ready(const Unit&) const {}
  DI void done(const Unit&) const {}
};
struct EpiGlu {
  static constexpr bool PERM = true, AFTER_DRAIN = true;
  const float* cw; const float* cb; const float* rowsq; u16* act; int pm, pn, L;
  DI void operator()(const f32x4 (&)[2][2][4][2], const Unit&, int, int, int, int) const {}
  DI void fused(const f32x4 (&acc)[2][2][4][2], const Unit&, int wr, int wc, int fr, int fq, PG8_LAS unsigned char* lds, int wid, int lane) const {
    const int rowbase = pm * 254 - 1;
#pragma unroll
    for (int ai = 0; ai < 2; ++ai) {
      f32x4 rq[4][4];
#pragma unroll
      for (int m = 0; m < 4; ++m) {
        const int rl = ai * HALF + wr * 64 + m * 16 + fr;
        int ar = rowbase + rl; ar = ar < 0 ? 0 : (ar > TG - 1 ? TG - 1 : ar);
        const f32x4* rp = (const f32x4*)(rowsq + (long)ar * 16);
#pragma unroll
        for (int q = 0; q < 4; ++q) rq[m][q] = rp[q];
      }
#pragma unroll
      for (int m = 0; m < 4; ++m) {
        const int rl = ai * HALF + wr * 64 + m * 16 + fr;
        const f32x4 q0 = rq[m][0], q1 = rq[m][1], q2 = rq[m][2], q3 = rq[m][3];
        const float ssq = (q0.x + q0.y + q0.z + q0.w) + (q1.x + q1.y + q1.z + q1.w) + (q2.x + q2.y + q2.z + q2.w) + (q3.x + q3.y + q3.z + q3.w);
        const float rs2 = __builtin_amdgcn_rsqf(ssq * (1.f / 1024.f) + 1e-6f);
#pragma unroll
        for (int bj = 0; bj < 2; ++bj)
#pragma unroll
          for (int n = 0; n < 2; ++n) {
            const int col = bj * HALF + wc * 32 + 8 * fq + 4 * n;
            const f32x4 a = acc[ai][bj][m][n];
            u32x2 o = {pk2(a.x * rs2, a.y * rs2), pk2(a.z * rs2, a.w * rs2)};
            *(PG8_LAS u32x2*)(lds + rl * 520 + col * 2) = o;
          }
      }
    }
    __syncthreads();
    {
      const int hp = lane, rg = wid;
      const int hid = pn * 128 + 2 * hp;
      float cwg[3][2], cwu[3][2], cbg[2], cbu[2];
#pragma unroll
      for (int j = 0; j < 3; ++j) {
        cwg[j][0] = cw[j * 5632 + hid]; cwg[j][1] = cw[j * 5632 + hid + 1];
        cwu[j][0] = cw[j * 5632 + 2816 + hid]; cwu[j][1] = cw[j * 5632 + 2816 + hid + 1];
      }
      cbg[0] = cb[hid]; cbg[1] = cb[hid + 1]; cbu[0] = cb[2816 + hid]; cbu[1] = cb[2816 + hid + 1];
      unsigned gk[34], uk[34];
#pragma unroll
      for (int k = 0; k < 34; ++k) {
        int r = rg * 32 - 1 + k; r = r < 0 ? 0 : (r > 255 ? 255 : r);
        gk[k] = *(const PG8_LAS unsigned*)(lds + r * 520 + hp * 4); uk[k] = *(const PG8_LAS unsigned*)(lds + r * 520 + 256 + hp * 4);
      }
#pragma unroll
      for (int kk = 0; kk < 32; ++kk) {
        const int i = rg * 32 + kk;
        const int lt = rowbase + i;
        if (i >= 1 && i <= 254 && lt < TG) {
          const unsigned gp = gk[kk], gc = gk[kk + 1], gn = gk[kk + 2], up = uk[kk], uc = uk[kk + 1], un = uk[kk + 2];
          const int pos = lt & (L - 1);
          float gp0 = bflo(gp), gp1 = bfhi(gp), up0 = bflo(up), up1 = bfhi(up), gn0 = bflo(gn), gn1 = bfhi(gn), un0 = bflo(un), un1 = bfhi(un);
          if (pos == 0) { gp0 = 0.f; gp1 = 0.f; up0 = 0.f; up1 = 0.f; }
          if (pos == L - 1) { gn0 = 0.f; gn1 = 0.f; un0 = 0.f; un1 = 0.f; }
          const float G0 = cwg[0][0] * gp0 + cwg[1][0] * bflo(gc) + cwg[2][0] * gn0 + cbg[0];
          const float G1 = cwg[0][1] * gp1 + cwg[1][1] * bfhi(gc) + cwg[2][1] * gn1 + cbg[1];
          const float U0 = cwu[0][0] * up0 + cwu[1][0] * bflo(uc) + cwu[2][0] * un0 + cbu[0];
          const float U1 = cwu[0][1] * up1 + cwu[1][1] * bfhi(uc) + cwu[2][1] * un1 + cbu[1];
          *(unsigned*)(act + (long)lt * 2816 + hid) = pk2(siluf_(G0) * U0, siluf_(G1) * U1);
        }
      }
    }
    __syncthreads();
  }
};
template <class Epi, class Sched>
__device__ __forceinline__ void gemm8_phase(PG8_LAS unsigned char* lds, const Gemm8 g, const Sched& S, const Epi& E) {
    constexpr bool STAMP = false; unsigned long long* stamps = nullptr;
    const int tid = opaque_tid(), wid = __builtin_amdgcn_readfirstlane(tid >> 6), lane = tid & 63, wr = wid >> 2, wc = wid & 3, fr = lane & 15, fq = lane >> 4;
    const int K = g.K, nt = K / BK;
    int ts_lo = 0, ts_hi = 0, nts = 0; const unsigned long long rt_entry = 0ull;
#define PG8_STAMP() do { if (STAMP && wid == 0 && nts < 64) { const unsigned long long _c = 0ull; \
        ts_lo = (lane == nts) ? (int)(unsigned)_c : ts_lo; ts_hi = (lane == nts) ? (int)(unsigned)(_c >> 32) : ts_hi; ++nts; } } while (0)
    PG8_STAMP();
    unsigned voffA[2], voffB[2];
#pragma unroll
    for (int i = 0; i < 2; ++i) { int R, C; stage_rc(tid * 16 + i * 8192, R, C); const int Rb = Epi::PERM ? ((R & ~31) + perm32(R & 31)) : R;
        voffA[i] = (unsigned)(R * K + C) * 2u; voffB[i] = (unsigned)(Rb * K + C) * 2u; }
    const size_t kstep = (size_t)(BK * 2);
    const size_t hstep = (size_t)HALF * K * 2;
    const size_t tstep = 2 * hstep;
    const unsigned ldsw = (unsigned)wid * 1024u;
    const int aoff = lds_byte(wr * 64 + fr, fq * 8), boff = lds_byte(wc * 32 + fr, fq * 8);
#define PG8_SA(b, h) (((b) * 2 + (h)) * HTB)
#define PG8_SB(b, h) ((4 + (b) * 2 + (h)) * HTB)
#define PG8_STAGE(bufoff, gbase, voff) do { _Pragma("unroll") for (int _i = 0; _i < 2; ++_i) \
        __builtin_amdgcn_global_load_lds((const unsigned*)((const char*)(gbase) + (voff)[_i]), (PG8_LAS unsigned*)(lds + (bufoff) + ldsw + _i * 8192), 16, 0, 0); } while (0)
#define PG8_LDA(dst, b, h) do { _Pragma("unroll") for (int m = 0; m < 4; ++m) _Pragma("unroll") for (int k = 0; k < 2; ++k) dst[m][k] = *(const PG8_LAS bf16x8*)(lds + PG8_SA(b, h) + aoff + m * 2048 + k * 1024); } while (0)
#define PG8_LDB(dst, b, h) do { _Pragma("unroll") for (int n = 0; n < 2; ++n) _Pragma("unroll") for (int k = 0; k < 2; ++k) dst[n][k] = *(const PG8_LAS bf16x8*)(lds + PG8_SB(b, h) + boff + n * 2048 + k * 1024); } while (0)
#define PG8_MMA(ai, bj, At, Bt) do { __builtin_amdgcn_s_setprio(1); _Pragma("unroll") for (int m = 0; m < 4; ++m) _Pragma("unroll") for (int n = 0; n < 2; ++n) _Pragma("unroll") for (int k = 0; k < 2; ++k) \
        acc[ai][bj][m][n] = __builtin_amdgcn_mfma_f32_16x16x32_bf16(Bt[n][k], At[m][k], acc[ai][bj][m][n], 0, 0, 0); __builtin_amdgcn_s_setprio(0); } while (0)
#define PG8_WAIT_V(n) asm volatile("s_waitcnt vmcnt(" #n ")" ::: "memory")
#define PG8_WAIT_L(n) asm volatile("s_waitcnt lgkmcnt(" #n ")" ::: "memory")
#define PG8_BAR __builtin_amdgcn_s_barrier()
#define PG8_SCHED __builtin_amdgcn_sched_barrier(0)
    Unit cur, nxt; int ui = 0;
    if (!S.next(0, cur)) return;
    f32x4 acc[2][2][4][2];
#pragma unroll
    for (int a = 0; a < 2; ++a)
#pragma unroll
        for (int b = 0; b < 2; ++b)
#pragma unroll
            for (int m = 0; m < 4; ++m)
#pragma unroll
                for (int n = 0; n < 2; ++n) acc[a][b][m][n] = (f32x4){0.f, 0.f, 0.f, 0.f};
    bf16x8 At[4][2], B0[2][2], B1[2][2];
    const char* cA = (const char*)g.A + (size_t)cur.pm * tstep; const char* cB = (const char*)g.Bt + (size_t)cur.pn * tstep;
    S.a_ready(cur);
    PG8_STAGE(PG8_SB(0, 0), cB, voffB); PG8_STAGE(PG8_SA(0, 0), cA, voffA); PG8_STAGE(PG8_SB(0, 1), cB + hstep, voffB); PG8_STAGE(PG8_SA(0, 1), cA + hstep, voffA);
    if (wr == 1) PG8_BAR;
    PG8_WAIT_V(4); PG8_BAR;
    PG8_STAGE(PG8_SB(1, 0), cB + kstep, voffB); PG8_STAGE(PG8_SA(1, 0), cA + kstep, voffA); PG8_STAGE(PG8_SB(1, 1), cB + hstep + kstep, voffB);
    PG8_WAIT_V(6); PG8_BAR;
    PG8_STAMP();
    for (;;) {
        const bool has_next = S.next(ui + 1, nxt);
        const char* nA = has_next ? (const char*)g.A + (size_t)nxt.pm * tstep : cA; const char* nB = has_next ? (const char*)g.Bt + (size_t)nxt.pn * tstep : cB;
        for (int t = 0; t < nt; t += 2) {
            const bool last = (t == nt - 2);
            const char* a1 = cA + (size_t)(t + 1) * kstep;
            const char* a2 = last ? nA : cA + (size_t)(t + 2) * kstep; const char* b2 = last ? nB : cB + (size_t)(t + 2) * kstep;
            const char* a3 = a2 + kstep; const char* b3 = b2 + kstep;
            if (last && has_next) S.a_ready(nxt);
            PG8_LDB(B0, 0, 0); PG8_SCHED; PG8_LDA(At, 0, 0); PG8_STAGE(PG8_SA(1, 1), a1 + hstep, voffA);
            PG8_WAIT_L(8); PG8_BAR; PG8_WAIT_L(0); PG8_MMA(0, 0, At, B0); PG8_BAR; PG8_SCHED;
            PG8_LDB(B1, 0, 1); PG8_STAGE(PG8_SB(0, 0), b2, voffB);
            PG8_BAR; PG8_WAIT_L(0); PG8_MMA(0, 1, At, B1); PG8_BAR;
            PG8_LDA(At, 0, 1); PG8_STAGE(PG8_SA(0, 0), a2, voffA);
            PG8_BAR; PG8_WAIT_L(0); PG8_MMA(1, 0, At, B0); PG8_BAR; PG8_SCHED;
            PG8_STAGE(PG8_SB(0, 1), b2 + hstep, voffB);
            PG8_WAIT_V(6); PG8_BAR; PG8_MMA(1, 1, At, B1); PG8_BAR;
            PG8_LDB(B0, 1, 0); PG8_SCHED; PG8_LDA(At, 1, 0); PG8_STAGE(PG8_SA(0, 1), a2 + hstep, voffA);
            PG8_WAIT_L(8); PG8_BAR; PG8_WAIT_L(0); PG8_MMA(0, 0, At, B0); PG8_BAR; PG8_SCHED;
            PG8_LDB(B1, 1, 1); PG8_STAGE(PG8_SB(1, 0), b3, voffB);
            PG8_BAR; PG8_WAIT_L(0); PG8_MMA(0, 1, At, B1); PG8_BAR;
            PG8_LDA(At, 1, 1); PG8_STAGE(PG8_SA(1, 0), a3, voffA);
            PG8_BAR; PG8_WAIT_L(0); PG8_MMA(1, 0, At, B0); PG8_BAR; PG8_SCHED;
            PG8_STAGE(PG8_SB(1, 1), b3 + hstep, voffB);
            PG8_WAIT_V(6); PG8_BAR; PG8_MMA(1, 1, At, B1); PG8_BAR;
        }
        PG8_STAMP();
        if constexpr (!Epi::AFTER_DRAIN) { E(acc, cur, wr, wc, fr, fq); S.done(cur); }
        PG8_STAMP();
        if (!has_next) break;
#pragma unroll
        for (int a = 0; a < 2; ++a)
#pragma unroll
            for (int b = 0; b < 2; ++b)
#pragma unroll
                for (int m = 0; m < 4; ++m)
#pragma unroll
                    for (int n = 0; n < 2; ++n) acc[a][b][m][n] = (f32x4){0.f, 0.f, 0.f, 0.f};
        cur = nxt; cA = nA; cB = nB; ++ui;
    }
    PG8_WAIT_V(0);
    if (wr == 0) PG8_BAR;
    PG8_BAR;
    if constexpr (Epi::AFTER_DRAIN) { E.fused(acc, cur, wr, wc, fr, fq, lds, wid, lane); S.done(cur); }
    PG8_STAMP();
    if (false) { stamps[lane] = lane < nts ? (((unsigned long long)(unsigned)ts_hi << 32) | (unsigned)ts_lo) : 0ull;
        if (lane == 62) stamps[62] = rt_entry; if (lane == 63) stamps[63] = 0ull; }
#undef PG8_STAMP
#undef PG8_SA
#undef PG8_SB
#undef PG8_STAGE
#undef PG8_LDA
#undef PG8_LDB
#undef PG8_MMA
#undef PG8_WAIT_V
#undef PG8_WAIT_L
#undef PG8_BAR
#undef PG8_SCHED
}
}

template <int MODE>
DI void gemm8_run(int grp, unsigned char* ws, const float* __restrict__ xg, float* __restrict__ outg, int bperm, int G, u16* projdst) {
  pg8::Gemm8 g; pg8::TileOrder S;
  S.G = G; S.bperm = bperm;
  S.nM = TG / 256;
  if (MODE == 1) { g.A = (const u16*)(ws + WS_NBUF2); g.Bt = (const u16*)(ws + WS_WIN); g.K = 1024; S.nN = NPROJ / 256; }
  else if (MODE == 2) { g.A = (const u16*)(ws + WS_NBUF); g.Bt = (const u16*)(ws + WS_WOUT); g.K = 1024; S.nN = 4; }
  else { g.A = (const u16*)(ws + WS_ACT); g.Bt = (const u16*)(ws + WS_WDOWN); g.K = 2816; S.nN = 4; }
  S.ntiles = S.nM * S.nN;
  __syncthreads();
  if (MODE == 1) { pg8::EpiProj E{projdst}; pg8::gemm8_phase((LAS unsigned char*)0, g, S, E); }
  else if (MODE == 2) { pg8::EpiH E{xg, outg, (u16*)(ws + WS_HB), (float*)(ws + WS_ROWSQ)}; pg8::gemm8_phase((LAS unsigned char*)0, g, S, E); }
  else { pg8::EpiOut E{outg, (const u16*)(ws + WS_HB)}; pg8::gemm8_phase((LAS unsigned char*)0, g, S, E); }
  __syncthreads();
}


DI void gemm8_glu(const Params& p, int grp, unsigned char* ws, int bperm) {
  const int L = (grp == 0) ? 16384 : 2048;
  const int nM = (TG + 253) / 254, nN = 22, ntiles = nM * nN, G = gridDim.x;
  __syncthreads();
  for (int T = bperm; T < ntiles; T += G) {
    const int sg = T / (8 * nN), fm = sg * 8, gsz = (nM - fm) < 8 ? (nM - fm) : 8, idx = T - sg * 8 * nN;
    const int pm = fm + (idx % gsz), pn = idx / gsz;
    pg8::Gemm8 g; g.A = (const u16*)(ws + WS_HB) + (long)(pm * 254 - 1) * 1024; g.Bt = (const u16*)(ws + WS_WUP); g.K = 1024;
    pg8::OneUnit S; S.u.pm = 0; S.u.pn = pn;
    pg8::EpiGlu E{p.ffn_cw, p.ffn_cb, (const float*)(ws + WS_ROWSQ), (u16*)(ws + WS_ACT), pm, pn, L};
    pg8::gemm8_phase((LAS unsigned char*)0, g, S, E);
  }
}

#define XB_TMO      128
#define XB_XCNT(j)  (256  + 64 * (j))
#define XB_XSUB(j)  (1280 + 64 * (j))
#define XB_XGEN(j)  (2304 + 64 * (j))
#define XB_TOP      3328
#define XB_TOPGEN   3392
#define XCD_BAR_WORDS 3456
#define XB_SPIN_CAP (1u << 18)
DI unsigned xb_ld(unsigned* p)              { return __hip_atomic_load(p, __ATOMIC_RELAXED, __HIP_MEMORY_SCOPE_AGENT); }
DI unsigned xb_add(unsigned* p, unsigned v) { return __hip_atomic_fetch_add(p, v, __ATOMIC_RELAXED, __HIP_MEMORY_SCOPE_AGENT); }
DI unsigned xb_xcc_id() { return (unsigned)__builtin_amdgcn_s_getreg((3 << 11) | 20) & 0xFu; }
#define XB_SPIN(cond, bar) do { unsigned _sp = 0; while (cond) { __builtin_amdgcn_s_sleep(1); \
    if ((++_sp & 255u) == 0u) { if (xb_ld(&(bar)[XB_TMO])) break; if (_sp > XB_SPIN_CAP) { atomicAdd(&(bar)[XB_TMO], 1u); break; } } } } while (0)
struct XcdBarrier { unsigned* bar; unsigned x; volatile LAS unsigned* st; };
DI XcdBarrier xcd_barrier_post(unsigned* bar, volatile LAS unsigned* st) {
  XcdBarrier b; b.bar = bar; b.x = xb_xcc_id(); b.st = st;
  if (opaque_tid() == 0) (void)xb_add(&bar[XB_XCNT(b.x)], 1u);
  return b;
}
DI void xcd_barrier_complete(unsigned* bar, unsigned x, unsigned& nloc, unsigned& nx) {
  const unsigned G = gridDim.x * gridDim.y * gridDim.z;
  unsigned sum, cnt, mine, sp = 0u;
  for (;;) {
    sum = 0u; cnt = 0u; mine = 0u;
#pragma unroll
    for (unsigned j = 0; j < 16; ++j) { const unsigned c = xb_ld(&bar[XB_XCNT(j)]); sum += c; cnt += (c > 0u) ? 1u : 0u; mine = (j == x) ? c : mine; }
    if (sum == G) break;
    __builtin_amdgcn_s_sleep(1);
    if ((++sp & 255u) == 0u) { if (xb_ld(&bar[XB_TMO])) break; if (sp > XB_SPIN_CAP) { atomicAdd(&bar[XB_TMO], 1u); break; } }
  }
  nloc = mine > 0u ? mine : 1u; nx = cnt > 0u ? cnt : 1u;
}
DI void xcd_barrier(const XcdBarrier& b) {
  asm volatile("s_waitcnt vmcnt(0)" ::: "memory");
  __syncthreads();
  if (opaque_tid() == 0) {
    unsigned* bar = b.bar;
    __builtin_amdgcn_s_waitcnt(0);
    unsigned nloc = b.st[0], nx = b.st[1];
    if (nloc == 0u) { xcd_barrier_complete(bar, b.x, nloc, nx); b.st[0] = nloc; b.st[1] = nx; }
    const unsigned old = xb_add(&bar[XB_XSUB(b.x)], 1u);
    const unsigned gen = old / nloc;
    if (old + 1u == (gen + 1u) * nloc) {
      __builtin_amdgcn_fence(__ATOMIC_RELEASE, "agent");
      asm volatile("s_waitcnt vmcnt(0)" ::: "memory");
      const unsigned og = xb_add(&bar[XB_TOP], 1u);
      const unsigned tg = og / nx;
      if (og + 1u == (tg + 1u) * nx) xb_add(&bar[XB_TOPGEN], 1u);
      else XB_SPIN(xb_ld(&bar[XB_TOPGEN]) == tg, bar);
      __builtin_amdgcn_fence(__ATOMIC_ACQUIRE, "agent");
      xb_add(&bar[XB_XGEN(b.x)], 1u);
      asm volatile("s_waitcnt vmcnt(0)" ::: "memory");
    } else {
      XB_SPIN(xb_ld(&bar[XB_XGEN(b.x)]) == gen, bar);
      __builtin_amdgcn_fence(__ATOMIC_ACQUIRE, "agent");
      asm volatile("s_waitcnt vmcnt(0)" ::: "memory");
    }
  }
  __syncthreads();
}

extern __shared__ __attribute__((aligned(16))) unsigned char smem[];

__global__ void __launch_bounds__(512) mk_fwd(Params p) {
  cg::grid_group grid = cg::this_grid();
  unsigned char* ws = p.ws;
  volatile LAS unsigned* xst = (volatile LAS unsigned*)(unsigned long)(LDS_BYTES - 16);
  if (opaque_tid() == 0) { xst[0] = 0u; xst[1] = 0u; }
  __syncthreads();
  const XcdBarrier xb = xcd_barrier_post((unsigned*)(ws + WS_BAR), xst);
  if (opaque_tid() == 0) xst[2] = xb_add(&xb.bar[XCD_BAR_WORDS + 32 * xb.x], 1u);
  int bperm = blockIdx.x;
  {
    const long gtid = (long)blockIdx.x * 512 + opaque_tid(), nthr = (long)gridDim.x * 512;
    conv_weight(p.w_in, 3600, 1024, NPROJ, (u16*)(ws + WS_WIN), 0, nullptr, gtid, nthr);
    conv_weight(p.w_out, 1024, 1024, 1024, (u16*)(ws + WS_WOUT), 0, nullptr, gtid, nthr);
    conv_weight(p.w_up, 5632, 1024, 5632, (u16*)(ws + WS_WUP), 1, p.norm2, gtid, nthr);
    conv_weight(p.w_down, 1024, 2816, 1024, (u16*)(ws + WS_WDOWN), 0, nullptr, gtid, nthr);
  }
  const bool beside = (gridDim.x >= 64);
#pragma unroll 1
  for (int grp = 0; grp < 3; ++grp) {
    const int gsc = __builtin_amdgcn_readfirstlane(grp);
    const float* xg = p.xgrp[gsc] + (long)(gsc >> 1) * TG * 1024;
    float* outg = p.out + (long)gsc * TG * 1024;
    const int psel = (gsc == 1 && beside) ? 1 : 0;
    u16* projg = (u16*)(p.pbase[psel] + (psel ? (size_t)TG * 1024 * sizeof(float) : WS_PROJ));
    if (!(grp == 1 && beside)) { REP(0) { phase_norm<0>(p, xg, ws, smem); __syncthreads(); } }
    if (grp == 0) {
      grid.sync();
      unsigned off = 0u;
#pragma unroll
      for (unsigned j = 0; j < 16; ++j) { const unsigned c = xb_ld(&xb.bar[XB_XCNT(j)]); off += (j < xb.x) ? c : 0u; }
      bperm = __builtin_amdgcn_readfirstlane((int)(off + xst[2]));
    } else GSYNC();
    if (!(grp == 1 && beside)) { REP(1) gemm8_run<1>(grp, ws, xg, outg, bperm, (int)gridDim.x, projg); GSYNC(); }
    phase_prep(p, grp, ws, projg);
    GSYNC();
    {
      REP(4) for (int it = blockIdx.x; it < 2048; it += gridDim.x) dnlocal_item(ws, smem, it);
    }
    GSYNC();
    {
      const int nchains = (grp == 0) ? 16 : 128;
      REP(3) for (int c = blockIdx.x; c < nchains; c += gridDim.x) scan_chain(grp, ws, smem, c);
      if (grp == 0 && beside && blockIdx.x >= 16) {
        __syncthreads(); phase_norm<16>(p, p.xs, ws, smem);
        {
          asm volatile("s_waitcnt vmcnt(0)" ::: "memory");
          __syncthreads();
          if (opaque_tid() == 0) {
            unsigned* sb = xb.bar + XCD_BAR_WORDS + 32 * 40;
            __builtin_amdgcn_fence(__ATOMIC_RELEASE, "agent");
            asm volatile("s_waitcnt vmcnt(0)" ::: "memory");
            xb_add(sb, 1u);
            XB_SPIN(xb_ld(sb) < gridDim.x - 16u, xb.bar);
            __builtin_amdgcn_fence(__ATOMIC_ACQUIRE, "agent");
            asm volatile("s_waitcnt vmcnt(0)" ::: "memory");
          }
          __syncthreads();
        }
        const int G2 = (int)gridDim.x - 16, b2 = (int)blockIdx.x - 16;
        const int slot = ((G2 & 7) == 0) ? ((b2 & 7) * (G2 >> 3) + (b2 >> 3)) : b2;
        gemm8_run<1>(1, ws, p.xs, p.out, slot, G2, (u16*)(p.pbase[1] + (size_t)TG * 1024 * sizeof(float)));
      }
      unsigned* qctr = xb.bar + XCD_BAR_WORDS + 32 * 16 + 32 * grp;
      for (;;) {
        if (opaque_tid() == 0) xst[3] = xb_add(qctr, 1u);
        __syncthreads();
        const int it = __builtin_amdgcn_readfirstlane((int)xst[3]);
        if (it >= 6144) break;
        attn_item(grp, ws, smem, it, projg);
      }
    }
    GSYNC();
    REP(5) phase_merge(p, ws, projg);
    GSYNC();
    REP(8) gemm8_run<2>(grp, ws, xg, outg, bperm, (int)gridDim.x, nullptr);
    GSYNC();
    REP(9) gemm8_glu(p, grp, ws, bperm);
    GSYNC();
    REP(11) gemm8_run<4>(grp, ws, xg, outg, bperm, (int)gridDim.x, nullptr);
  }
}

extern "C" void kernel_launch(void* const* d_in, const int* in_sizes, int n_in, void* d_out, int out_size,
                              void* d_ws, size_t ws_size, hipStream_t stream) {
  static int grid_blocks = 0;
  if (!grid_blocks) {
    int dev = 0, cus = 0, per_cu = 0;
    (void)hipGetDevice(&dev);
    (void)hipDeviceGetAttribute(&cus, hipDeviceAttributeMultiprocessorCount, dev);
    (void)hipFuncSetAttribute((const void*)mk_fwd, hipFuncAttributeMaxDynamicSharedMemorySize, LDS_BYTES);
    (void)hipOccupancyMaxActiveBlocksPerMultiprocessor(&per_cu, (const void*)mk_fwd, 512, LDS_BYTES);
    if (per_cu < 1) per_cu = 1;
    grid_blocks = cus * per_cu;
    if (ws_size < 947 * MiB) fprintf(stderr, "workspace too small: %zu\n", ws_size);
  }
  Params p{};
  p.xp = (const float*)d_in[0]; p.xs = (const float*)d_in[1]; p.norm1 = (const float*)d_in[2]; p.w_in = (const float*)d_in[3];
  p.qn = (const float*)d_in[4]; p.kn = (const float*)d_in[5]; p.dn_conv_w = (const float*)d_in[6]; p.a_log = (const float*)d_in[7];
  p.dt_bias = (const float*)d_in[8]; p.out_norm = (const float*)d_in[9]; p.w_out = (const float*)d_in[10]; p.norm2 = (const float*)d_in[11];
  p.w_up = (const float*)d_in[12]; p.ffn_cw = (const float*)d_in[13]; p.ffn_cb = (const float*)d_in[14]; p.w_down = (const float*)d_in[15];
  p.out = (float*)d_out; p.ws = (unsigned char*)d_ws;
  p.xgrp[0] = p.xp; p.xgrp[1] = p.xs; p.xgrp[2] = p.xs;
  p.pbase[0] = (unsigned char*)d_ws; p.pbase[1] = (unsigned char*)d_out;
  (void)hipMemsetAsync((unsigned char*)d_ws + WS_BAR, 0, 16384, stream);
  void* args[] = {&p};
  hipError_t e = hipLaunchCooperativeKernel((void*)mk_fwd, dim3(grid_blocks), dim3(512), args, LDS_BYTES, stream);
  if (e != hipSuccess) fprintf(stderr, "cooperative launch failed: %s (grid %d)\n", hipGetErrorString(e), grid_blocks);
}
```
